# Optimizing an MI355X kernel written in HIP

```python
import jax, jax.numpy as jnp
from jax import lax
import numpy as np

D_MODEL = 1024
BATCH = 8
SEQ = 4096
DEPTH = 1

D_MIX = D_MODEL
D_LRU = D_MIX // 2
LRU_BLOCKS = 8
LRU_BD = D_LRU // LRU_BLOCKS
CONV_W = 4
LRU_C = 8.0
N_HEADS = 8
QK_NOPE = 64
QK_ROPE = 32
QK_HEAD = QK_NOPE + QK_ROPE
V_HEAD = (D_MIX - D_LRU) // N_HEADS
Q_LORA = 256
KV_LORA = 128
ROPE_THETA = 10000.0
Q_BLOCK = 128
D_IN = 2 * D_LRU + Q_LORA + KV_LORA + QK_ROPE
N_EXPERTS = 32
TOP_K = 4
D_FF = D_MODEL
SWIGLU_LIMIT = 7.0
SWIGLU_ALPHA = 1.702
MOE_BLOCK = 512
EPS = 1e-6

kernel_name = "hymba_lru_mla_moe_adaln"


def rms_norm(x, g):
    x32 = x.astype(jnp.float32)
    y = x32 * lax.rsqrt(jnp.mean(x32 * x32, axis=-1, keepdims=True) + EPS)
    return (y * g.astype(jnp.float32)).astype(x.dtype)


def modulate(h, shift, scale):
    return h * (1.0 + scale[:, None, :]) + shift[:, None, :]


def apply_rope(x, pos):
    half = x.shape[-1] // 2
    freqs = ROPE_THETA ** (-jnp.arange(half, dtype=jnp.float32) / half)
    ang = pos.astype(jnp.float32)[..., None] * freqs
    cos = jnp.cos(ang)[:, :, None, :]
    sin = jnp.sin(ang)[:, :, None, :]
    x32 = x.astype(jnp.float32)
    x1, x2 = x32[..., :half], x32[..., half:]
    return jnp.concatenate([x1 * cos - x2 * sin, x2 * cos + x1 * sin], axis=-1).astype(x.dtype)


def causal_depthwise_conv(x, w, b):
    S = x.shape[1]
    xp = jnp.pad(x, ((0, 0), (CONV_W - 1, 0), (0, 0)))
    y = xp[:, 0:S] * w[0]
    for j in range(1, CONV_W):
        y = y + xp[:, j:j + S] * w[j]
    return y + b


def _lin_comb(left, right):
    a1, b1 = left
    a2, b2 = right
    return a1 * a2, a2 * b1 + b2


def rg_lru(x, w_a, b_a, w_x, b_x, lam):
    B, S, C = x.shape
    xb = x.reshape(B, S, LRU_BLOCKS, LRU_BD)
    r = jax.nn.sigmoid(jnp.einsum('bsnc,ncd->bsnd', xb, w_a).reshape(B, S, C) + b_a)
    i = jax.nn.sigmoid(jnp.einsum('bsnc,ncd->bsnd', xb, w_x).reshape(B, S, C) + b_x)
    log_a = -LRU_C * r.astype(jnp.float32) * jax.nn.softplus(-lam.astype(jnp.float32))
    a = jnp.exp(log_a)
    mult = jnp.sqrt(-jnp.expm1(2.0 * log_a))
    u = mult * (i * x).astype(jnp.float32)
    _, h = lax.associative_scan(_lin_comb, (a, u), axis=1)
    return h.astype(x.dtype)


def causal_block_attention(q, k, v):
    B, S, H, Dk = q.shape
    nb = S // Q_BLOCK
    qb = q.reshape(B, nb, Q_BLOCK, H, Dk).transpose(1, 0, 2, 3, 4)
    kpos = jnp.arange(S, dtype=jnp.int32)
    scale = QK_HEAD ** -0.5

    def one_block(args):
        qblk, bi = args
        s = jnp.einsum('bqhd,bkhd->bhqk', qblk, k, preferred_element_type=jnp.float32) * scale
        qpos = bi * Q_BLOCK + jnp.arange(Q_BLOCK, dtype=jnp.int32)
        mask = kpos[None, :] <= qpos[:, None]
        s = jnp.where(mask[None, None], s, jnp.float32(-1e30))
        p = jax.nn.softmax(s, axis=-1).astype(v.dtype)
        return jnp.einsum('bhqk,bkhd->bqhd', p, v)

    o = lax.map(one_block, (qb, jnp.arange(nb, dtype=jnp.int32)))
    return o.transpose(1, 0, 2, 3, 4).reshape(B, S, H * v.shape[-1])


def moe_ffn(h, w_router, b_router, w1, b1, w2, b2):
    Bn, S, D = h.shape
    T = Bn * S
    A = T * TOP_K
    hf = h.reshape(T, D)
    logits = (hf @ w_router + b_router).astype(jnp.float32)
    top_vals, top_idx = lax.top_k(logits, TOP_K)
    gates = jax.nn.softmax(top_vals, axis=-1).astype(h.dtype)
    flat_e = top_idx.reshape(A).astype(jnp.int32)
    flat_g = gates.reshape(A)
    flat_tok = jnp.arange(A, dtype=jnp.int32) // TOP_K
    order = jnp.argsort(flat_e)
    se, stok, sg = flat_e[order], flat_tok[order], flat_g[order]
    counts = jnp.zeros((N_EXPERTS,), jnp.int32).at[flat_e].add(1)
    group_start = jnp.cumsum(counts) - counts
    padded = (counts + MOE_BLOCK - 1) // MOE_BLOCK * MOE_BLOCK
    pad_end = jnp.cumsum(padded)
    pad_start = pad_end - padded
    dest = pad_start[se] + jnp.arange(A, dtype=jnp.int32) - group_start[se]
    n_blocks = -(-A // MOE_BLOCK) + N_EXPERTS
    P = n_blocks * MOE_BLOCK
    buf_tok = jnp.zeros((P,), jnp.int32).at[dest].set(stok)
    buf_g = jnp.zeros((P,), h.dtype).at[dest].set(sg)
    block_start = jnp.arange(n_blocks, dtype=jnp.int32) * MOE_BLOCK
    block_e = jnp.clip(jnp.searchsorted(pad_end, block_start, side='right'), 0, N_EXPERTS - 1)

    def body(acc, blk):
        tok, g, e = blk
        xb = hf[tok]
        gu = xb @ w1[e] + b1[e]
        glu = jnp.minimum(gu[:, :D_FF], SWIGLU_LIMIT)
        lin = jnp.clip(gu[:, D_FF:], -SWIGLU_LIMIT, SWIGLU_LIMIT)
        y = ((lin + 1.0) * (glu * jax.nn.sigmoid(SWIGLU_ALPHA * glu))) @ w2[e] + b2[e]
        return acc.at[tok].add(y * g[:, None]), None

    out, _ = lax.scan(body, jnp.zeros_like(hf),
                      (buf_tok.reshape(n_blocks, MOE_BLOCK), buf_g.reshape(n_blocks, MOE_BLOCK), block_e))
    return out.reshape(Bn, S, D)


def setup_inputs(seed: int = 0) -> dict:
    key = jax.random.key(seed)
    ks = jax.random.split(key, 32)
    f32 = jnp.float32
    L = DEPTH

    def nrm(k, shape, scale):
        return jax.random.normal(k, shape, f32) * scale

    def gain(k, shape):
        return 1.0 + 0.01 * jax.random.normal(k, shape, f32)

    x = jax.random.normal(ks[0], (BATCH, SEQ, D_MODEL), f32)
    c = jax.random.normal(ks[1], (BATCH, D_MODEL), f32)
    offs = jax.random.randint(ks[2], (BATCH, 1), 0, 1024, dtype=jnp.int32)
    positions = offs + jnp.arange(SEQ, dtype=jnp.int32)[None, :]
    u = jax.random.uniform(ks[3], (L, D_LRU), f32, 0.9, 0.999)
    s = u ** (1.0 / LRU_C)
    lam = jnp.log(s) - jnp.log1p(-s)
    return {
        "x": x, "c": c, "positions": positions,
        "w_ada": nrm(ks[4], (L, D_MODEL, 6 * D_MODEL), D_MODEL ** -0.5),
        "b_ada": nrm(ks[5], (L, 6 * D_MODEL), 0.01),
        "g_mix": gain(ks[6], (L, D_MODEL)),
        "w_in": nrm(ks[7], (L, D_MODEL, D_IN), D_MODEL ** -0.5),
        "conv_w": nrm(ks[8], (L, CONV_W, D_LRU), CONV_W ** -0.5),
        "conv_b": nrm(ks[9], (L, D_LRU), 0.01),
        "w_a": nrm(ks[10], (L, LRU_BLOCKS, LRU_BD, LRU_BD), LRU_BD ** -0.5),
        "b_a": nrm(ks[11], (L, D_LRU), 0.01),
        "w_x": nrm(ks[12], (L, LRU_BLOCKS, LRU_BD, LRU_BD), LRU_BD ** -0.5),
        "b_x": nrm(ks[13], (L, D_LRU), 0.01),
        "lam": lam,
        "g_q_lat": gain(ks[14], (L, Q_LORA)),
        "w_uq": nrm(ks[15], (L, Q_LORA, N_HEADS * QK_HEAD), Q_LORA ** -0.5),
        "g_kv_lat": gain(ks[16], (L, KV_LORA)),
        "w_ukv": nrm(ks[17], (L, KV_LORA, N_HEADS * (QK_NOPE + V_HEAD)), KV_LORA ** -0.5),
        "g_qn": gain(ks[18], (L, QK_HEAD)),
        "g_kn": gain(ks[19], (L, QK_HEAD)),
        "w_out": nrm(ks[20], (L, D_MIX, D_MODEL), D_MIX ** -0.5),
        "g_ffn": gain(ks[21], (L, D_MODEL)),
        "w_router": nrm(ks[22], (L, D_MODEL, N_EXPERTS), D_MODEL ** -0.5),
        "b_router": nrm(ks[23], (L, N_EXPERTS), 0.01),
        "w1": nrm(ks[24], (L, N_EXPERTS, D_MODEL, 2 * D_FF), D_MODEL ** -0.5),
        "b1": nrm(ks[25], (L, N_EXPERTS, 2 * D_FF), 0.01),
        "w2": nrm(ks[26], (L, N_EXPERTS, D_FF, D_MODEL), D_FF ** -0.5),
        "b2": nrm(ks[27], (L, N_EXPERTS, D_MODEL), 0.01),
    }


def reference(x, c, positions, w_ada, b_ada, g_mix, w_in, conv_w, conv_b, w_a, b_a, w_x, b_x, lam,
              g_q_lat, w_uq, g_kv_lat, w_ukv, g_qn, g_kn, w_out, g_ffn, w_router, b_router,
              w1, b1, w2, b2):
    B, S, D = x.shape
    o1 = 2 * D_LRU
    o2 = o1 + Q_LORA
    o3 = o2 + KV_LORA
    for l in range(DEPTH):
        mod = jax.nn.silu(c) @ w_ada[l] + b_ada[l]
        shift1, scale1, gate1, shift2, scale2, gate2 = jnp.split(mod, 6, axis=-1)

        h = modulate(rms_norm(x, g_mix[l]), shift1, scale1)
        z = h @ w_in[l]
        x_lru, y_lru = z[..., :D_LRU], z[..., D_LRU:o1]
        q_lat, kv_lat, k_rope = z[..., o1:o2], z[..., o2:o3], z[..., o3:]

        xc = causal_depthwise_conv(x_lru, conv_w[l], conv_b[l])
        hr = rg_lru(xc, w_a[l], b_a[l], w_x[l], b_x[l], lam[l])
        lru_out = jax.nn.gelu(y_lru) * hr

        q = (rms_norm(q_lat, g_q_lat[l]) @ w_uq[l]).reshape(B, S, N_HEADS, QK_HEAD)
        kv = (rms_norm(kv_lat, g_kv_lat[l]) @ w_ukv[l]).reshape(B, S, N_HEADS, QK_NOPE + V_HEAD)
        k_nope, v = kv[..., :QK_NOPE], kv[..., QK_NOPE:]
        k_r = jnp.broadcast_to(k_rope[:, :, None, :], (B, S, N_HEADS, QK_ROPE))
        k = jnp.concatenate([k_nope, k_r], axis=-1)
        q = rms_norm(q, g_qn[l])
        k = rms_norm(k, g_kn[l])
        q = jnp.concatenate([q[..., :QK_NOPE], apply_rope(q[..., QK_NOPE:], positions)], axis=-1)
        k = jnp.concatenate([k[..., :QK_NOPE], apply_rope(k[..., QK_NOPE:], positions)], axis=-1)
        attn_out = causal_block_attention(q, k, v)

        mix = jnp.concatenate([lru_out, attn_out], axis=-1) @ w_out[l]
        x = x + gate1[:, None, :] * mix

        h2 = modulate(rms_norm(x, g_ffn[l]), shift2, scale2)
        x = x + gate2[:, None, :] * moe_ffn(h2, w_router[l], b_router[l], w1[l], b1[l], w2[l], b2[l])
    return x
```

```cpp
#include <hip/hip_runtime.h>
#include <cstdio>
#include <cstdint>

#ifndef MK_N_LAUNCHES
#define MK_N_LAUNCHES 1
#endif
#ifndef PROBE_PHASE
#define PROBE_PHASE -1
#endif
#ifndef PROBE_REP
#define PROBE_REP 3
#endif
#ifndef MK_LAST_PHASE
#define MK_LAST_PHASE 12
#endif

#define LAS __attribute__((address_space(3)))
#define GAS __attribute__((address_space(1)))
typedef unsigned short bf16;
typedef short bf16x8 __attribute__((ext_vector_type(8)));
typedef float f32x4 __attribute__((ext_vector_type(4)));
typedef float f32x16 __attribute__((ext_vector_type(16)));
typedef unsigned u32x4 __attribute__((ext_vector_type(4)));
typedef unsigned u32x2 __attribute__((ext_vector_type(2)));
typedef float f32x2 __attribute__((ext_vector_type(2)));
typedef int v4i __attribute__((ext_vector_type(4)));
typedef int v8i __attribute__((ext_vector_type(8)));

constexpr int NB = 8, SEQ = 4096, DM = 1024, T = NB * SEQ;
constexpr int DLRU = 512, NHEAD = 8, QKH = 96, VH = 64, QLORA = 256, KVLORA = 128, DIN = 1440, DINP = 1536;
constexpr int NEXP = 32, TOPK = 4, DFF = 1024;
constexpr float EPS = 1e-6f;
constexpr int ACT_ROWS = T * TOPK + NEXP * 256;

constexpr size_t MiB = 1u << 20;
constexpr size_t WS_CTL = 0, CTL_ZERO_BYTES = 64 * 1024;
constexpr size_t WS_MOD = 1 * MiB;
constexpr size_t WS_COS = 2 * MiB, WS_SIN = 4 * MiB;
constexpr size_t WS_SSQ = 6 * MiB;
constexpr size_t WS_AGG = 8 * MiB;
constexpr size_t WS_WAX = 10 * MiB;
constexpr size_t WS_LIST = 12 * MiB;
constexpr size_t WS_GATES = 16 * MiB;
constexpr size_t WS_WUQ = 17 * MiB;
constexpr size_t WS_WUKV = 18 * MiB;
constexpr size_t WS_WIN = 20 * MiB;
constexpr size_t WS_WOUT = 24 * MiB;
constexpr size_t WS_WR = 26 * MiB;
constexpr size_t WS_LOGIT = 28 * MiB;
constexpr size_t WS_W2 = 32 * MiB;
constexpr size_t WS_W1 = 96 * MiB;
constexpr size_t WS_H = 224 * MiB;
constexpr size_t WS_Z = 288 * MiB;
constexpr size_t WS_Q = 384 * MiB;
constexpr size_t WS_K = 432 * MiB;
constexpr size_t WS_V = 480 * MiB;
constexpr size_t WS_ACT = 224 * MiB;
constexpr size_t WS_MIX = 512 * MiB;
constexpr size_t WS_H2 = 576 * MiB;
constexpr size_t WS_Y4 = 640 * MiB;
constexpr size_t WS_H2B = 768 * MiB;
constexpr size_t WS_X1B = 832 * MiB;
constexpr size_t WS_END = 896 * MiB;
static_assert(WS_ACT + (size_t)ACT_ROWS * 1024 * 2 <= WS_MIX, "act overlay");
constexpr int CW_BAR = 1024;
constexpr int CW_CNT = 8192;

constexpr int RING_BYTES = 131072;
constexpr int LDSCTL_OFF = RING_BYTES;
constexpr int MISC_OFF = LDSCTL_OFF + 64;
constexpr int TAB_OFF = LDSCTL_OFF + 256;
constexpr int ROWTAB_OFF = LDSCTL_OFF + 1024;
constexpr int LDS_BYTES = 147456;

#define RLX_AGENT __ATOMIC_RELAXED, __HIP_MEMORY_SCOPE_AGENT
#define LDS_WAIT() asm volatile("s_waitcnt lgkmcnt(0)" ::: "memory")
typedef __bf16 bf16x2_t __attribute__((ext_vector_type(2)));
__device__ __forceinline__ unsigned cvt_pk_bf16(float lo, float hi) { const f32x2 v = {lo, hi}; const bf16x2_t b = __builtin_convertvector(v, bf16x2_t); return __builtin_bit_cast(unsigned, b); }
__device__ __forceinline__ unsigned f2bf(float f) { return cvt_pk_bf16(f, f) & 0xffffu; }
__device__ __forceinline__ unsigned pk2(float lo, float hi) { return cvt_pk_bf16(lo, hi); }
__device__ __forceinline__ float bf2f(unsigned short v) { return __builtin_bit_cast(float, (unsigned)v << 16); }
__device__ __forceinline__ float bflo(unsigned w) { return __builtin_bit_cast(float, w << 16); }
__device__ __forceinline__ float bfhi(unsigned w) { return __builtin_bit_cast(float, w & 0xffff0000u); }
__device__ __forceinline__ float clamp448(float v) { return __builtin_amdgcn_fmed3f(v, -448.0f, 448.0f); }
__device__ __forceinline__ unsigned pk4_fp8(float a, float b, float c, float d) { int w = 0; w = __builtin_amdgcn_cvt_pk_fp8_f32(clamp448(a), clamp448(b), w, false); w = __builtin_amdgcn_cvt_pk_fp8_f32(clamp448(c), clamp448(d), w, true); return (unsigned)w; }
__device__ __forceinline__ float fast_exp(float v) { return __builtin_amdgcn_exp2f(v * 1.4426950408889634f); }
__device__ __forceinline__ float sigmoidf_(float v) { return __builtin_amdgcn_rcpf(1.0f + fast_exp(-v)); }
__device__ __forceinline__ float wave_sum(float v) {
#pragma unroll
    for (int o = 1; o < 64; o <<= 1) v += __shfl_xor(v, o);
    return v;
}
__device__ __forceinline__ float wave_max(float v) {
#pragma unroll
    for (int o = 1; o < 64; o <<= 1) v = fmaxf(v, __shfl_xor(v, o));
    return v;
}
__device__ __forceinline__ int wave_min_i(int v) {
#pragma unroll
    for (int o = 1; o < 64; o <<= 1) { int t = __shfl_xor(v, o); v = t < v ? t : v; }
    return v;
}
__device__ __forceinline__ int lane_id() { int l; asm volatile("v_mbcnt_lo_u32_b32 %0, -1, 0\n\tv_mbcnt_hi_u32_b32 %0, -1, %0" : "=v"(l)); __builtin_assume(l >= 0 && l < 64); return l; }
__device__ __forceinline__ int crow(int r, int hi) { return (r & 3) + 8 * (r >> 2) + 4 * hi; }

#ifndef MOE_DUPK
#define MOE_DUPK 0
#endif
#ifndef MOE_DUPE
#define MOE_DUPE 0
#endif
namespace pg8 {
constexpr int BM = 256, BK = 64, HALF = 128, HTB = HALF * BK * 2, STAGE_BYTES = 8 * HTB, NXCD = 8, WGM = 8;
template <int SW> __device__ __forceinline__ int lds_byte(int r, int kb) { const int st = (r >> 4) * 2 + (kb >> 6), rr = r & 15, ob = rr * 64 + (kb & 63); return st * 1024 + (ob ^ (((ob >> 9) & 1) << SW)); }
template <int SW> __device__ __forceinline__ void stage_rc(int b, int& R, int& CB) { const int st = b / 1024, sb = b % 1024, swz = sb ^ (((sb >> 9) & 1) << SW); R = (st >> 1) * 16 + swz / 64; CB = (st & 1) * 64 + (swz % 64); }
__device__ __forceinline__ int perm32(int rho) { const int n = rho >> 4, i = rho & 15; return 8 * (i >> 2) + 4 * n + (i & 3); }

struct Unit { int pm, pn, e, aux, par; };

struct DenseSched {
    static constexpr bool VAROFF = false, VAROFF_OR_MOE = false, HAS_PREFETCH = false;
    const GAS bf16* A; const GAS bf16* Bt; int lda, K, nM, nN, nwg, G, c;
    __device__ __forceinline__ void init(const GAS bf16* A_, int lda_, const GAS bf16* Bt_, int K_, int M, int N, int G_, int c_) { A = A_; lda = lda_; Bt = Bt_; K = K_; nM = M / BM; nN = N / BM; nwg = nM * nN; G = G_; c = c_; }
    __device__ __forceinline__ bool next(int i, Unit& u) const {
        const long L = (long)i * G + c; if (L >= nwg) return false;
        int wgid = (int)L; { const int q = nwg / NXCD, r = nwg % NXCD, xcd = wgid % NXCD, off = wgid / NXCD; wgid = (xcd < r ? xcd * (q + 1) : r * (q + 1) + (xcd - r) * q) + off; }
        const int nig = WGM * nN, gid = wgid / nig, fm = gid * WGM, gsz = (nM - fm) < WGM ? (nM - fm) : WGM;
        u.pm = fm + ((wgid % nig) % gsz); u.pn = (wgid % nig) / gsz; u.e = 0; u.aux = 0; u.par = 0; return true;
    }
    __device__ __forceinline__ const GAS char* baseA(const Unit& u) const { return (const GAS char*)(A + (size_t)u.pm * BM * lda); }
    __device__ __forceinline__ const GAS char* baseB(const Unit& u) const { return (const GAS char*)(Bt + (size_t)u.pn * BM * K); }
    __device__ __forceinline__ void offsA(const Unit&, const int (&R)[2], const int (&CB)[2], unsigned (&vo)[2][2]) const {
#pragma unroll
        for (int h = 0; h < 2; ++h)
#pragma unroll
            for (int i = 0; i < 2; ++i) vo[h][i] = (unsigned)((h * HALF + R[i]) * lda * 2 + CB[i]);
    }
};

template <int NN, bool GATHER> struct MoeSched {
    const LAS int* tab; const GAS int* list; const GAS unsigned char* A; const GAS unsigned char* Bt; int G, v; size_t bstride;
    static constexpr int PMT = 32 / NN; static constexpr bool VAROFF = GATHER, VAROFF_OR_MOE = true, HAS_PREFETCH = !GATHER;
    const GAS float* gates; LAS unsigned* rowtab;
    __device__ __forceinline__ void prefetch(const Unit& u, int tid) const {
        if (tid < 256) { const int cnt = tab[33 + u.e]; const int pos = u.aux * BM + tid; const int pc = pos < cnt ? pos : cnt - 1; const int ent = list[(size_t)u.e * T + pc]; const float g = 16.0f * gates[ent];
            LAS unsigned* p = rowtab + (u.par * 256 + tid) * 2; p[0] = (unsigned)ent; p[1] = __builtin_bit_cast(unsigned, g); } }
    __device__ __forceinline__ bool next(int i0, Unit& u) const {
        const int i = MOE_DUPK ? (i0 >> 1) : i0;
        const int L = i * G + v, gq = L >> 5, w = L & 31, gmt = gq * PMT + (w % PMT), Mt = tab[32];
        if (gmt >= Mt) return false;
        int e = 0;
        for (int j = 1; j < 32; ++j) e += (tab[j] <= gmt) ? 1 : 0;
        u.pm = gmt; u.pn = w / PMT; u.e = e; u.aux = gmt - tab[e]; u.par = i0 & 1; return true;
    }
    __device__ __forceinline__ const GAS char* baseA(const Unit& u) const { return GATHER ? (const GAS char*)A : (const GAS char*)(A + (size_t)u.pm * BM * 1024); }
    __device__ __forceinline__ const GAS char* baseB(const Unit& u) const { return (const GAS char*)(Bt + (size_t)u.e * bstride + (size_t)u.pn * BM * 1024); }
    __device__ __forceinline__ void offsA(const Unit& u, const int (&R)[2], const int (&C)[2], unsigned (&vo)[2][2]) const {
        if constexpr (GATHER) {
            const int cnt = tab[33 + u.e];
#pragma unroll
            for (int h = 0; h < 2; ++h)
#pragma unroll
                for (int i = 0; i < 2; ++i) { const int pos = u.aux * BM + h * HALF + R[i]; const int pc = pos < cnt ? pos : cnt - 1;
                    const int tok = list[(size_t)u.e * T + pc] >> 2; vo[h][i] = (unsigned)(tok * 1024 + C[i]); }
        } else {
#pragma unroll
            for (int h = 0; h < 2; ++h)
#pragma unroll
                for (int i = 0; i < 2; ++i) vo[h][i] = (unsigned)((h * HALF + R[i]) * 1024 + C[i]);
        }
    }
};

template <class Epi> struct BRowMap { static constexpr int HALF_ROWS = HALF; __device__ static __forceinline__ int map(int R) { return Epi::PERM ? ((R & ~31) + perm32(R & 31)) : R; } };
template <class Epi> __device__ __forceinline__ constexpr int bhalf_rows() { return BRowMap<Epi>::HALF_ROWS; }
template <class Epi> __device__ __forceinline__ int brow_of(int R) { return BRowMap<Epi>::map(R); }
template <class Epi, class Sched, bool ALIGN_EPI, bool FP8 = false>
__device__ __forceinline__ void gemm_phase(LAS unsigned char* lds, const int KB, const Sched& S, const Epi& E, const int wid) {
    const int lane = lane_id(), tid = wid * 64 + lane, wr = wid >> 2, wc = wid & 3, fr = lane & 15, fq = lane >> 4;
    constexpr int SW = FP8 ? 4 : 5;
    int nt = KB / 128; asm volatile("" : "+s"(nt));
    unsigned voffB[2];
#define PG8_RC() int Rp[2], Cp[2]; _Pragma("unroll") for (int i = 0; i < 2; ++i) { int t_ = tid; asm volatile("" : "+v"(t_)); stage_rc<SW>(t_ * 16 + i * 8192, Rp[i], Cp[i]); }
    { PG8_RC();
#pragma unroll
      for (int i = 0; i < 2; ++i) { const int Rb = brow_of<Epi>(Rp[i]); voffB[i] = (unsigned)(Rb * KB + Cp[i]); } }
    const size_t kstep = (size_t)128;
    const size_t hstepB = (size_t)bhalf_rows<Epi>() * KB;
    const unsigned ldsw = (unsigned)wid * 1024u;
    int aoffk[2], boffk[2];
#pragma unroll
    for (int k = 0; k < 2; ++k) { const int kb = FP8 ? (32 * fq + 16 * k) : (16 * fq + 64 * k); aoffk[k] = lds_byte<SW>(wr * 64 + fr, kb); boffk[k] = lds_byte<SW>(wc * 32 + fr, kb); }
#define PG8_SA(b, h) (((b) * 2 + (h)) * HTB)
#define PG8_SB(b, h) ((4 + (b) * 2 + (h)) * HTB)
#define PG8_STAGE(bufoff, gbase, voff) do { _Pragma("unroll") for (int _i = 0; _i < 2; ++_i) \
        __builtin_amdgcn_global_load_lds((const GAS unsigned*)((gbase) + (voff)[_i]), (LAS unsigned*)(lds + (bufoff) + ldsw + _i * 8192), 16, 0, 0); } while (0)
#define PG8_LD16(off) (*(const LAS v4i*)(lds + (off)))
#define PG8_LDA(dst, b, h) do { _Pragma("unroll") for (int m = 0; m < 4; ++m) { if constexpr (FP8) dst##8[m] = __builtin_shufflevector(PG8_LD16(PG8_SA(b, h) + aoffk[0] + m * 2048), PG8_LD16(PG8_SA(b, h) + aoffk[1] + m * 2048), 0, 1, 2, 3, 4, 5, 6, 7); \
        else { _Pragma("unroll") for (int k = 0; k < 2; ++k) dst[m][k] = *(const LAS bf16x8*)(lds + PG8_SA(b, h) + aoffk[k] + m * 2048); } } } while (0)
#define PG8_LDB(dst, b, h) do { _Pragma("unroll") for (int n = 0; n < 2; ++n) { if constexpr (FP8) dst##8[n] = __builtin_shufflevector(PG8_LD16(PG8_SB(b, h) + boffk[0] + n * 2048), PG8_LD16(PG8_SB(b, h) + boffk[1] + n * 2048), 0, 1, 2, 3, 4, 5, 6, 7); \
        else { _Pragma("unroll") for (int k = 0; k < 2; ++k) dst[n][k] = *(const LAS bf16x8*)(lds + PG8_SB(b, h) + boffk[k] + n * 2048); } } } while (0)
#define PG8_MMA(ai, bj, At, Bt) do { __builtin_amdgcn_s_setprio(1); \
        if constexpr (FP8) { _Pragma("unroll") for (int m = 0; m < 4; ++m) _Pragma("unroll") for (int n = 0; n < 2; ++n) \
            asm volatile("v_mfma_f32_16x16x128_f8f6f4 %0, %1, %2, %0" : "+v"(acc[ai][bj][m][n]) : "v"(Bt##8[n]), "v"(At##8[m])); } \
        else { _Pragma("unroll") for (int m = 0; m < 4; ++m) _Pragma("unroll") for (int n = 0; n < 2; ++n) _Pragma("unroll") for (int k = 0; k < 2; ++k) \
            acc[ai][bj][m][n] = __builtin_amdgcn_mfma_f32_16x16x32_bf16(Bt[n][k], At[m][k], acc[ai][bj][m][n], 0, 0, 0); } \
        __builtin_amdgcn_s_setprio(0); } while (0)
#define PG8_WAIT_V(n) asm volatile("s_waitcnt vmcnt(" #n ")" ::: "memory")
#define PG8_WAIT_L(n) asm volatile("s_waitcnt lgkmcnt(" #n ")" ::: "memory")
#define PG8_BAR __builtin_amdgcn_s_barrier()
#define PG8_SCHED __builtin_amdgcn_sched_barrier(0)
    Unit cur, nxt; int ui = 0;
    if (!S.next(0, cur)) return;
    f32x4 acc[2][2][4][2];
#pragma unroll
    for (int a = 0; a < 2; ++a)
#pragma unroll
        for (int b = 0; b < 2; ++b)
#pragma unroll
            for (int m = 0; m < 4; ++m)
#pragma unroll
                for (int n = 0; n < 2; ++n) acc[a][b][m][n] = (f32x4){0.f, 0.f, 0.f, 0.f};
    bf16x8 At[4][2], B0[2][2], B1[2][2]; v8i At8[4], B08[2], B18[2];
    unsigned voA[2][2], vnA[2][2];
    { PG8_RC(); S.offsA(cur, Rp, Cp, voA); }
    if constexpr (Sched::HAS_PREFETCH) S.prefetch(cur, tid);
    const GAS char* cA = S.baseA(cur); const GAS char* cB = S.baseB(cur);
    PG8_STAGE(PG8_SB(0, 0), cB, voffB); PG8_STAGE(PG8_SB(0, 1), cB + hstepB, voffB); PG8_STAGE(PG8_SA(0, 0), cA, voA[0]); PG8_STAGE(PG8_SA(0, 1), cA, voA[1]);
    if (wr == 1) PG8_BAR;
    PG8_WAIT_V(2); PG8_BAR;
    PG8_STAGE(PG8_SB(1, 0), cB + kstep, voffB); PG8_STAGE(PG8_SA(1, 0), cA + kstep, voA[0]); PG8_STAGE(PG8_SB(1, 1), cB + hstepB + kstep, voffB);
    PG8_WAIT_V(6); PG8_BAR;
    for (;;) {
        const bool has_next = S.next(ui + 1, nxt);
        const GAS char* nA = has_next ? S.baseA(nxt) : cA; const GAS char* nB = has_next ? S.baseB(nxt) : cB;
        if constexpr (Sched::VAROFF) { if (has_next) { PG8_RC(); S.offsA(nxt, Rp, Cp, vnA); } }
        if (!Sched::VAROFF || !has_next) {
#pragma unroll
            for (int h = 0; h < 2; ++h)
#pragma unroll
                for (int i = 0; i < 2; ++i) vnA[h][i] = voA[h][i];
        }
#pragma unroll 1
        for (int t = 0; t < nt; t += 2) {
            const bool last = (t == nt - 2);
            asm volatile("" : "+v"(voffB[0]), "+v"(voffB[1]), "+v"(voA[0][0]), "+v"(voA[0][1]), "+v"(voA[1][0]), "+v"(voA[1][1]));
            const GAS char* a1 = cA + (size_t)(t + 1) * kstep;
            const GAS char* a2 = last ? nA : cA + (size_t)(t + 2) * kstep; const GAS char* b2 = last ? nB : cB + (size_t)(t + 2) * kstep;
            const GAS char* a3 = a2 + kstep; const GAS char* b3 = b2 + kstep;
            unsigned o0[2], o1[2];
#pragma unroll
            for (int i = 0; i < 2; ++i) { o0[i] = voA[0][i]; o1[i] = voA[1][i]; }
            if constexpr (Sched::VAROFF) { if (last) {
#pragma unroll
                for (int i = 0; i < 2; ++i) { o0[i] = vnA[0][i]; o1[i] = vnA[1][i]; } } }
            PG8_LDB(B0, 0, 0); PG8_LDB(B1, 0, 1); PG8_SCHED; PG8_LDA(At, 0, 0); PG8_STAGE(PG8_SA(1, 1), a1, voA[1]);
            PG8_WAIT_V(8); PG8_WAIT_L(0); PG8_BAR; PG8_MMA(0, 0, At, B0); PG8_MMA(0, 1, At, B1); PG8_BAR; PG8_SCHED;
            PG8_LDA(At, 0, 1); PG8_STAGE(PG8_SB(0, 0), b2, voffB); PG8_STAGE(PG8_SB(0, 1), b2 + hstepB, voffB); PG8_STAGE(PG8_SA(0, 0), a2, o0);
            PG8_WAIT_V(8); PG8_WAIT_L(0); PG8_BAR; PG8_MMA(1, 0, At, B0); PG8_MMA(1, 1, At, B1); PG8_BAR; PG8_SCHED;
            PG8_LDB(B0, 1, 0); PG8_LDB(B1, 1, 1); PG8_SCHED; PG8_LDA(At, 1, 0); PG8_STAGE(PG8_SA(0, 1), a2, o1);
            PG8_WAIT_V(8); PG8_WAIT_L(0); PG8_BAR; PG8_MMA(0, 0, At, B0); PG8_MMA(0, 1, At, B1); PG8_BAR; PG8_SCHED;
            PG8_LDA(At, 1, 1); PG8_STAGE(PG8_SB(1, 0), b3, voffB); PG8_STAGE(PG8_SB(1, 1), b3 + hstepB, voffB); PG8_STAGE(PG8_SA(1, 0), a3, o0);
            PG8_WAIT_V(8); PG8_WAIT_L(0); PG8_BAR; PG8_MMA(1, 0, At, B0); PG8_MMA(1, 1, At, B1); PG8_BAR; PG8_SCHED;
        }
        if constexpr (ALIGN_EPI) { if (wr == 0) PG8_BAR; }
        if constexpr (FP8) asm volatile("s_nop 15\n\ts_nop 7" ::: "memory");
        if (!(MOE_DUPK && Sched::VAROFF_OR_MOE && !(ui & 1))) E(acc, cur, wr, wc, fr, fq);
        if (MOE_DUPE && Sched::VAROFF_OR_MOE) { asm volatile("" ::: "memory"); E(acc, cur, wr, wc, fr, fq); }
        if (!has_next) break;
#pragma unroll
        for (int a = 0; a < 2; ++a)
#pragma unroll
            for (int b = 0; b < 2; ++b)
#pragma unroll
                for (int m = 0; m < 4; ++m)
#pragma unroll
                    for (int n = 0; n < 2; ++n) acc[a][b][m][n] = (f32x4){0.f, 0.f, 0.f, 0.f};
        cur = nxt; cA = nA; cB = nB; ++ui;
        if constexpr (Sched::HAS_PREFETCH) S.prefetch(cur, wid * 64 + lane_id());
#pragma unroll
        for (int h = 0; h < 2; ++h)
#pragma unroll
            for (int i = 0; i < 2; ++i) voA[h][i] = vnA[h][i];
        if constexpr (ALIGN_EPI) { if (wr == 1) PG8_BAR; }
    }
    PG8_WAIT_V(0);
    if constexpr (!ALIGN_EPI) { if (wr == 0) PG8_BAR; }
    PG8_BAR;
#undef PG8_SA
#undef PG8_SB
#undef PG8_STAGE
#undef PG8_LDA
#undef PG8_LDB
#undef PG8_MMA
#undef PG8_LD16
#undef PG8_RC
#undef PG8_WAIT_V
#undef PG8_WAIT_L
#undef PG8_BAR
#undef PG8_SCHED
}

typedef const f32x4 (&AccRef)[2][2][4][2];

struct EpiZ {
    static constexpr bool PERM = true;
    GAS bf16* Z; GAS float* ssq;
    __device__ __forceinline__ void operator()(AccRef acc, const Unit& u, int wr, int wc, int fr, int fq) const {
        const int row0 = u.pm * BM + wr * 64 + fr, col0 = u.pn * BM + wc * 32 + 8 * fq;
#pragma unroll
        for (int ai = 0; ai < 2; ++ai)
#pragma unroll
            for (int m = 0; m < 4; ++m) { const int row = row0 + ai * HALF + m * 16; GAS bf16* rowp = Z + (size_t)row * DINP + col0;
                float s0 = 0.f, s1 = 0.f;
#pragma unroll
                for (int bj = 0; bj < 2; ++bj) { const f32x4 v0 = acc[ai][bj][m][0], v1 = acc[ai][bj][m][1];
                    const float s = (v0[0] * v0[0] + v0[1] * v0[1]) + (v0[2] * v0[2] + v0[3] * v0[3]) + (v1[0] * v1[0] + v1[1] * v1[1]) + (v1[2] * v1[2] + v1[3] * v1[3]);
                    if (bj == 0) s0 = s; else s1 = s;
                    u32x4 w; w.x = cvt_pk_bf16(v0[0], v0[1]); w.y = cvt_pk_bf16(v0[2], v0[3]); w.z = cvt_pk_bf16(v1[0], v1[1]); w.w = cvt_pk_bf16(v1[2], v1[3]);
                    *(GAS u32x4*)(rowp + bj * HALF) = w; }
                if (u.pn >= 4) {
                    s0 += __shfl_xor(s0, 16); s0 += __shfl_xor(s0, 32); s1 += __shfl_xor(s1, 16); s1 += __shfl_xor(s1, 32);
                    if (fq == 0) {
                        if (u.pn == 4) ssq[(size_t)row * 12 + wc] = s0 + s1;
                        else { ssq[(size_t)row * 12 + 4 + wc] = s0; if (wc == 0) ssq[(size_t)row * 12 + 8] = s1; }
                    }
                }
            }
    }
};
struct EpiQ {
    static constexpr bool PERM = true;
    GAS bf16* Q; const GAS float* ssq;
    __device__ __forceinline__ void operator()(AccRef acc, const Unit& u, int wr, int wc, int fr, int fq) const {
        const int row0 = u.pm * BM + wr * 64 + fr, col0 = u.pn * BM + wc * 32 + 8 * fq;
#pragma unroll
        for (int ai = 0; ai < 2; ++ai)
#pragma unroll
            for (int m = 0; m < 4; ++m) { const int row = row0 + ai * HALF + m * 16; GAS bf16* rowp = Q + (size_t)row * 768 + col0;
                const f32x4 sp = *(const GAS f32x4*)(ssq + (size_t)row * 12);
                const float rs = __builtin_amdgcn_rsqf(((sp[0] + sp[1]) + (sp[2] + sp[3])) * (1.0f / QLORA) + EPS);
#pragma unroll
                for (int bj = 0; bj < 2; ++bj) { const f32x4 v0 = acc[ai][bj][m][0] * rs, v1 = acc[ai][bj][m][1] * rs;
                    u32x4 w; w.x = cvt_pk_bf16(v0[0], v0[1]); w.y = cvt_pk_bf16(v0[2], v0[3]); w.z = cvt_pk_bf16(v1[0], v1[1]); w.w = cvt_pk_bf16(v1[2], v1[3]);
                    *(GAS u32x4*)(rowp + bj * HALF) = w; }
            }
    }
};
struct EpiKV {
    static constexpr bool PERM = true;
    GAS bf16* Kb; GAS bf16* Vb; const GAS bf16* Z; const GAS float* ssq; const GAS float* gkn; const GAS float* ctab; const GAS float* stab;
    __device__ __forceinline__ void operator()(AccRef acc, const Unit& u, int wr, int wc, int fr, int fq) const {
        const int row0 = u.pm * BM + wr * 64 + fr; const int head = 2 * u.pn + (wc & 1);
        if (wc < 2) {
#pragma unroll
            for (int ai = 0; ai < 2; ++ai)
#pragma unroll
                for (int m = 0; m < 4; ++m) { const int row = row0 + ai * HALF + m * 16;
                    asm volatile("" ::: "memory");
                    const f32x4 sp = *(const GAS f32x4*)(ssq + (size_t)row * 12 + 4); const float ssr = ssq[(size_t)row * 12 + 8];
                    const float rkv = __builtin_amdgcn_rsqf(((sp[0] + sp[1]) + (sp[2] + sp[3])) * (1.0f / KVLORA) + EPS);
                    f32x4 v[2][2]; float s = 0.f;
#pragma unroll
                    for (int bj = 0; bj < 2; ++bj)
#pragma unroll
                        for (int n = 0; n < 2; ++n) { v[bj][n] = acc[ai][bj][m][n] * rkv; s += (v[bj][n][0] * v[bj][n][0] + v[bj][n][1] * v[bj][n][1]) + (v[bj][n][2] * v[bj][n][2] + v[bj][n][3] * v[bj][n][3]); }
                    s += __shfl_xor(s, 16); s += __shfl_xor(s, 32);
                    const float rk = __builtin_amdgcn_rsqf((s + ssr) * (1.0f / QKH) + EPS);
                    GAS bf16* kp = Kb + (size_t)row * 768 + head * QKH;
#pragma unroll
                    for (int bj = 0; bj < 2; ++bj) { u32x4 w; const f32x4 g0 = *(const GAS f32x4*)(gkn + bj * 32 + 8 * fq) * rk, g1 = *(const GAS f32x4*)(gkn + bj * 32 + 8 * fq + 4) * rk;
                        w.x = cvt_pk_bf16(v[bj][0][0] * g0[0], v[bj][0][1] * g0[1]); w.y = cvt_pk_bf16(v[bj][0][2] * g0[2], v[bj][0][3] * g0[3]);
                        w.z = cvt_pk_bf16(v[bj][1][0] * g1[0], v[bj][1][1] * g1[1]); w.w = cvt_pk_bf16(v[bj][1][2] * g1[2], v[bj][1][3] * g1[3]);
                        *(GAS u32x4*)(kp + bj * 32 + 8 * fq) = w; }
                    const u32x2 r1 = *(const GAS u32x2*)(Z + (size_t)row * DINP + 1408 + 4 * fq), r2 = *(const GAS u32x2*)(Z + (size_t)row * DINP + 1424 + 4 * fq);
                    const f32x4 cs = *(const GAS f32x4*)(ctab + (size_t)row * 16 + 4 * fq), sn = *(const GAS f32x4*)(stab + (size_t)row * 16 + 4 * fq);
                    float x1[4] = {bflo(r1.x), bfhi(r1.x), bflo(r1.y), bfhi(r1.y)}, x2[4] = {bflo(r2.x), bfhi(r2.x), bflo(r2.y), bfhi(r2.y)};
                    float o1[4], o2[4]; const f32x4 gr1 = *(const GAS f32x4*)(gkn + 64 + 4 * fq), gr2 = *(const GAS f32x4*)(gkn + 80 + 4 * fq);
#pragma unroll
                    for (int j = 0; j < 4; ++j) { const float a = x1[j] * rk * gr1[j], b = x2[j] * rk * gr2[j]; o1[j] = a * cs[j] - b * sn[j]; o2[j] = b * cs[j] + a * sn[j]; }
                    u32x2 w1, w2; w1.x = cvt_pk_bf16(o1[0], o1[1]); w1.y = cvt_pk_bf16(o1[2], o1[3]); w2.x = cvt_pk_bf16(o2[0], o2[1]); w2.y = cvt_pk_bf16(o2[2], o2[3]);
                    *(GAS u32x2*)(kp + 64 + 4 * fq) = w1; *(GAS u32x2*)(kp + 80 + 4 * fq) = w2;
                }
        } else {
#pragma unroll
            for (int ai = 0; ai < 2; ++ai)
#pragma unroll
                for (int m = 0; m < 4; ++m) { const int row = row0 + ai * HALF + m * 16;
                    const f32x4 sp = *(const GAS f32x4*)(ssq + (size_t)row * 12 + 4);
                    const float rkv = __builtin_amdgcn_rsqf(((sp[0] + sp[1]) + (sp[2] + sp[3])) * (1.0f / KVLORA) + EPS);
                    GAS bf16* vp = Vb + (size_t)row * 512 + head * VH;
#pragma unroll
                    for (int bj = 0; bj < 2; ++bj) { const f32x4 v0 = acc[ai][bj][m][0] * rkv, v1 = acc[ai][bj][m][1] * rkv;
                        u32x4 w; w.x = cvt_pk_bf16(v0[0], v0[1]); w.y = cvt_pk_bf16(v0[2], v0[3]); w.z = cvt_pk_bf16(v1[0], v1[1]); w.w = cvt_pk_bf16(v1[2], v1[3]);
                        *(GAS u32x4*)(vp + bj * 32 + 8 * fq) = w; }
                }
        }
    }
};
struct EpiX1 {
    static constexpr bool PERM = true;
    const GAS float* x; GAS bf16* x1; const GAS float* gate;
    __device__ __forceinline__ void operator()(AccRef acc, const Unit& u, int wr, int wc, int fr, int fq) const {
        const int row0 = u.pm * BM + wr * 64 + fr, col0 = u.pn * BM + wc * 32 + 8 * fq; const int b = (u.pm * BM) / SEQ;
        f32x4 gv[2][2];
#pragma unroll
        for (int bj = 0; bj < 2; ++bj)
#pragma unroll
            for (int n = 0; n < 2; ++n) gv[bj][n] = *(const GAS f32x4*)(gate + (size_t)b * 6144 + col0 + bj * HALF + n * 4);
#pragma unroll
        for (int ai = 0; ai < 2; ++ai)
#pragma unroll
            for (int m = 0; m < 4; ++m) { const size_t off = (size_t)(row0 + ai * HALF + m * 16) * DM + col0;
#pragma unroll
                for (int bj = 0; bj < 2; ++bj) { const f32x4 x0 = __builtin_nontemporal_load((const GAS f32x4*)(x + off + bj * HALF)), x1v = __builtin_nontemporal_load((const GAS f32x4*)(x + off + bj * HALF + 4));
                    const f32x4 v0 = x0 + gv[bj][0] * acc[ai][bj][m][0], v1 = x1v + gv[bj][1] * acc[ai][bj][m][1];
                    u32x4 w; w.x = cvt_pk_bf16(v0[0], v0[1]); w.y = cvt_pk_bf16(v0[2], v0[3]); w.z = cvt_pk_bf16(v1[0], v1[1]); w.w = cvt_pk_bf16(v1[2], v1[3]);
                    *(GAS u32x4*)(x1 + off + bj * HALF) = w; }
                if (m & 1) asm volatile("" ::: "memory"); }
    }
};
struct EpiAct {
    static constexpr bool PERM = true;
    GAS unsigned char* act; const GAS float* b1;
    __device__ __forceinline__ void operator()(AccRef acc, const Unit& u, int wr, int wc, int fr, int fq) const {
        const int row0 = u.pm * BM + wr * 64 + fr, col0 = u.pn * 128 + wc * 32 + 8 * fq;
        const GAS float* bp = b1 + (size_t)u.e * 2048 + col0;
        f32x2 bg[4], bu[4];
#pragma unroll
        for (int q = 0; q < 4; ++q) { bg[q] = *(const GAS f32x2*)(bp + 2 * q); bu[q] = *(const GAS f32x2*)(bp + 1024 + 2 * q); }
#pragma unroll
        for (int ai = 0; ai < 2; ++ai)
#pragma unroll
            for (int m = 0; m < 4; ++m) { GAS unsigned char* rowp = act + (size_t)(row0 + ai * HALF + m * 16) * DFF + col0;
                f32x2 o[4];
#pragma unroll
                for (int q = 0; q < 4; ++q) { const int n = q >> 1, j = 2 * (q & 1);
                    const f32x2 ga = {acc[ai][0][m][n][j], acc[ai][0][m][n][j + 1]}, ua = {acc[ai][1][m][n][j], acc[ai][1][m][n][j + 1]};
                    f32x2 gl = ga * 0.015625f + bg[q], li = ua * 0.015625f + bu[q];
                    gl.x = fminf(gl.x, 7.0f); gl.y = fminf(gl.y, 7.0f);
                    li.x = __builtin_amdgcn_fmed3f(li.x, -7.0f, 7.0f); li.y = __builtin_amdgcn_fmed3f(li.y, -7.0f, 7.0f);
                    const f32x2 ea = gl * (-1.702f * 1.4426950408889634f);
                    f32x2 den; den.x = __builtin_amdgcn_exp2f(ea.x); den.y = __builtin_amdgcn_exp2f(ea.y); den = den + 1.0f;
                    f32x2 sg; sg.x = __builtin_amdgcn_rcpf(den.x); sg.y = __builtin_amdgcn_rcpf(den.y);
                    o[q] = (li * 4.0f + 4.0f) * (gl * sg); }
                u32x2 w;
                { int t0 = 0; t0 = __builtin_amdgcn_cvt_pk_fp8_f32(o[0].x, o[0].y, t0, false); t0 = __builtin_amdgcn_cvt_pk_fp8_f32(o[1].x, o[1].y, t0, true); w.x = (unsigned)t0; }
                { int t1 = 0; t1 = __builtin_amdgcn_cvt_pk_fp8_f32(o[2].x, o[2].y, t1, false); t1 = __builtin_amdgcn_cvt_pk_fp8_f32(o[3].x, o[3].y, t1, true); w.y = (unsigned)t1; }
                *(GAS u32x2*)rowp = w; }
    }
};
struct EpiY {
    static constexpr bool PERM = true;
    GAS unsigned char* y4; const GAS float* b2; const LAS unsigned* rowtab; const LAS int* tab;
    __device__ __forceinline__ void operator()(AccRef acc, const Unit& u, int wr, int wc, int fr, int fq) const {
        const int r0 = wr * 64 + fr, col0 = u.pn * BM + wc * 64 + 16 * fq; const int cnt = tab[33 + u.e];
        f32x4 bv[2][2];
#pragma unroll
        for (int bj = 0; bj < 2; ++bj)
#pragma unroll
            for (int n = 0; n < 2; ++n) bv[bj][n] = *(const GAS f32x4*)(b2 + (size_t)u.e * DM + col0 + 8 * bj + 4 * n);
        int ent[8]; float gg[8];
#pragma unroll
        for (int q = 0; q < 8; ++q) { const LAS unsigned* p = rowtab + (u.par * 256 + r0 + (q >> 2) * HALF + (q & 3) * 16) * 2; ent[q] = (int)p[0]; gg[q] = __builtin_bit_cast(float, p[1]); }
#pragma unroll
        for (int ai = 0; ai < 2; ++ai)
#pragma unroll
            for (int m = 0; m < 4; ++m) { const int pos = u.aux * BM + r0 + ai * HALF + m * 16;
                if (pos < cnt) { const float g = gg[ai * 4 + m]; GAS unsigned char* rowp = y4 + (size_t)ent[ai * 4 + m] * DM + col0;
                    u32x4 w;
#pragma unroll
                    for (int bj = 0; bj < 2; ++bj) { const f32x4 v0 = (acc[ai][bj][m][0] * 0.00390625f + bv[bj][0]) * g, v1 = (acc[ai][bj][m][1] * 0.00390625f + bv[bj][1]) * g;
                        w[2 * bj] = pk4_fp8(v0[0], v0[1], v0[2], v0[3]); w[2 * bj + 1] = pk4_fp8(v1[0], v1[1], v1[2], v1[3]); }
                    *(GAS u32x4*)rowp = w; } }
    }
};
template <> struct BRowMap<EpiY> { static constexpr int HALF_ROWS = 8; __device__ static __forceinline__ int map(int R) { const int wc = R >> 5, i = perm32(R & 31); return 64 * wc + 16 * (i >> 3) + (i & 7); } };
struct EpiLogit {
    static constexpr bool PERM = false;
    GAS float* logit; const GAS float* br;
    __device__ __forceinline__ void operator()(AccRef acc, const Unit& u, int wr, int wc, int fr, int fq) const {
        if (wc != 0) return;
        const int row0 = u.pm * BM + wr * 64 + fr;
        const f32x4 b0 = *(const GAS f32x4*)(br + 4 * fq), b1 = *(const GAS f32x4*)(br + 16 + 4 * fq);
#pragma unroll
        for (int ai = 0; ai < 2; ++ai)
#pragma unroll
            for (int m = 0; m < 4; ++m) { GAS float* rp = logit + (size_t)(row0 + ai * HALF + m * 16) * NEXP + 4 * fq;
                *(GAS f32x4*)rp = acc[ai][0][m][0] + b0; *(GAS f32x4*)(rp + 16) = acc[ai][0][m][1] + b1; }
    }
};
}

#define XB_TMO      128
#define XB_XCNT(j)  (256  + 64 * (j))
#define XB_XSUB(j)  (1280 + 64 * (j))
#define XB_XGEN(j)  (2304 + 64 * (j))
#define XB_TOP      3328
#define XB_TOPGEN   3392
#define XCD_BAR_WORDS 3456
#define XB_SPIN_CAP (1u << 18)
__device__ __forceinline__ unsigned xb_ld(unsigned* p)              { return __hip_atomic_load(p, __ATOMIC_RELAXED, __HIP_MEMORY_SCOPE_AGENT); }
__device__ __forceinline__ unsigned xb_add(unsigned* p, unsigned v) { return __hip_atomic_fetch_add(p, v, __ATOMIC_RELAXED, __HIP_MEMORY_SCOPE_AGENT); }
__device__ __forceinline__ unsigned xb_xcc_id() { return (unsigned)__builtin_amdgcn_s_getreg((3 << 11) | 20) & 0xFu; }
#define XB_SPIN(cond, bar) do { unsigned _sp = 0; while (cond) { __builtin_amdgcn_s_sleep(1); \
    if ((++_sp & 255u) == 0u) { if (xb_ld(&(bar)[XB_TMO])) break; if (_sp > XB_SPIN_CAP) { atomicAdd(&(bar)[XB_TMO], 1u); break; } } } } while (0)
struct XcdBarrier { unsigned* bar; unsigned x; volatile LAS unsigned* st; };
__device__ __forceinline__ XcdBarrier xcd_barrier_post(unsigned* bar, volatile LAS unsigned* st, bool leader) {
    XcdBarrier b; b.bar = bar; b.x = xb_xcc_id(); b.st = st;
    if (leader) (void)xb_add(&bar[XB_XCNT(b.x)], 1u);
    return b;
}
__device__ __forceinline__ void xcd_barrier_complete(unsigned* bar, unsigned x, unsigned& nloc, unsigned& nx) {
    const unsigned G = gridDim.x * gridDim.y * gridDim.z;
    unsigned sum, cnt, mine, sp = 0u;
    for (;;) {
        sum = 0u; cnt = 0u; mine = 0u;
#pragma unroll
        for (unsigned j = 0; j < 16; ++j) { const unsigned c = xb_ld(&bar[XB_XCNT(j)]); sum += c; cnt += (c > 0u) ? 1u : 0u; mine = (j == x) ? c : mine; }
        if (sum == G) break;
        __builtin_amdgcn_s_sleep(1);
        if ((++sp & 255u) == 0u) { if (xb_ld(&bar[XB_TMO])) break; if (sp > XB_SPIN_CAP) { atomicAdd(&bar[XB_TMO], 1u); break; } }
    }
    nloc = mine > 0u ? mine : 1u; nx = cnt > 0u ? cnt : 1u;
}
__device__ __forceinline__ void xcd_barrier(const XcdBarrier& b, bool leader) {
    asm volatile("s_waitcnt vmcnt(0)" ::: "memory");
    __syncthreads();
    if (leader) {
        unsigned* bar = b.bar;
        __builtin_amdgcn_s_waitcnt(0);
        unsigned nloc = b.st[0], nx = b.st[1];
        if (nloc == 0u) { xcd_barrier_complete(bar, b.x, nloc, nx); b.st[0] = nloc; b.st[1] = nx; }
        const unsigned old = xb_add(&bar[XB_XSUB(b.x)], 1u);
        const unsigned gen = old / nloc;
        if (old + 1u == (gen + 1u) * nloc) {
            __builtin_amdgcn_fence(__ATOMIC_RELEASE, "agent");
            asm volatile("s_waitcnt vmcnt(0)" ::: "memory");
            const unsigned og = xb_add(&bar[XB_TOP], 1u);
            const unsigned tg = og / nx;
            if (og + 1u == (tg + 1u) * nx) xb_add(&bar[XB_TOPGEN], 1u);
            else XB_SPIN(xb_ld(&bar[XB_TOPGEN]) == tg, bar);
            __builtin_amdgcn_fence(__ATOMIC_ACQUIRE, "agent");
            xb_add(&bar[XB_XGEN(b.x)], 1u);
            asm volatile("s_waitcnt vmcnt(0)" ::: "memory");
        } else {
            XB_SPIN(xb_ld(&bar[XB_XGEN(b.x)]) == gen, bar);
            __builtin_amdgcn_fence(__ATOMIC_ACQUIRE, "agent");
            asm volatile("s_waitcnt vmcnt(0)" ::: "memory");
        }
    }
    __syncthreads();
}

struct Frame {
    LAS unsigned char* lds;
    int tid, lane, wave, vcu, G;
    const float *x, *c; const int* pos; const float *w_ada, *b_ada, *g_mix, *w_in, *conv_w, *conv_b, *w_a, *b_a, *w_x, *b_x, *lam, *g_q_lat, *w_uq, *g_kv_lat, *w_ukv, *g_qn, *g_kn, *w_out, *g_ffn, *w_router, *b_router, *w1, *b1, *w2, *b2;
    float* out; unsigned char* ws; unsigned* ctl;
};
#define WSP(type, off) ((type*)(GAS type*)(F.ws + (off)))
#define WSG(type, off) ((GAS type*)(F.ws + (off)))
#define GG(type, p) ((const GAS type*)(p))

__device__ __forceinline__ void p0_mod_rope(Frame& F) {
    LAS float* sc = (LAS float*)F.lds; LAS float* red = (LAS float*)(F.lds + 32768);
    for (int i = F.tid; i < NB * DM; i += 512) { const float v = F.c[i]; sc[i] = v * sigmoidf_(v); }
    __syncthreads();
    float* mod = WSP(float, WS_MOD);
    for (int u = blockIdx.x; u < 192; u += F.G) {
        const int n = u * 32 + (F.lane & 31), k0 = F.wave * 128 + (F.lane >> 5) * 64;
        float acc[8];
#pragma unroll
        for (int b = 0; b < 8; ++b) acc[b] = 0.f;
#pragma unroll 16
        for (int kk = 0; kk < 64; ++kk) { const int k = k0 + kk; const float w = __builtin_nontemporal_load((const GAS float*)F.w_ada + (size_t)k * 6144 + n);
#pragma unroll
            for (int b = 0; b < 8; ++b) acc[b] += sc[b * DM + k] * w; }
#pragma unroll
        for (int b = 0; b < 8; ++b) acc[b] += __shfl_xor(acc[b], 32);
        if (F.lane < 32) {
#pragma unroll
            for (int b = 0; b < 8; ++b) red[(F.wave * 8 + b) * 32 + F.lane] = acc[b]; }
        __syncthreads();
        if (F.tid < 256) { const int b = F.tid >> 5, j = F.tid & 31; float s = 0.f;
#pragma unroll
            for (int w = 0; w < 8; ++w) s += red[(w * 8 + b) * 32 + j];
            mod[b * 6144 + u * 32 + j] = s + F.b_ada[u * 32 + j]; }
        __syncthreads();
    }
    float* ct = WSP(float, WS_COS); float* st = WSP(float, WS_SIN);
    for (int idx = blockIdx.x * 512 + F.tid; idx < T * 16; idx += F.G * 512) {
        const int t = idx >> 4, i = idx & 15; const float freq = exp2f(-(float)i * (13.287712379549449f / 16.0f));
        const float ang = (float)F.pos[t] * freq; double rev = (double)ang * 0.15915494309189535; rev -= floor(rev); const float rv = (float)rev;
        ct[idx] = __builtin_amdgcn_cosf(rv); st[idx] = __builtin_amdgcn_sinf(rv);
    }
}

__device__ __forceinline__ void transpose_item(const float* W, int ldw, int Ks, int scol0, const float* g, bf16* WT, int Kd, int n0, int k0, LAS float* scr, int lane, float cs = 1.0f) {
#pragma unroll 8
    for (int i = 0; i < 32; ++i) { const int kk = 2 * i + (lane >> 5), k = k0 + kk; float v = 0.f;
        if (scol0 >= 0 && k < Ks) { v = W[(size_t)k * ldw + scol0 + (lane & 31)] * cs; if (g) v *= g[k]; }
        scr[kk * 33 + (lane & 31)] = v; }
    LDS_WAIT(); asm volatile("" ::: "memory");
    const int c = lane & 7;
#pragma unroll
    for (int j = 0; j < 4; ++j) { const int n = (lane >> 3) + 8 * j; const LAS float* s = scr + (8 * c) * 33 + n;
        u32x4 o; o.x = pk2(s[0 * 33], s[1 * 33]); o.y = pk2(s[2 * 33], s[3 * 33]); o.z = pk2(s[4 * 33], s[5 * 33]); o.w = pk2(s[6 * 33], s[7 * 33]);
        *(u32x4*)(WT + (size_t)(n0 + n) * Kd + k0 + 8 * c) = o; }
    LDS_WAIT(); asm volatile("" ::: "memory");
}
__device__ __forceinline__ void transpose_item_fp8(const float* W, int ldw, int scol0, unsigned char* WT, int Kd, int n0, int k0, LAS float* scr, int lane) {
    const GAS float* Wg = (const GAS float*)W;
    f32x4 v[8];
#pragma unroll
    for (int i = 0; i < 8; ++i) v[i] = __builtin_nontemporal_load((const GAS f32x4*)(Wg + (size_t)(k0 + 8 * i + (lane >> 3)) * ldw + scol0 + 4 * (lane & 7)));
#pragma unroll
    for (int i = 0; i < 8; ++i) { LAS float* d = scr + (8 * i + (lane >> 3)) * 33 + 4 * (lane & 7); d[0] = v[i][0] * 64.0f; d[1] = v[i][1] * 64.0f; d[2] = v[i][2] * 64.0f; d[3] = v[i][3] * 64.0f; }
    LDS_WAIT(); asm volatile("" ::: "memory");
    const int c = lane & 3;
#pragma unroll
    for (int j = 0; j < 2; ++j) { const int n = (lane >> 2) + 16 * j; const LAS float* s = scr + (16 * c) * 33 + n;
        u32x4 o; o.x = pk4_fp8(s[0 * 33], s[1 * 33], s[2 * 33], s[3 * 33]); o.y = pk4_fp8(s[4 * 33], s[5 * 33], s[6 * 33], s[7 * 33]);
        o.z = pk4_fp8(s[8 * 33], s[9 * 33], s[10 * 33], s[11 * 33]); o.w = pk4_fp8(s[12 * 33], s[13 * 33], s[14 * 33], s[15 * 33]);
        __builtin_nontemporal_store(o, (GAS u32x4*)(WT + (size_t)(n0 + n) * Kd + k0 + 16 * c)); }
    LDS_WAIT(); asm volatile("" ::: "memory");
}
__device__ __forceinline__ void p1_convert_norm(Frame& F) {
    LAS float* scr = (LAS float*)(F.lds + F.wave * 16384);
    const int gw = F.vcu * 8 + F.wave, NGW = F.G * 8;
    constexpr int I_W1 = NEXP * 16 * 64, I_W2 = NEXP * 16 * 32, I_IN = 16 * 48, I_OUT = 16 * 32, I_UQ = 4 * 24, I_UKV = 4 * 32, I_AX = 32;
    constexpr int I_WR = 16 * 8;
    constexpr int NITEMS = I_W1 + I_W2 + I_IN + I_OUT + I_UQ + I_UKV + I_AX + I_WR;
    for (int it = gw; it < NITEMS; it += NGW) {
        int r = it;
        if (r < I_W1) { const int e = r >> 10, q = r & 1023, kb = q >> 6, ng = q & 63; const int pn = ng >> 3, bj = (ng >> 2) & 1, c32 = ng & 3;
            transpose_item_fp8(F.w1 + (size_t)e * 1024 * 2048, 2048, bj * 1024 + 128 * pn + 32 * c32, WSP(unsigned char, WS_W1) + (size_t)e * 2048 * 1024, 1024, ng * 32, kb * 64, scr, F.lane); continue; } r -= I_W1;
        if (r < I_W2) { const int e = r >> 9, q = r & 511, kb = q >> 5, ng = q & 31;
            transpose_item_fp8(F.w2 + (size_t)e * 1024 * 1024, 1024, ng * 32, WSP(unsigned char, WS_W2) + (size_t)e * 1024 * 1024, 1024, ng * 32, kb * 64, scr, F.lane); continue; } r -= I_W2;
        if (r < I_IN) { const int kb = r / 48, ng = r % 48;
            transpose_item(F.w_in, DIN, 1024, ng < 45 ? ng * 32 : -1, nullptr, WSP(bf16, WS_WIN), 1024, ng * 32, kb * 64, scr, F.lane); continue; } r -= I_IN;
        if (r < I_OUT) { const int kb = r >> 5, ng = r & 31;
            transpose_item(F.w_out, 1024, 1024, ng * 32, nullptr, WSP(bf16, WS_WOUT), 1024, ng * 32, kb * 64, scr, F.lane); continue; } r -= I_OUT;
        if (r < I_UQ) { const int kb = r / 24, ng = r % 24;
            transpose_item(F.w_uq, 768, 256, ng * 32, F.g_q_lat, WSP(bf16, WS_WUQ), 256, ng * 32, kb * 64, scr, F.lane); continue; } r -= I_UQ;
        if (r < I_UKV) { const int kb = r >> 5, ng = r & 31; const int pn = ng >> 3, bj = (ng >> 2) & 1, wc = ng & 3; const int head = 2 * pn + (wc & 1);
            transpose_item(F.w_ukv, 1024, 128, head * 128 + (wc < 2 ? 0 : 64) + 32 * bj, F.g_kv_lat, WSP(bf16, WS_WUKV), 256, ng * 32, kb * 64, scr, F.lane); continue; } r -= I_UKV;
        if (r >= I_AX) { r -= I_AX; const int kb = r >> 3, ng = r & 7;
            transpose_item(F.w_router, NEXP, 1024, ng == 0 ? 0 : -1, nullptr, WSP(bf16, WS_WR), 1024, ng * 32, kb * 64, scr, F.lane); continue; }
        { const int g = r >> 4, n = (r >> 1) & 7, ng = r & 1;
            transpose_item((g ? F.w_x : F.w_a) + (size_t)n * 64 * 64, 64, 64, ng * 32, nullptr, WSP(bf16, WS_WAX) + (size_t)(g * 8 + n) * 64 * 64, 64, ng * 32, 0, scr, F.lane, -1.4426950408889634f); }
    }
    const GAS float* mod = WSG(float, WS_MOD); GAS bf16* H = WSG(bf16, WS_H); const GAS float* X = GG(float, F.x); const GAS float* gm = GG(float, F.g_mix);
    for (int m0 = gw * 2; m0 < T; m0 += NGW * 2) {
        const int b = m0 / SEQ;
        f32x4 v[2][4]; float s[2] = {0.f, 0.f};
#pragma unroll
        for (int r = 0; r < 2; ++r)
#pragma unroll
            for (int j = 0; j < 4; ++j) v[r][j] = __builtin_nontemporal_load((const GAS f32x4*)(X + (size_t)(m0 + r) * DM) + F.lane + 64 * j);
#pragma unroll
        for (int r = 0; r < 2; ++r) {
#pragma unroll
            for (int j = 0; j < 4; ++j) s[r] += (v[r][j][0] * v[r][j][0] + v[r][j][1] * v[r][j][1]) + (v[r][j][2] * v[r][j][2] + v[r][j][3] * v[r][j][3]);
            const float rstd = 1.0f / sqrtf(wave_sum(s[r]) * (1.0f / DM) + EPS);
            GAS u32x2* o8 = (GAS u32x2*)(H + (size_t)(m0 + r) * DM) + F.lane;
#pragma unroll
            for (int j = 0; j < 4; ++j) { const int col = 256 * j + 4 * F.lane;
                const f32x4 g = *(const GAS f32x4*)(gm + col), sh = *(const GAS f32x4*)(mod + (size_t)b * 6144 + col), scl = *(const GAS f32x4*)(mod + (size_t)b * 6144 + 1024 + col);
                const f32x4 o = v[r][j] * rstd * g * (scl + 1.0f) + sh;
                u32x2 w; w.x = pk2(o[0], o[1]); w.y = pk2(o[2], o[3]); o8[64 * j] = w; } }
    }
}

constexpr int LRU_XROW = 144, LRU_WL = 15616;
template <bool PASS2>
__device__ __forceinline__ void lru_pass(Frame& F) {
    const int lane = F.lane, n = F.wave, r32 = lane & 31, hi = lane >> 5;
    LAS unsigned char* wl = F.lds + n * LRU_WL; LAS unsigned char* xs = wl; LAS unsigned char* xcs = wl + 5120; LAS float* cw = (LAS float*)(wl + 5120 + 4608); LAS unsigned char* ys = wl + 5120 + 4608 + 1280;
#pragma unroll
    for (int j = 0; j < 4; ++j) cw[j * 64 + lane] = F.conv_w[j * DLRU + 64 * n + lane];
    cw[256 + lane] = F.conv_b[64 * n + lane];
    const GAS bf16* Wt = WSG(bf16, WS_WAX);
    float ba[2], bx[2], sp8[2];
#pragma unroll
    for (int oc = 0; oc < 2; ++oc) { const int ch = 64 * n + 32 * oc + r32; ba[oc] = -1.4426950408889634f * F.b_a[ch]; bx[oc] = -1.4426950408889634f * F.b_x[ch]; sp8[oc] = -8.0f * 1.4426950408889634f * log1pf(expf(-F.lam[ch])); }
    const GAS bf16* Z = WSG(bf16, WS_Z); GAS float* agg = WSG(float, WS_AGG); GAS bf16* MIX = WSG(bf16, WS_MIX);
    const int gw = F.vcu * 8 + F.wave, NGW = F.G * 8;
    for (int pidx = gw >> 3; pidx < NB * 32; pidx += (NGW >> 3)) {
        const int b = pidx >> 5, ttp = pidx & 31; const size_t rowb = (size_t)b * SEQ;
        float c[2] = {0.f, 0.f};
        if constexpr (PASS2) {
            for (int tp0 = 0; tp0 < 2 * ttp; tp0 += 8) {
                f32x2 ah[8][2];
#pragma unroll
                for (int j = 0; j < 8; ++j) { const int tp = (tp0 + j < 2 * ttp) ? tp0 + j : 2 * ttp - 1;
#pragma unroll
                    for (int oc = 0; oc < 2; ++oc) ah[j][oc] = *(const GAS f32x2*)(agg + ((size_t)((b * 64 + tp) * DLRU) + 64 * n + 32 * oc + r32) * 2); }
#pragma unroll
                for (int j = 0; j < 8; ++j) { const bool ok = tp0 + j < 2 * ttp;
#pragma unroll
                    for (int oc = 0; oc < 2; ++oc) c[oc] = ok ? ah[j][oc].x * c[oc] + ah[j][oc].y : c[oc]; } }
        }
#pragma unroll 1
        for (int u2 = 0; u2 < 2; ++u2) {
            const int tt = 2 * ttp + u2, t0 = tt * 64;
            float aprod[2] = {1.f, 1.f};
            if constexpr (!PASS2) { c[0] = 0.f; c[1] = 0.f; }
#pragma unroll 1
            for (int tt2 = 0; tt2 < 2; ++tt2) {
                const int tb = t0 + 32 * tt2;
#pragma unroll
                for (int i = 0; i < 5; ++i) { const int row = i * 8 + (lane >> 3), ch = lane & 7; const int t = tb - 3 + row;
                    if (row < 35) { u32x4 v = (u32x4){0u, 0u, 0u, 0u}; if (t >= 0) v = *(const GAS u32x4*)(Z + (rowb + t) * DINP + 64 * n + ch * 8);
                        *(LAS u32x4*)(xs + row * LRU_XROW + ch * 16) = v; } }
                if constexpr (PASS2) {
#pragma unroll
                    for (int i = 0; i < 4; ++i) { const int row = i * 8 + (lane >> 3), ch = lane & 7;
                        *(LAS u32x4*)(ys + row * LRU_XROW + ch * 16) = *(const GAS u32x4*)(Z + (rowb + tb + row) * DINP + DLRU + 64 * n + ch * 8); }
                }
                bf16x8 af[4];
#pragma unroll
                for (int ks = 0; ks < 4; ++ks) { const int c0 = 16 * ks + 8 * hi;
                    float xc[8];
                    { const f32x4 b0 = *(const LAS f32x4*)(cw + 256 + c0), b1 = *(const LAS f32x4*)(cw + 256 + c0 + 4);
#pragma unroll
                      for (int q = 0; q < 4; ++q) { xc[q] = b0[q]; xc[4 + q] = b1[q]; } }
#pragma unroll
                    for (int j = 0; j < 4; ++j) { const u32x4 xv = *(const LAS u32x4*)(xs + (r32 + j) * LRU_XROW + c0 * 2);
                        const f32x4 w0 = *(const LAS f32x4*)(cw + j * 64 + c0), w1 = *(const LAS f32x4*)(cw + j * 64 + c0 + 4);
                        xc[0] += w0[0] * bflo(xv.x); xc[1] += w0[1] * bfhi(xv.x); xc[2] += w0[2] * bflo(xv.y); xc[3] += w0[3] * bfhi(xv.y);
                        xc[4] += w1[0] * bflo(xv.z); xc[5] += w1[1] * bfhi(xv.z); xc[6] += w1[2] * bflo(xv.w); xc[7] += w1[3] * bfhi(xv.w); }
                    u32x4 pk; pk.x = pk2(xc[0], xc[1]); pk.y = pk2(xc[2], xc[3]); pk.z = pk2(xc[4], xc[5]); pk.w = pk2(xc[6], xc[7]);
                    af[ks] = __builtin_bit_cast(bf16x8, pk);
                    *(LAS u32x4*)(xcs + r32 * LRU_XROW + c0 * 2) = pk; }
#pragma unroll
                for (int oc = 0; oc < 2; ++oc) {
                    asm volatile("" ::: "memory");
                    f32x16 da = {}, dx = {};
#pragma unroll
                    for (int ks = 0; ks < 4; ++ks) {
                        const bf16x8 wa = *(const GAS bf16x8*)(Wt + ((size_t)((0 * 8 + n) * 64 + 32 * oc + r32) * 64 + 16 * ks + 8 * hi)), wx = *(const GAS bf16x8*)(Wt + ((size_t)((1 * 8 + n) * 64 + 32 * oc + r32) * 64 + 16 * ks + 8 * hi));
                        da = __builtin_amdgcn_mfma_f32_32x32x16_bf16(af[ks], wa, da, 0, 0, 0); dx = __builtin_amdgcn_mfma_f32_32x32x16_bf16(af[ks], wx, dx, 0, 0, 0); }
                    float av[16], uv[16];
#pragma unroll
                    for (int r = 0; r < 16; ++r) { const int tl = crow(r, hi); const float xcv = bf2f(*(const LAS unsigned short*)(xcs + tl * LRU_XROW + (32 * oc + r32) * 2));
                        const float rg = __builtin_amdgcn_rcpf(1.0f + __builtin_amdgcn_exp2f(da[r] + ba[oc])), ig = __builtin_amdgcn_rcpf(1.0f + __builtin_amdgcn_exp2f(dx[r] + bx[oc])); const float a = __builtin_amdgcn_exp2f(rg * sp8[oc]);
                        av[r] = a; uv[r] = __builtin_amdgcn_sqrtf(fmaxf(1.0f - a * a, 0.f)) * ig * xcv; }
                    float As[4], Hs[4], cin[4];
#pragma unroll
                    for (int g = 0; g < 4; ++g) { float h = uv[4 * g]; float ap = av[4 * g];
#pragma unroll
                        for (int q = 1; q < 4; ++q) { h = av[4 * g + q] * h + uv[4 * g + q]; ap *= av[4 * g + q]; }
                        As[g] = ap; Hs[g] = h; }
                    float crun = c[oc];
#pragma unroll
                    for (int g = 0; g < 4; ++g) { const float o0 = As[g] * crun + Hs[g]; const float mid = __shfl_xor(o0, 32); const float ci = hi ? mid : crun; const float o1 = As[g] * ci + Hs[g];
                        const float fin = __shfl_xor(o1, 32); crun = hi ? o1 : fin; cin[g] = ci; }
                    c[oc] = crun;
                    if constexpr (!PASS2) { aprod[oc] *= (As[0] * As[1]) * (As[2] * As[3]); }
                    else {
#pragma unroll
                        for (int g = 0; g < 4; ++g) { float h = cin[g];
#pragma unroll
                            for (int q = 0; q < 4; ++q) { const int r = 4 * g + q; h = av[r] * h + uv[r];
                                LAS unsigned short* yp = (LAS unsigned short*)(ys + crow(r, hi) * LRU_XROW + (32 * oc + r32) * 2);
                                const float y = bf2f(*yp); const float ge = y * __builtin_amdgcn_rcpf(1.0f + __builtin_amdgcn_exp2f(y * (-2.3022082f + -0.1029432f * (y * y))));
                                *yp = (unsigned short)f2bf(ge * h); } }
                    }
                }
                if constexpr (PASS2) {
#pragma unroll
                    for (int i = 0; i < 4; ++i) { const int row = i * 8 + (lane >> 3), ch = lane & 7;
                        *(GAS u32x4*)(MIX + (rowb + tb + row) * DM + 64 * n + ch * 8) = *(const LAS u32x4*)(ys + row * LRU_XROW + ch * 16); }
                }
            }
            if constexpr (!PASS2) {
#pragma unroll
                for (int oc = 0; oc < 2; ++oc) { const float at = aprod[oc] * __shfl_xor(aprod[oc], 32);
                    if (hi == 0) *(GAS f32x2*)(agg + ((size_t)((b * 64 + tt) * DLRU) + 64 * n + 32 * oc + r32) * 2) = (f32x2){at, c[oc]}; }
            }
        }
    }
}

namespace att {
constexpr int KROW = 208, KTB = 64 * KROW, VROW = 192, VTB = 64 * VROW;
constexpr int OFF_K = 0, OFF_V = 2 * KTB, OFF_Q = 2 * KTB + 3 * VTB;
typedef short s16x4 __attribute__((ext_vector_type(4)));
__device__ __forceinline__ s16x4 vtr(const LAS unsigned char* p) { return __builtin_bit_cast(s16x4, __builtin_amdgcn_ds_read_tr16_b64_v4i16((LAS s16x4*)p)); }
__device__ __forceinline__ void unit(Frame& F, int b, int h, int qb, float MB) {
    const int tid = F.tid, lane = F.lane, w = F.wave, r32 = lane & 31, hi = lane >> 5;
    const GAS bf16* Qb = WSG(bf16, WS_Q); const GAS bf16* Kb = WSG(bf16, WS_K); const GAS bf16* Vb = WSG(bf16, WS_V); GAS bf16* MIX = WSG(bf16, WS_MIX);
    const GAS float* ct = WSG(float, WS_COS); const GAS float* st = WSG(float, WS_SIN); const GAS float* gqn = GG(float, F.g_qn);
    const size_t rowb = (size_t)b * SEQ; const int qrow = qb * 256 + w * 32 + r32; const size_t gr = rowb + qrow;
    bf16x8 qr[6];
    {
        float qf[6][8]; float ss = 0.f;
#pragma unroll
        for (int ks = 0; ks < 6; ++ks) { const u32x4 v = *(const GAS u32x4*)(Qb + gr * 768 + h * QKH + 16 * ks + 8 * hi);
            qf[ks][0] = bflo(v.x); qf[ks][1] = bfhi(v.x); qf[ks][2] = bflo(v.y); qf[ks][3] = bfhi(v.y); qf[ks][4] = bflo(v.z); qf[ks][5] = bfhi(v.z); qf[ks][6] = bflo(v.w); qf[ks][7] = bfhi(v.w);
#pragma unroll
            for (int j = 0; j < 8; ++j) ss += qf[ks][j] * qf[ks][j]; }
        ss += __shfl_xor(ss, 32);
        const float rs = __builtin_amdgcn_rsqf(ss * (1.0f / QKH) + EPS);
#pragma unroll
        for (int ks = 0; ks < 6; ++ks)
#pragma unroll
            for (int j = 0; j < 8; ++j) qf[ks][j] *= rs * gqn[16 * ks + 8 * hi + j];
#pragma unroll
        for (int j = 0; j < 8; ++j) { const float cs = ct[gr * 16 + 8 * hi + j], sn = st[gr * 16 + 8 * hi + j]; const float a = qf[4][j], bb = qf[5][j]; qf[4][j] = a * cs - bb * sn; qf[5][j] = bb * cs + a * sn; }
        const float sc = 0.10206207261596575f * 1.4426950408889634f;
#pragma unroll
        for (int ks = 0; ks < 6; ++ks) { u32x4 pk; pk.x = pk2(qf[ks][0] * sc, qf[ks][1] * sc); pk.y = pk2(qf[ks][2] * sc, qf[ks][3] * sc); pk.z = pk2(qf[ks][4] * sc, qf[ks][5] * sc); pk.w = pk2(qf[ks][6] * sc, qf[ks][7] * sc);
            qr[ks] = __builtin_bit_cast(bf16x8, pk); }
    }
    LAS unsigned char* qlds = F.lds + OFF_Q + w * 6144 + hi * 512 + r32 * 16;
#pragma unroll
    for (int ks = 0; ks < 6; ++ks) *(LAS bf16x8*)(qlds + ks * 1024) = qr[ks];
    const int NT = 4 * (qb + 1);
    const int kr1 = tid / 12, kc1 = tid % 12, kr2 = (512 + tid) / 12, kc2 = (512 + tid) % 12; const bool k2 = tid < 256;
    const int vr = tid >> 3, vc = tid & 7;
    const GAS char* kbase = (const GAS char*)(Kb + rowb * 768 + h * QKH); const GAS char* vbase_g = (const GAS char*)(Vb + rowb * 512 + h * VH);
    const unsigned ko1 = (unsigned)(kr1 * 768 + kc1 * 8) * 2u, ko2 = (unsigned)(kr2 * 768 + kc2 * 8) * 2u, vo1 = (unsigned)(vr * 512 + vc * 8) * 2u;
    LAS unsigned char* L = F.lds;
    u32x4 skA1, skA2 = (u32x4){0u, 0u, 0u, 0u}, svA;
#define ATT_BAR() do { __builtin_amdgcn_sched_barrier(0); asm volatile("s_waitcnt lgkmcnt(0)" ::: "memory"); __builtin_amdgcn_s_barrier(); asm volatile("" ::: "memory"); __builtin_amdgcn_sched_barrier(0); } while (0)
#define ATT_LOADK(X, t) do { const GAS char* kt_ = kbase + (size_t)(t) * (64 * 768 * 2); sk##X##1 = *(const GAS u32x4*)(kt_ + ko1); if (k2) sk##X##2 = *(const GAS u32x4*)(kt_ + ko2); } while (0)
#define ATT_LOADV(X, t) do { sv##X = *(const GAS u32x4*)(vbase_g + (size_t)(t) * (64 * 512 * 2) + vo1); } while (0)
#define ATT_WRITEK(X, buf) do { *(LAS u32x4*)(L + OFF_K + (buf) * KTB + kr1 * KROW + kc1 * 16) = sk##X##1; if (k2) *(LAS u32x4*)(L + OFF_K + (buf) * KTB + kr2 * KROW + kc2 * 16) = sk##X##2; } while (0)
#define ATT_WRITEV(X, voff) do { *(LAS u32x4*)(L + OFF_V + (voff) + vr * VROW + vc * 16) = sv##X; } while (0)
#define ATT_QK(S0, S1, buf) do { const LAS unsigned char* kb_ = L + OFF_K + (buf) * KTB + r32 * KROW + hi * 16; \
        _Pragma("unroll") for (int ks = 0; ks < 6; ++ks) { const bf16x8 a0 = *(const LAS bf16x8*)(kb_ + ks * 32), a1 = *(const LAS bf16x8*)(kb_ + 32 * KROW + ks * 32); \
            const bf16x8 qv = *(const LAS bf16x8*)(qlds + ks * 1024); \
            if (ks == 0) { S0 = __builtin_amdgcn_mfma_f32_32x32x16_bf16(a0, qv, f32x16{}, 0, 0, 0); S1 = __builtin_amdgcn_mfma_f32_32x32x16_bf16(a1, qv, f32x16{}, 0, 0, 0); } \
            else { S0 = __builtin_amdgcn_mfma_f32_32x32x16_bf16(a0, qv, S0, 0, 0, 0); S1 = __builtin_amdgcn_mfma_f32_32x32x16_bf16(a1, qv, S1, 0, 0, 0); } } } while (0)
#define ATT_PV(voff) do { const LAS unsigned char* vb = vbase + (voff); \
        _Pragma("unroll") for (int s4 = 0; s4 < 4; ++s4) { const bf16x8 pfv = __builtin_bit_cast(bf16x8, pf[s4]); \
            _Pragma("unroll") for (int d = 0; d < 2; ++d) { const LAS unsigned char* vp = vb + (16 * s4) * VROW + (32 * d) * 2; \
                const s16x4 lo = vtr(vp), hh = vtr(vp + 8 * VROW); \
                const bf16x8 vv = __builtin_shufflevector(lo, hh, 0, 1, 2, 3, 4, 5, 6, 7); \
                o[d] = __builtin_amdgcn_mfma_f32_32x32x16_bf16(vv, pfv, o[d], 0, 0, 0); } } } while (0)
    const float sh = fmaxf(MB - 100.0f, 0.f);
    ATT_LOADK(A, 0); ATT_LOADV(A, 0); ATT_WRITEK(A, 0); ATT_WRITEV(A, 0);
    ATT_LOADK(A, 1); ATT_WRITEK(A, 1);
    for (int i = tid; i < VTB / 8; i += 512) *(LAS u32x2*)(L + OFF_V + 2 * VTB + i * 8) = (u32x2){0u, 0u};
    ATT_LOADK(A, 2); ATT_LOADV(A, 1);
    ATT_BAR();
    float lsum = 0.f; f32x16 o[2]; o[0] = f32x16{}; o[1] = f32x16{};
    const int wq_max = qb * 256 + w * 32 + 31;
    f32x16 pa0, pa1, pb0 = f32x16{}, pb1 = f32x16{};
    u32x4 pf[4]; pf[0] = pf[1] = pf[2] = pf[3] = (u32x4){0u, 0u, 0u, 0u};
    ATT_QK(pa0, pa1, 0);
    const LAS unsigned char* vbase = L + OFF_V + (4 * hi + ((lane & 15) >> 2)) * VROW + (16 * ((lane >> 4) & 1) + 4 * (lane & 3)) * 2;
    int vprev = 2 * VTB, vcur = 0, vnext = VTB;
#ifndef ATT_DUP
#define ATT_DUP 0
#endif
#ifndef ATT_HINT_MODE
#define ATT_HINT_MODE 3
#endif
#if ATT_HINT_MODE == 0
#define ATT_HINT(C) do {} while (0)
#elif ATT_HINT_MODE == 1
#define ATT_HINT(C) do { if (C) { _Pragma("unroll") for (int i_ = 0; i_ < 20; ++i_) { __builtin_amdgcn_sched_group_barrier(0x008, 1, 0); __builtin_amdgcn_sched_group_barrier(0x002, 5, 0); } } } while (0)
#elif ATT_HINT_MODE == 3
#define ATT_HINT(C) do { if (C) { __builtin_amdgcn_sched_group_barrier(0x100, 6, 0); \
        _Pragma("unroll") for (int i_ = 0; i_ < 6; ++i_) { __builtin_amdgcn_sched_group_barrier(0x008, 1, 0); __builtin_amdgcn_sched_group_barrier(0x002, 5, 0); __builtin_amdgcn_sched_group_barrier(0x008, 1, 0); __builtin_amdgcn_sched_group_barrier(0x100, 3, 0); __builtin_amdgcn_sched_group_barrier(0x002, 5, 0); } \
        _Pragma("unroll") for (int i_ = 0; i_ < 8; ++i_) { __builtin_amdgcn_sched_group_barrier(0x008, 1, 0); __builtin_amdgcn_sched_group_barrier(0x100, 2, 0); __builtin_amdgcn_sched_group_barrier(0x002, 6, 0); } } } while (0)
#elif ATT_HINT_MODE == 2
#define ATT_HINT(C) do { if (C) { __builtin_amdgcn_sched_group_barrier(0x100, 18, 0); \
        _Pragma("unroll") for (int i_ = 0; i_ < 12; ++i_) { __builtin_amdgcn_sched_group_barrier(0x008, 1, 0); if (i_ < 8) __builtin_amdgcn_sched_group_barrier(0x100, 2, 0); __builtin_amdgcn_sched_group_barrier(0x002, 4, 0); } \
        _Pragma("unroll") for (int i_ = 0; i_ < 8; ++i_) { __builtin_amdgcn_sched_group_barrier(0x008, 1, 0); __builtin_amdgcn_sched_group_barrier(0x002, 6, 0); } } } while (0)
#endif
#define ATT_STEP(t, P0, P1, N0, N1, CLEAN) do { const int buf = (t) & 1; \
        if (CLEAN || (((t) + 1 < NT) && (64 * ((t) + 1) <= wq_max))) ATT_QK(N0, N1, buf ^ 1); \
        if (CLEAN || (64 * ((t) - 1) <= wq_max)) ATT_PV(vprev); \
        if (CLEAN || (64 * (t) <= wq_max)) { \
            if (!CLEAN && (t) >= 4 * qb) { const int kv0 = 64 * (t) + 4 * hi; \
                _Pragma("unroll") for (int r = 0; r < 16; ++r) { const int kv = kv0 + (r & 3) + 8 * (r >> 2); if (kv > qrow) P0[r] = -1e30f; if (kv + 32 > qrow) P1[r] = -1e30f; } } \
            if (!CLEAN) { if (sh > 0.f) { _Pragma("unroll") for (int r = 0; r < 16; ++r) { P0[r] -= sh; P1[r] -= sh; } } } \
            f32x2 ps0 = {0.f, 0.f}, ps1 = {0.f, 0.f}, ps2 = {0.f, 0.f}, ps3 = {0.f, 0.f};     \
            _Pragma("unroll") for (int r = 0; r < 16; ++r) { P0[r] = __builtin_amdgcn_exp2f(P0[r]); P1[r] = __builtin_amdgcn_exp2f(P1[r]); } \
            _Pragma("unroll") for (int r = 0; r < 16; r += 4) { ps0 += (f32x2){P0[r], P0[r + 1]}; ps1 += (f32x2){P0[r + 2], P0[r + 3]}; ps2 += (f32x2){P1[r], P1[r + 1]}; ps3 += (f32x2){P1[r + 2], P1[r + 3]}; } \
            { const f32x2 pt = (ps0 + ps1) + (ps2 + ps3); lsum += pt.x + pt.y; } \
            _Pragma("unroll") for (int s = 0; s < 2; ++s) { \
                pf[s].x = cvt_pk_bf16(P0[8 * s + 0], P0[8 * s + 1]); pf[s].y = cvt_pk_bf16(P0[8 * s + 2], P0[8 * s + 3]); pf[s].z = cvt_pk_bf16(P0[8 * s + 4], P0[8 * s + 5]); pf[s].w = cvt_pk_bf16(P0[8 * s + 6], P0[8 * s + 7]); \
                pf[2 + s].x = cvt_pk_bf16(P1[8 * s + 0], P1[8 * s + 1]); pf[2 + s].y = cvt_pk_bf16(P1[8 * s + 2], P1[8 * s + 3]); pf[2 + s].z = cvt_pk_bf16(P1[8 * s + 4], P1[8 * s + 5]); pf[2 + s].w = cvt_pk_bf16(P1[8 * s + 6], P1[8 * s + 7]); } \
        } else { pf[0] = pf[1] = pf[2] = pf[3] = (u32x4){0u, 0u, 0u, 0u}; } \
        ATT_HINT(CLEAN); \
        ATT_WRITEK(A, buf); \
        ATT_WRITEV(A, vnext); \
        if (ATT_DUP && CLEAN) { asm volatile("" ::: "memory"); ATT_WRITEK(A, buf); ATT_WRITEV(A, vnext); asm volatile("" ::: "memory"); \
            ATT_LOADK(A, ((t) + 3 < NT) ? (t) + 3 : NT - 1); ATT_LOADV(A, ((t) + 2 < NT) ? (t) + 2 : NT - 1); asm volatile("" : "+v"(skA1), "+v"(skA2), "+v"(svA)); } \
        ATT_LOADK(A, ((t) + 3 < NT) ? (t) + 3 : NT - 1); \
        ATT_LOADV(A, ((t) + 2 < NT) ? (t) + 2 : NT - 1); \
        ATT_BAR(); \
        { const int tmp_ = vprev; vprev = vcur; vcur = vnext; vnext = tmp_; } } while (0)
    int t = 0;
    if (sh == 0.f) for (; t < 4 * qb; t += 2) { ATT_STEP(t, pa0, pa1, pb0, pb1, 1); ATT_STEP(t + 1, pb0, pb1, pa0, pa1, 1); }
    for (; t < NT; t += 2) { ATT_STEP(t, pa0, pa1, pb0, pb1, 0); ATT_STEP(t + 1, pb0, pb1, pa0, pa1, 0); }
    if (64 * (NT - 1) <= wq_max) ATT_PV(vprev);
    ATT_BAR();
#undef ATT_STEP
#undef ATT_HINT
#undef ATT_BAR
#undef ATT_PV
#undef ATT_LOADK
#undef ATT_LOADV
#undef ATT_WRITEK
#undef ATT_WRITEV
#undef ATT_QK
    lsum += __shfl_xor(lsum, 32);
    const float inv = 1.0f / lsum;
    GAS bf16* op = MIX + gr * DM + DLRU + h * VH;
#pragma unroll
    for (int d = 0; d < 2; ++d)
#pragma unroll
        for (int g = 0; g < 4; ++g) { u32x2 wv; wv.x = cvt_pk_bf16(o[d][4 * g] * inv, o[d][4 * g + 1] * inv); wv.y = cvt_pk_bf16(o[d][4 * g + 2] * inv, o[d][4 * g + 3] * inv);
            *(GAS u32x2*)(op + 32 * d + 8 * g + 4 * hi) = wv; }
}
__device__ __forceinline__ void phase(Frame& F) {
    float gq = 0.f, gk = 0.f;
    for (int i = 0; i < QKH; ++i) { gq = fmaxf(gq, fabsf(F.g_qn[i])); gk = fmaxf(gk, fabsf(F.g_kn[i])); }
    const float MB = 9.797958971f * 1.4426950408889634f * gq * gk * 1.02f;
    for (int pi = F.vcu; pi < 512; pi += F.G) {
        const int bh = pi >> 3, s = pi & 7;
        unit(F, bh >> 3, bh & 7, 15 - s, MB);
        unit(F, bh >> 3, bh & 7, s, MB);
    }
}
}

__device__ __forceinline__ void p6a_norm(Frame& F) {
    const GAS float* mod = WSG(float, WS_MOD); GAS unsigned char* H2 = WSG(unsigned char, WS_H2); GAS bf16* H2B = WSG(bf16, WS_H2B);
    const GAS float* gf = GG(float, F.g_ffn); const GAS bf16* X1 = WSG(bf16, WS_X1B);
    const int gw = F.vcu * 8 + F.wave, NGW = F.G * 8, lane = F.lane;
    for (int m0 = gw * 2; m0 < T; m0 += NGW * 2) {
        const int b = m0 / SEQ;
        u32x4 xr[2][2];
#pragma unroll
        for (int r = 0; r < 2; ++r)
#pragma unroll
            for (int h = 0; h < 2; ++h) xr[r][h] = *(const GAS u32x4*)(X1 + (size_t)(m0 + r) * DM + 16 * lane + 8 * h);
        f32x4 G[4], S[4];
#pragma unroll
        for (int q = 0; q < 4; ++q) { const int col = 16 * lane + 4 * q; const f32x4 g = *(const GAS f32x4*)(gf + col), sc = *(const GAS f32x4*)(mod + (size_t)b * 6144 + 4096 + col);
            G[q] = g * (sc + 1.0f); S[q] = *(const GAS f32x4*)(mod + (size_t)b * 6144 + 3072 + col); }
#pragma unroll
        for (int r = 0; r < 2; ++r) { f32x4 v[4];
#pragma unroll
            for (int h = 0; h < 2; ++h) { v[2 * h] = (f32x4){bflo(xr[r][h].x), bfhi(xr[r][h].x), bflo(xr[r][h].y), bfhi(xr[r][h].y)}; v[2 * h + 1] = (f32x4){bflo(xr[r][h].z), bfhi(xr[r][h].z), bflo(xr[r][h].w), bfhi(xr[r][h].w)}; }
            float s = 0.f;
#pragma unroll
            for (int q = 0; q < 4; ++q) s += (v[q][0] * v[q][0] + v[q][1] * v[q][1]) + (v[q][2] * v[q][2] + v[q][3] * v[q][3]);
            const float rstd = 1.0f / sqrtf(wave_sum(s) * (1.0f / DM) + EPS);
            u32x4 o8, ob[2];
#pragma unroll
            for (int q = 0; q < 4; ++q) { const f32x4 hv = v[q] * rstd * G[q] + S[q];
                o8[q] = pk4_fp8(hv[0], hv[1], hv[2], hv[3]);
                ob[q >> 1][2 * (q & 1)] = cvt_pk_bf16(hv[0], hv[1]); ob[q >> 1][2 * (q & 1) + 1] = cvt_pk_bf16(hv[2], hv[3]); }
            *(GAS u32x4*)(H2 + (size_t)(m0 + r) * DM + 16 * lane) = o8;
            *(GAS u32x4*)(H2B + (size_t)(m0 + r) * DM + 16 * lane) = ob[0]; *(GAS u32x4*)(H2B + (size_t)(m0 + r) * DM + 16 * lane + 8) = ob[1]; }
    }
}
__device__ __forceinline__ void p6c_topk(Frame& F) {
    LAS int* hist = (LAS int*)(F.lds + TAB_OFF); LAS int* base = hist + 32;
    const GAS float* logit = WSG(float, WS_LOGIT); GAS int* list = WSG(int, WS_LIST); GAS float* gates = WSG(float, WS_GATES);
    unsigned* gcount = F.ctl + CW_CNT;
    for (int chunk = blockIdx.x; chunk < T / 128; chunk += F.G) {
        if (F.tid < 32) hist[F.tid] = 0;
        __syncthreads();
        const int row = chunk * 128 + F.tid; const bool act = F.tid < 128;
        int se[4] = {0, 0, 0, 0}, lp[4] = {0, 0, 0, 0}; float gk[4] = {0.f, 0.f, 0.f, 0.f};
        if (act) {
            float v[32];
#pragma unroll
            for (int q = 0; q < 8; ++q) { const f32x4 t = *(const GAS f32x4*)(logit + (size_t)row * NEXP + 4 * q); v[4 * q] = t[0]; v[4 * q + 1] = t[1]; v[4 * q + 2] = t[2]; v[4 * q + 3] = t[3]; }
            float sv[4];
#pragma unroll
            for (int k = 0; k < 4; ++k) { float best = v[0]; int bi = 0;
#pragma unroll
                for (int e = 1; e < 32; ++e) { const bool gt = v[e] > best; best = gt ? v[e] : best; bi = gt ? e : bi; }
                sv[k] = best; se[k] = bi;
#pragma unroll
                for (int e = 0; e < 32; ++e) v[e] = (e == bi) ? -3.0e38f : v[e]; }
            const float t1 = fast_exp(sv[1] - sv[0]), t2 = fast_exp(sv[2] - sv[0]), t3 = fast_exp(sv[3] - sv[0]); const float rinv = 1.0f / (1.0f + t1 + t2 + t3);
            gk[0] = rinv; gk[1] = t1 * rinv; gk[2] = t2 * rinv; gk[3] = t3 * rinv;
#pragma unroll
            for (int k = 0; k < 4; ++k) lp[k] = __hip_atomic_fetch_add(hist + se[k], 1, __ATOMIC_RELAXED, __HIP_MEMORY_SCOPE_WORKGROUP);
        }
        __syncthreads();
        if (F.tid < 32) base[F.tid] = (int)__hip_atomic_fetch_add(gcount + F.tid, (unsigned)hist[F.tid], RLX_AGENT);
        __syncthreads();
        if (act) {
#pragma unroll
            for (int k = 0; k < 4; ++k) { const int ent = row * 4 + k; list[(size_t)se[k] * T + base[se[k]] + lp[k]] = ent; gates[ent] = gk[k]; }
        }
        __syncthreads();
    }
}

__device__ __forceinline__ void moe_tables(Frame& F) {
    LAS int* tab = (LAS int*)(F.lds + TAB_OFF);
    if (F.tid == 0) { int acc = 0;
        for (int e = 0; e < NEXP; ++e) { const int c = (int)__hip_atomic_load(F.ctl + CW_CNT + e, RLX_AGENT); tab[e] = acc; tab[33 + e] = c; acc += (c + 255) >> 8; }
        tab[32] = acc; }
    __syncthreads();
}

__device__ __forceinline__ void p9_combine(Frame& F) {
    const GAS float* mod = WSG(float, WS_MOD); const GAS unsigned char* Y4 = WSG(unsigned char, WS_Y4); GAS float* O = (GAS float*)F.out; const GAS bf16* X1 = WSG(bf16, WS_X1B);
    const int gw = F.vcu * 8 + F.wave, NGW = F.G * 8, lane = F.lane;
    for (int m0 = gw * 2; m0 < T; m0 += NGW * 2) {
        const int b = m0 / SEQ;
        u32x4 y[2][4], xr[2][2];
#pragma unroll
        for (int r = 0; r < 2; ++r) {
#pragma unroll
            for (int k = 0; k < 4; ++k) y[r][k] = *(const GAS u32x4*)(Y4 + ((size_t)(m0 + r) * 4 + k) * DM + 16 * lane);
#pragma unroll
            for (int h = 0; h < 2; ++h) xr[r][h] = *(const GAS u32x4*)(X1 + (size_t)(m0 + r) * DM + 16 * lane + 8 * h); }
        f32x4 g2[4];
#pragma unroll
        for (int q = 0; q < 4; ++q) g2[q] = *(const GAS f32x4*)(mod + (size_t)b * 6144 + 5120 + 16 * lane + 4 * q) * 0.0625f;
#pragma unroll
        for (int r = 0; r < 2; ++r)
#pragma unroll
            for (int q = 0; q < 4; ++q) { f32x4 s = (f32x4){0.f, 0.f, 0.f, 0.f};
#pragma unroll
                for (int k = 0; k < 4; ++k) { const int w = (int)y[r][k][q]; const f32x2 lo = __builtin_amdgcn_cvt_pk_f32_fp8(w, false), hi2 = __builtin_amdgcn_cvt_pk_f32_fp8(w, true); s[0] += lo[0]; s[1] += lo[1]; s[2] += hi2[0]; s[3] += hi2[1]; }
                const unsigned w0 = xr[r][q >> 1][2 * (q & 1)], w1 = xr[r][q >> 1][2 * (q & 1) + 1];
                const f32x4 xv = (f32x4){bflo(w0), bfhi(w0), bflo(w1), bfhi(w1)};
                *(GAS f32x4*)(O + (size_t)(m0 + r) * DM + 16 * lane + 4 * q) = xv + g2[q] * s; }
    }
}

struct Args { const void* in[28]; float* out; unsigned char* ws; int ph_lo, ph_hi; };
__global__ void __launch_bounds__(512, 2) mega_fwd(Args args) {
    extern __shared__ __attribute__((aligned(16))) unsigned char lds_raw[];
    Frame F;
    F.lds = (LAS unsigned char*)lds_raw;
    F.wave = __builtin_amdgcn_readfirstlane((int)threadIdx.x >> 6); F.lane = lane_id(); F.tid = F.wave * 64 + F.lane;
    F.G = gridDim.x; { const int bx = blockIdx.x; F.vcu = (F.G % 8 == 0) ? (bx % 8) * (F.G / 8) + bx / 8 : bx; }
    F.x = F.c = F.w_ada = F.b_ada = F.g_mix = F.w_in = F.conv_w = F.conv_b = F.w_a = F.b_a = F.w_x = F.b_x = F.lam = F.g_q_lat = F.w_uq = F.g_kv_lat = F.w_ukv = F.g_qn = F.g_kn = F.w_out = F.g_ffn = F.w_router = F.b_router = F.w1 = F.b1 = F.w2 = F.b2 = nullptr; F.pos = nullptr;
#define LDIN(field, idx) F.field = (decltype(F.field))(GAS void*)args.in[idx]
#define PH_BEGIN() do { unsigned char* w_ = args.ws; asm volatile("" : "+s"(w_)); F.ws = (unsigned char*)(GAS unsigned char*)w_; F.ctl = (unsigned*)(F.ws + WS_CTL); F.lane = lane_id(); F.tid = F.wave * 64 + F.lane; } while (0)
    F.out = (float*)(GAS float*)args.out; F.ws = (unsigned char*)(GAS unsigned char*)args.ws; F.ctl = (unsigned*)(F.ws + WS_CTL);
    for (int u = F.tid; u < (LDS_BYTES - LDSCTL_OFF) / 4; u += 512) ((LAS unsigned*)(F.lds + LDSCTL_OFF))[u] = 0u;
    __syncthreads();
    const int lo = args.ph_lo, hi = args.ph_hi;
    const bool multi = (hi - lo) > 1;
    XcdBarrier bar; bar.bar = F.ctl + CW_BAR; bar.x = 0; bar.st = nullptr;
    if (multi) bar = xcd_barrier_post(F.ctl + CW_BAR, (volatile LAS unsigned*)(F.lds + MISC_OFF), F.tid == 0);
#ifndef PH_MASK
#define PH_MASK 0xfff
#endif
#define IN(k) ((((PH_MASK) >> (k)) & 1) && lo <= (k) && (k) < hi)
#define LEADER() (F.wave == 0 && lane_id() == 0)
#define SEAM(k) do { if (IN(k) && IN((k) + 1)) xcd_barrier(bar, LEADER()); } while (0)

    if (IN(0)) { PH_BEGIN(); LDIN(c, 1); LDIN(pos, 2); LDIN(w_ada, 3); LDIN(b_ada, 4); p0_mod_rope(F); SEAM(0); }
    if (IN(1)) { PH_BEGIN(); LDIN(x, 0); LDIN(g_mix, 5); LDIN(w_in, 6); LDIN(w_router, 22); LDIN(w_a, 9); LDIN(w_x, 11); LDIN(g_q_lat, 14); LDIN(w_uq, 15); LDIN(g_kv_lat, 16); LDIN(w_ukv, 17); LDIN(w_out, 20); LDIN(w1, 24); LDIN(w2, 26);
        p1_convert_norm(F); SEAM(1); }
    if (IN(2)) { PH_BEGIN();
        pg8::DenseSched S; S.init(WSG(bf16, WS_H), DM, WSG(bf16, WS_WIN), DM, T, DINP, F.G, (int)blockIdx.x);
        pg8::EpiZ E{WSG(bf16, WS_Z), WSG(float, WS_SSQ)};
        pg8::gemm_phase<pg8::EpiZ, pg8::DenseSched, true>(F.lds, DM * 2, S, E, F.wave);
        SEAM(2);
    }
    if (IN(3)) { PH_BEGIN();
        LDIN(conv_w, 7); LDIN(conv_b, 8); LDIN(b_a, 10); LDIN(b_x, 12); LDIN(lam, 13); LDIN(g_kn, 19);
#ifndef P3_PARTS
#define P3_PARTS 7
#endif
        if (P3_PARTS & 1) { pg8::DenseSched S; S.init(WSG(bf16, WS_Z) + 1024, DINP, WSG(bf16, WS_WUQ), 256, T, 768, F.G, (int)blockIdx.x);
          pg8::EpiQ E{WSG(bf16, WS_Q), WSG(float, WS_SSQ)};
          pg8::gemm_phase<pg8::EpiQ, pg8::DenseSched, true>(F.lds, 512, S, E, F.wave); }
        if (P3_PARTS & 2) { pg8::DenseSched S; S.init(WSG(bf16, WS_Z) + 1280, DINP, WSG(bf16, WS_WUKV), 256, T, 1024, F.G, (int)blockIdx.x);
          pg8::EpiKV E{WSG(bf16, WS_K), WSG(bf16, WS_V), WSG(bf16, WS_Z), WSG(float, WS_SSQ), GG(float, F.g_kn), WSG(float, WS_COS), WSG(float, WS_SIN)};
          pg8::gemm_phase<pg8::EpiKV, pg8::DenseSched, true>(F.lds, 512, S, E, F.wave); }
#ifndef P3_LRU_REP
#define P3_LRU_REP 1
#endif
        if (P3_PARTS & 4) for (int rr_ = 0; rr_ < P3_LRU_REP; ++rr_) lru_pass<false>(F);
        SEAM(3);
    }
    if (IN(4)) { PH_BEGIN();
        LDIN(conv_w, 7); LDIN(conv_b, 8); LDIN(b_a, 10); LDIN(b_x, 12); LDIN(lam, 13); LDIN(g_qn, 18); LDIN(g_kn, 19);
#ifndef P4_PARTS
#define P4_PARTS 3
#endif
#ifndef P4_LRU_REP
#define P4_LRU_REP 1
#endif
        if (P4_PARTS & 1) for (int rr_ = 0; rr_ < P4_LRU_REP; ++rr_) lru_pass<true>(F);
        __syncthreads();
        if (P4_PARTS & 2) att::phase(F);
        SEAM(4);
    }
    if (IN(5)) { PH_BEGIN();
        LDIN(x, 0);
        pg8::DenseSched S; S.init(WSG(bf16, WS_MIX), DM, WSG(bf16, WS_WOUT), DM, T, DM, F.G, (int)blockIdx.x);
        pg8::EpiX1 E{GG(float, F.x), WSG(bf16, WS_X1B), WSG(float, WS_MOD) + 2048};
        pg8::gemm_phase<pg8::EpiX1, pg8::DenseSched, true>(F.lds, DM * 2, S, E, F.wave);
        SEAM(5);
    }
    if (IN(6)) { PH_BEGIN(); LDIN(g_ffn, 21); p6a_norm(F); SEAM(6); }
    if (IN(7)) { PH_BEGIN(); LDIN(b_router, 23);
        pg8::DenseSched S; S.init(WSG(bf16, WS_H2B), DM, WSG(bf16, WS_WR), DM, T, 256, F.G, (int)blockIdx.x);
        pg8::EpiLogit E{WSG(float, WS_LOGIT), GG(float, F.b_router)};
        pg8::gemm_phase<pg8::EpiLogit, pg8::DenseSched, true>(F.lds, DM * 2, S, E, F.wave);
        SEAM(7); }
    if (IN(8)) { PH_BEGIN(); p6c_topk(F); SEAM(8); }
    if (IN(9)) { PH_BEGIN();
        LDIN(b1, 25);
        moe_tables(F);
        pg8::MoeSched<8, true> S{(const LAS int*)(F.lds + TAB_OFF), WSG(int, WS_LIST), WSG(unsigned char, WS_H2), WSG(unsigned char, WS_W1), F.G, F.vcu, (size_t)2048 * 1024, nullptr, nullptr};
        pg8::EpiAct E{WSG(unsigned char, WS_ACT), GG(float, F.b1)};
        pg8::gemm_phase<pg8::EpiAct, pg8::MoeSched<8, true>, true, true>(F.lds, DM, S, E, F.wave);
        SEAM(9);
    }
    if (IN(10)) { PH_BEGIN();
        LDIN(b2, 27);
        moe_tables(F);
        pg8::MoeSched<4, false> S{(const LAS int*)(F.lds + TAB_OFF), WSG(int, WS_LIST), WSG(unsigned char, WS_ACT), WSG(unsigned char, WS_W2), F.G, F.vcu, (size_t)1024 * 1024, WSG(float, WS_GATES), (LAS unsigned*)(F.lds + ROWTAB_OFF)};
        pg8::EpiY E{WSG(unsigned char, WS_Y4), GG(float, F.b2), (const LAS unsigned*)(F.lds + ROWTAB_OFF), (const LAS int*)(F.lds + TAB_OFF)};
        pg8::gemm_phase<pg8::EpiY, pg8::MoeSched<4, false>, true, true>(F.lds, DFF, S, E, F.wave);
        SEAM(10);
    }
    if (IN(11)) { PH_BEGIN(); p9_combine(F); }
#undef IN
#undef SEAM
}

extern "C" void kernel_launch(void* const* d_in, const int* in_sizes, int n_in, void* d_out, int out_size, void* d_ws, size_t ws_size, hipStream_t stream) {
    static int grid = 0;
    if (grid == 0) {
        if (n_in != 28 || out_size != T * DM || ws_size < WS_END) { fprintf(stderr, "kernel_launch: unexpected shapes (n_in %d out %d ws %zu)\n", n_in, out_size, ws_size); grid = -1; return; }
        int dev = 0, cus = 0, per_cu = 0;
        if (hipGetDevice(&dev) != hipSuccess || hipDeviceGetAttribute(&cus, hipDeviceAttributeMultiprocessorCount, dev) != hipSuccess) { grid = -1; return; }
        if (hipFuncSetAttribute((const void*)mega_fwd, hipFuncAttributeMaxDynamicSharedMemorySize, LDS_BYTES) != hipSuccess) { fprintf(stderr, "kernel_launch: hipFuncSetAttribute failed\n"); grid = -1; return; }
        if (hipOccupancyMaxActiveBlocksPerMultiprocessor(&per_cu, (const void*)mega_fwd, 512, LDS_BYTES) != hipSuccess || per_cu < 1) { fprintf(stderr, "kernel_launch: occupancy query says %d blocks per CU\n", per_cu); per_cu = 1; }
        (void)hipGetLastError();
        grid = cus;
    }
    if (grid < 0) return;
    (void)hipMemsetAsync((char*)d_ws + WS_CTL, 0, CTL_ZERO_BYTES, stream);
    Args a{};
    for (int i = 0; i < 28; ++i) a.in[i] = d_in[i];
    a.out = (float*)d_out; a.ws = (unsigned char*)d_ws;
    constexpr int NPH = MK_LAST_PHASE;
    if (MK_N_LAUNCHES == 1) { a.ph_lo = 0; a.ph_hi = NPH; hipLaunchKernelGGL(mega_fwd, dim3(grid), dim3(512), LDS_BYTES, stream, a); }
    else { for (int p = 0; p < NPH; ++p) { const int reps = (p == PROBE_PHASE) ? PROBE_REP : 1;
            for (int r = 0; r < reps; ++r) { if (r > 0 && p == 8) (void)hipMemsetAsync((char*)d_ws + WS_CTL, 0, CTL_ZERO_BYTES, stream);
                a.ph_lo = p; a.ph_hi = p + 1; hipLaunchKernelGGL(mega_fwd, dim3(grid), dim3(512), LDS_BYTES, stream, a); } } }
}
```

```cpp
#include <hip/hip_runtime.h>
#include <cstdio>
#include <cstdint>

#ifndef MK_N_LAUNCHES
#define MK_N_LAUNCHES 1
#endif
#ifndef PROBE_PHASE
#define PROBE_PHASE -1
#endif
#ifndef PROBE_REP
#define PROBE_REP 3
#endif
#ifndef MK_LAST_PHASE
#define MK_LAST_PHASE 12
#endif

#define LAS __attribute__((address_space(3)))
#define GAS __attribute__((address_space(1)))
typedef unsigned short bf16;
typedef short bf16x8 __attribute__((ext_vector_type(8)));
typedef float f32x4 __attribute__((ext_vector_type(4)));
typedef float f32x16 __attribute__((ext_vector_type(16)));
typedef unsigned u32x4 __attribute__((ext_vector_type(4)));
typedef unsigned u32x2 __attribute__((ext_vector_type(2)));
typedef float f32x2 __attribute__((ext_vector_type(2)));
typedef int v4i __attribute__((ext_vector_type(4)));
typedef int v8i __attribute__((ext_vector_type(8)));

constexpr int NB = 8, SEQ = 4096, DM = 1024, T = NB * SEQ;
constexpr int DLRU = 512, NHEAD = 8, QKH = 96, VH = 64, QLORA = 256, KVLORA = 128, DIN = 1440, DINP = 1536;
constexpr int NEXP = 32, TOPK = 4, DFF = 1024;
constexpr float EPS = 1e-6f;
constexpr int ACT_ROWS = T * TOPK + NEXP * 256;

constexpr size_t MiB = 1u << 20;
constexpr size_t WS_CTL = 0, CTL_ZERO_BYTES = 64 * 1024;
constexpr size_t WS_MOD = 1 * MiB;
constexpr size_t WS_COS = 2 * MiB, WS_SIN = 4 * MiB;
constexpr size_t WS_SSQ = 6 * MiB;
constexpr size_t WS_AGG = 8 * MiB;
constexpr size_t WS_WAX = 10 * MiB;
constexpr size_t WS_LIST = 12 * MiB;
constexpr size_t WS_GATES = 16 * MiB;
constexpr size_t WS_WUQ = 17 * MiB;
constexpr size_t WS_WUKV = 18 * MiB;
constexpr size_t WS_WIN = 20 * MiB;
constexpr size_t WS_WOUT = 24 * MiB;
constexpr size_t WS_WR = 26 * MiB;
constexpr size_t WS_LOGIT = 28 * MiB;
constexpr size_t WS_W2 = 32 * MiB;
constexpr size_t WS_W1 = 96 * MiB;
constexpr size_t WS_H = 224 * MiB;
constexpr size_t WS_Z = 288 * MiB;
constexpr size_t WS_Q = 384 * MiB;
constexpr size_t WS_K = 432 * MiB;
constexpr size_t WS_V = 480 * MiB;
constexpr size_t WS_ACT = 224 * MiB;
constexpr size_t WS_MIX = 512 * MiB;
constexpr size_t WS_H2 = 576 * MiB;
constexpr size_t WS_Y4 = 640 * MiB;
constexpr size_t WS_H2B = 768 * MiB;
constexpr size_t WS_X1B = 832 * MiB;
constexpr size_t WS_END = 896 * MiB;
static_assert(WS_ACT + (size_t)ACT_ROWS * 1024 * 2 <= WS_MIX, "act overlay");
constexpr int CW_BAR = 1024;
constexpr int CW_CNT = 8192;

constexpr int RING_BYTES = 131072;
constexpr int LDSCTL_OFF = RING_BYTES;
constexpr int MISC_OFF = LDSCTL_OFF + 64;
constexpr int TAB_OFF = LDSCTL_OFF + 256;
constexpr int ROWTAB_OFF = LDSCTL_OFF + 1024;
constexpr int BIASTAB_OFF = LDSCTL_OFF + 5120;
constexpr int LDS_BYTES = 147456;

#define RLX_AGENT __ATOMIC_RELAXED, __HIP_MEMORY_SCOPE_AGENT
#define LDS_WAIT() asm volatile("s_waitcnt lgkmcnt(0)" ::: "memory")
typedef __bf16 bf16x2_t __attribute__((ext_vector_type(2)));
__device__ __forceinline__ unsigned cvt_pk_bf16(float lo, float hi) { const f32x2 v = {lo, hi}; const bf16x2_t b = __builtin_convertvector(v, bf16x2_t); return __builtin_bit_cast(unsigned, b); }
__device__ __forceinline__ unsigned f2bf(float f) { return cvt_pk_bf16(f, f) & 0xffffu; }
__device__ __forceinline__ unsigned pk2(float lo, float hi) { return cvt_pk_bf16(lo, hi); }
__device__ __forceinline__ float bf2f(unsigned short v) { return __builtin_bit_cast(float, (unsigned)v << 16); }
__device__ __forceinline__ float bflo(unsigned w) { return __builtin_bit_cast(float, w << 16); }
__device__ __forceinline__ float bfhi(unsigned w) { return __builtin_bit_cast(float, w & 0xffff0000u); }
__device__ __forceinline__ float clamp448(float v) { return __builtin_amdgcn_fmed3f(v, -448.0f, 448.0f); }
__device__ __forceinline__ unsigned pk4_fp8(float a, float b, float c, float d) { int w = 0; w = __builtin_amdgcn_cvt_pk_fp8_f32(clamp448(a), clamp448(b), w, false); w = __builtin_amdgcn_cvt_pk_fp8_f32(clamp448(c), clamp448(d), w, true); return (unsigned)w; }
__device__ __forceinline__ float fast_exp(float v) { return __builtin_amdgcn_exp2f(v * 1.4426950408889634f); }
__device__ __forceinline__ float sigmoidf_(float v) { return __builtin_amdgcn_rcpf(1.0f + fast_exp(-v)); }
__device__ __forceinline__ float wave_sum(float v) {
#pragma unroll
    for (int o = 1; o < 64; o <<= 1) v += __shfl_xor(v, o);
    return v;
}
__device__ __forceinline__ float wave_max(float v) {
#pragma unroll
    for (int o = 1; o < 64; o <<= 1) v = fmaxf(v, __shfl_xor(v, o));
    return v;
}
__device__ __forceinline__ int wave_min_i(int v) {
#pragma unroll
    for (int o = 1; o < 64; o <<= 1) { int t = __shfl_xor(v, o); v = t < v ? t : v; }
    return v;
}
__device__ __forceinline__ int lane_id() { int l; asm volatile("v_mbcnt_lo_u32_b32 %0, -1, 0\n\tv_mbcnt_hi_u32_b32 %0, -1, %0" : "=v"(l)); __builtin_assume(l >= 0 && l < 64); return l; }
__device__ __forceinline__ int crow(int r, int hi) { return (r & 3) + 8 * (r >> 2) + 4 * hi; }

#ifndef MOE_DUPK
#define MOE_DUPK 0
#endif
#ifndef MOE_DUPE
#define MOE_DUPE 0
#endif
namespace pg8 {
constexpr int BM = 256, BK = 64, HALF = 128, HTB = HALF * BK * 2, STAGE_BYTES = 8 * HTB, NXCD = 8, WGM = 8;
template <int SW> __device__ __forceinline__ int lds_byte(int r, int kb) { const int st = (r >> 4) * 2 + (kb >> 6), rr = r & 15, ob = rr * 64 + (kb & 63); return st * 1024 + (ob ^ (((ob >> 9) & 1) << SW)); }
template <int SW> __device__ __forceinline__ void stage_rc(int b, int& R, int& CB) { const int st = b / 1024, sb = b % 1024, swz = sb ^ (((sb >> 9) & 1) << SW); R = (st >> 1) * 16 + swz / 64; CB = (st & 1) * 64 + (swz % 64); }
__device__ __forceinline__ int perm32(int rho) { const int n = rho >> 4, i = rho & 15; return 8 * (i >> 2) + 4 * n + (i & 3); }

struct Unit { int pm, pn, e, aux, par; };

struct DenseSched {
    static constexpr bool VAROFF = false, VAROFF_OR_MOE = false, HAS_PREFETCH = false;
    const GAS bf16* A; const GAS bf16* Bt; int lda, K, nM, nN, nwg, G, c;
    __device__ __forceinline__ void init(const GAS bf16* A_, int lda_, const GAS bf16* Bt_, int K_, int M, int N, int G_, int c_) { A = A_; lda = lda_; Bt = Bt_; K = K_; nM = M / BM; nN = N / BM; nwg = nM * nN; G = G_; c = c_; }
    __device__ __forceinline__ bool next(int i, Unit& u) const {
        const long L = (long)i * G + c; if (L >= nwg) return false;
        int wgid = (int)L; { const int q = nwg / NXCD, r = nwg % NXCD, xcd = wgid % NXCD, off = wgid / NXCD; wgid = (xcd < r ? xcd * (q + 1) : r * (q + 1) + (xcd - r) * q) + off; }
        const int nig = WGM * nN, gid = wgid / nig, fm = gid * WGM, gsz = (nM - fm) < WGM ? (nM - fm) : WGM;
        u.pm = fm + ((wgid % nig) % gsz); u.pn = (wgid % nig) / gsz; u.e = 0; u.aux = 0; u.par = 0; return true;
    }
    __device__ __forceinline__ const GAS char* baseA(const Unit& u) const { return (const GAS char*)(A + (size_t)u.pm * BM * lda); }
    __device__ __forceinline__ const GAS char* baseB(const Unit& u) const { return (const GAS char*)(Bt + (size_t)u.pn * BM * K); }
    __device__ __forceinline__ void offsA(const Unit&, const int (&R)[2], const int (&CB)[2], unsigned (&vo)[2][2]) const {
#pragma unroll
        for (int h = 0; h < 2; ++h)
#pragma unroll
            for (int i = 0; i < 2; ++i) vo[h][i] = (unsigned)((h * HALF + R[i]) * lda * 2 + CB[i]);
    }
};

template <int NN, bool GATHER> struct MoeSched {
    const LAS int* tab; const GAS int* list; const GAS unsigned char* A; const GAS unsigned char* Bt; int G, v; size_t bstride;
    static constexpr int PMT = 32 / NN; static constexpr bool VAROFF = GATHER, VAROFF_OR_MOE = true, HAS_PREFETCH = true;
    const GAS float* gates; LAS unsigned* rowtab; const GAS float* bias; LAS float* biastab;
    __device__ __forceinline__ void prefetch(const Unit& u, int tid) const {
        if (tid < 256) {
            const int bcol = GATHER ? ((tid < 128) ? (u.pn * 128 + tid) : (1024 + u.pn * 128 + tid - 128)) : (u.pn * BM + tid);
            biastab[u.par * 256 + tid] = bias[(size_t)u.e * (GATHER ? 2048 : 1024) + bcol];
            if constexpr (!GATHER) { const int cnt = tab[33 + u.e]; const int pos = u.aux * BM + tid; const int pc = pos < cnt ? pos : cnt - 1; const int ent = list[(size_t)u.e * T + pc]; const float g = 16.0f * gates[ent];
                LAS unsigned* p = rowtab + (u.par * 256 + tid) * 2; p[0] = (unsigned)ent; p[1] = __builtin_bit_cast(unsigned, g); } } }
    __device__ __forceinline__ bool next(int i0, Unit& u) const {
        const int i = MOE_DUPK ? (i0 >> 1) : i0;
        const int L = i * G + v, gq = L >> 5, w = L & 31, gmt = gq * PMT + (w % PMT), Mt = tab[32];
        if (gmt >= Mt) return false;
        int e = 0;
        for (int j = 1; j < 32; ++j) e += (tab[j] <= gmt) ? 1 : 0;
        u.pm = gmt; u.pn = w / PMT; u.e = e; u.aux = gmt - tab[e]; u.par = i0 & 1; return true;
    }
    __device__ __forceinline__ const GAS char* baseA(const Unit& u) const { return GATHER ? (const GAS char*)A : (const GAS char*)(A + (size_t)u.pm * BM * 1024); }
    __device__ __forceinline__ const GAS char* baseB(const Unit& u) const { return (const GAS char*)(Bt + (size_t)u.e * bstride + (size_t)u.pn * BM * 1024); }
    __device__ __forceinline__ void offsA(const Unit& u, const int (&R)[2], const int (&C)[2], unsigned (&vo)[2][2]) const {
        if constexpr (GATHER) {
            const int cnt = tab[33 + u.e];
#pragma unroll
            for (int h = 0; h < 2; ++h)
#pragma unroll
                for (int i = 0; i < 2; ++i) { const int pos = u.aux * BM + h * HALF + R[i]; const int pc = pos < cnt ? pos : cnt - 1;
                    const int tok = list[(size_t)u.e * T + pc] >> 2; vo[h][i] = (unsigned)(tok * 1024 + C[i]); }
        } else {
#pragma unroll
            for (int h = 0; h < 2; ++h)
#pragma unroll
                for (int i = 0; i < 2; ++i) vo[h][i] = (unsigned)((h * HALF + R[i]) * 1024 + C[i]);
        }
    }
};

template <class Epi> struct BRowMap { static constexpr int HALF_ROWS = HALF; __device__ static __forceinline__ int map(int R) { return Epi::PERM ? ((R & ~31) + perm32(R & 31)) : R; } };
template <class Epi> __device__ __forceinline__ constexpr int bhalf_rows() { return BRowMap<Epi>::HALF_ROWS; }
template <class Epi> __device__ __forceinline__ int brow_of(int R) { return BRowMap<Epi>::map(R); }
template <class Epi, class Sched, bool ALIGN_EPI, bool FP8 = false>
__device__ __forceinline__ void gemm_phase(LAS unsigned char* lds, const int KB, const Sched& S, const Epi& E, const int wid) {
    const int lane = lane_id(), tid = wid * 64 + lane, wr = wid >> 2, wc = wid & 3, fr = lane & 15, fq = lane >> 4;
    constexpr int SW = FP8 ? 4 : 5;
    int nt = KB / 128; asm volatile("" : "+s"(nt));
    unsigned voffB[2];
#define PG8_RC() int Rp[2], Cp[2]; _Pragma("unroll") for (int i = 0; i < 2; ++i) { int t_ = tid; asm volatile("" : "+v"(t_)); stage_rc<SW>(t_ * 16 + i * 8192, Rp[i], Cp[i]); }
    { PG8_RC();
#pragma unroll
      for (int i = 0; i < 2; ++i) { const int Rb = brow_of<Epi>(Rp[i]); voffB[i] = (unsigned)(Rb * KB + Cp[i]); } }
    const size_t kstep = (size_t)128;
    const size_t hstepB = (size_t)bhalf_rows<Epi>() * KB;
    const unsigned ldsw = (unsigned)wid * 1024u;
    int aoffk[2], boffk[2];
#pragma unroll
    for (int k = 0; k < 2; ++k) { const int kb = FP8 ? (32 * fq + 16 * k) : (16 * fq + 64 * k); aoffk[k] = lds_byte<SW>(wr * 64 + fr, kb); boffk[k] = lds_byte<SW>(wc * 32 + fr, kb); }
#define PG8_SA(b, h) (((b) * 2 + (h)) * HTB)
#define PG8_SB(b, h) ((4 + (b) * 2 + (h)) * HTB)
#define PG8_STAGE(bufoff, gbase, voff) do { _Pragma("unroll") for (int _i = 0; _i < 2; ++_i) \
        __builtin_amdgcn_global_load_lds((const GAS unsigned*)((gbase) + (voff)[_i]), (LAS unsigned*)(lds + (bufoff) + ldsw + _i * 8192), 16, 0, 0); } while (0)
#define PG8_LD16(off) (*(const LAS v4i*)(lds + (off)))
#define PG8_LDA(dst, b, h) do { _Pragma("unroll") for (int m = 0; m < 4; ++m) { if constexpr (FP8) dst##8[m] = __builtin_shufflevector(PG8_LD16(PG8_SA(b, h) + aoffk[0] + m * 2048), PG8_LD16(PG8_SA(b, h) + aoffk[1] + m * 2048), 0, 1, 2, 3, 4, 5, 6, 7); \
        else { _Pragma("unroll") for (int k = 0; k < 2; ++k) dst[m][k] = *(const LAS bf16x8*)(lds + PG8_SA(b, h) + aoffk[k] + m * 2048); } } } while (0)
#define PG8_LDB(dst, b, h) do { _Pragma("unroll") for (int n = 0; n < 2; ++n) { if constexpr (FP8) dst##8[n] = __builtin_shufflevector(PG8_LD16(PG8_SB(b, h) + boffk[0] + n * 2048), PG8_LD16(PG8_SB(b, h) + boffk[1] + n * 2048), 0, 1, 2, 3, 4, 5, 6, 7); \
        else { _Pragma("unroll") for (int k = 0; k < 2; ++k) dst[n][k] = *(const LAS bf16x8*)(lds + PG8_SB(b, h) + boffk[k] + n * 2048); } } } while (0)
#define PG8_MMA(ai, bj, At, Bt) do { __builtin_amdgcn_s_setprio(1); \
        if constexpr (FP8) { _Pragma("unroll") for (int m = 0; m < 4; ++m) _Pragma("unroll") for (int n = 0; n < 2; ++n) \
            asm volatile("v_mfma_f32_16x16x128_f8f6f4 %0, %1, %2, %0" : "+v"(acc[ai][bj][m][n]) : "v"(Bt##8[n]), "v"(At##8[m])); } \
        else { _Pragma("unroll") for (int m = 0; m < 4; ++m) _Pragma("unroll") for (int n = 0; n < 2; ++n) _Pragma("unroll") for (int k = 0; k < 2; ++k) \
            acc[ai][bj][m][n] = __builtin_amdgcn_mfma_f32_16x16x32_bf16(Bt[n][k], At[m][k], acc[ai][bj][m][n], 0, 0, 0); } \
        __builtin_amdgcn_s_setprio(0); } while (0)
#define PG8_WAIT_V(n) asm volatile("s_waitcnt vmcnt(" #n ")" ::: "memory")
#define PG8_WAIT_L(n) asm volatile("s_waitcnt lgkmcnt(" #n ")" ::: "memory")
#define PG8_BAR __builtin_amdgcn_s_barrier()
#define PG8_SCHED __builtin_amdgcn_sched_barrier(0)
    Unit cur, nxt; int ui = 0;
    if (!S.next(0, cur)) return;
    f32x4 acc[2][2][4][2];
#pragma unroll
    for (int a = 0; a < 2; ++a)
#pragma unroll
        for (int b = 0; b < 2; ++b)
#pragma unroll
            for (int m = 0; m < 4; ++m)
#pragma unroll
                for (int n = 0; n < 2; ++n) acc[a][b][m][n] = (f32x4){0.f, 0.f, 0.f, 0.f};
    bf16x8 At[4][2], B0[2][2], B1[2][2]; v8i At8[4], B08[2], B18[2];
    unsigned voA[2][2], vnA[2][2];
    { PG8_RC(); S.offsA(cur, Rp, Cp, voA); }
    if constexpr (Sched::HAS_PREFETCH) S.prefetch(cur, tid);
    const GAS char* cA = S.baseA(cur); const GAS char* cB = S.baseB(cur);
    PG8_STAGE(PG8_SB(0, 0), cB, voffB); PG8_STAGE(PG8_SB(0, 1), cB + hstepB, voffB); PG8_STAGE(PG8_SA(0, 0), cA, voA[0]); PG8_STAGE(PG8_SA(0, 1), cA, voA[1]);
    if (wr == 1) PG8_BAR;
    PG8_WAIT_V(2); PG8_BAR;
    PG8_STAGE(PG8_SB(1, 0), cB + kstep, voffB); PG8_STAGE(PG8_SA(1, 0), cA + kstep, voA[0]); PG8_STAGE(PG8_SB(1, 1), cB + hstepB + kstep, voffB);
    PG8_WAIT_V(6); PG8_BAR;
    for (;;) {
        const bool has_next = S.next(ui + 1, nxt);
        const GAS char* nA = has_next ? S.baseA(nxt) : cA; const GAS char* nB = has_next ? S.baseB(nxt) : cB;
        if constexpr (Sched::VAROFF) { if (has_next) { PG8_RC(); S.offsA(nxt, Rp, Cp, vnA); } }
        if (!Sched::VAROFF || !has_next) {
#pragma unroll
            for (int h = 0; h < 2; ++h)
#pragma unroll
                for (int i = 0; i < 2; ++i) vnA[h][i] = voA[h][i];
        }
#pragma unroll 1
        for (int t = 0; t < nt; t += 2) {
            const bool last = (t == nt - 2);
            asm volatile("" : "+v"(voffB[0]), "+v"(voffB[1]), "+v"(voA[0][0]), "+v"(voA[0][1]), "+v"(voA[1][0]), "+v"(voA[1][1]));
            const GAS char* a1 = cA + (size_t)(t + 1) * kstep;
            const GAS char* a2 = last ? nA : cA + (size_t)(t + 2) * kstep; const GAS char* b2 = last ? nB : cB + (size_t)(t + 2) * kstep;
            const GAS char* a3 = a2 + kstep; const GAS char* b3 = b2 + kstep;
            unsigned o0[2], o1[2];
#pragma unroll
            for (int i = 0; i < 2; ++i) { o0[i] = voA[0][i]; o1[i] = voA[1][i]; }
            if constexpr (Sched::VAROFF) { if (last) {
#pragma unroll
                for (int i = 0; i < 2; ++i) { o0[i] = vnA[0][i]; o1[i] = vnA[1][i]; } } }
            PG8_LDB(B0, 0, 0); PG8_LDB(B1, 0, 1); PG8_SCHED; PG8_LDA(At, 0, 0); PG8_STAGE(PG8_SA(1, 1), a1, voA[1]);
            PG8_WAIT_V(8); PG8_WAIT_L(0); PG8_BAR; PG8_MMA(0, 0, At, B0); PG8_MMA(0, 1, At, B1); PG8_BAR; PG8_SCHED;
            PG8_LDA(At, 0, 1); PG8_STAGE(PG8_SB(0, 0), b2, voffB); PG8_STAGE(PG8_SB(0, 1), b2 + hstepB, voffB); PG8_STAGE(PG8_SA(0, 0), a2, o0);
            PG8_WAIT_V(8); PG8_WAIT_L(0); PG8_BAR; PG8_MMA(1, 0, At, B0); PG8_MMA(1, 1, At, B1); PG8_BAR; PG8_SCHED;
            PG8_LDB(B0, 1, 0); PG8_LDB(B1, 1, 1); PG8_SCHED; PG8_LDA(At, 1, 0); PG8_STAGE(PG8_SA(0, 1), a2, o1);
            PG8_WAIT_V(8); PG8_WAIT_L(0); PG8_BAR; PG8_MMA(0, 0, At, B0); PG8_MMA(0, 1, At, B1); PG8_BAR; PG8_SCHED;
            PG8_LDA(At, 1, 1); PG8_STAGE(PG8_SB(1, 0), b3, voffB); PG8_STAGE(PG8_SB(1, 1), b3 + hstepB, voffB); PG8_STAGE(PG8_SA(1, 0), a3, o0);
            PG8_WAIT_V(8); PG8_WAIT_L(0); PG8_BAR; PG8_MMA(1, 0, At, B0); PG8_MMA(1, 1, At, B1); PG8_BAR; PG8_SCHED;
        }
        if constexpr (ALIGN_EPI) { if (wr == 0) PG8_BAR; }
        if constexpr (FP8) asm volatile("s_nop 15\n\ts_nop 7" ::: "memory");
        if (!(MOE_DUPK && Sched::VAROFF_OR_MOE && !(ui & 1))) E(acc, cur, wr, wc, fr, fq);
        if (MOE_DUPE && Sched::VAROFF_OR_MOE) { asm volatile("" ::: "memory"); E(acc, cur, wr, wc, fr, fq); }
        if (!has_next) break;
#pragma unroll
        for (int a = 0; a < 2; ++a)
#pragma unroll
            for (int b = 0; b < 2; ++b)
#pragma unroll
                for (int m = 0; m < 4; ++m)
#pragma unroll
                    for (int n = 0; n < 2; ++n) acc[a][b][m][n] = (f32x4){0.f, 0.f, 0.f, 0.f};
        cur = nxt; cA = nA; cB = nB; ++ui;
        if constexpr (Sched::HAS_PREFETCH) S.prefetch(cur, wid * 64 + lane_id());
#pragma unroll
        for (int h = 0; h < 2; ++h)
#pragma unroll
            for (int i = 0; i < 2; ++i) voA[h][i] = vnA[h][i];
        if constexpr (ALIGN_EPI) { if (wr == 1) PG8_BAR; }
    }
    PG8_WAIT_V(0);
    if constexpr (!ALIGN_EPI) { if (wr == 0) PG8_BAR; }
    PG8_BAR;
#undef PG8_SA
#undef PG8_SB
#undef PG8_STAGE
#undef PG8_LDA
#undef PG8_LDB
#undef PG8_MMA
#undef PG8_LD16
#undef PG8_RC
#undef PG8_WAIT_V
#undef PG8_WAIT_L
#undef PG8_BAR
#undef PG8_SCHED
}

typedef const f32x4 (&AccRef)[2][2][4][2];

struct EpiZ {
    static constexpr bool PERM = true;
    GAS bf16* Z; GAS float* ssq;
    __device__ __forceinline__ void operator()(AccRef acc, const Unit& u, int wr, int wc, int fr, int fq) const {
        const int row0 = u.pm * BM + wr * 64 + fr, col0 = u.pn * BM + wc * 32 + 8 * fq;
#pragma unroll
        for (int ai = 0; ai < 2; ++ai)
#pragma unroll
            for (int m = 0; m < 4; ++m) { const int row = row0 + ai * HALF + m * 16; GAS bf16* rowp = Z + (size_t)row * DINP + col0;
                float s0 = 0.f, s1 = 0.f;
#pragma unroll
                for (int bj = 0; bj < 2; ++bj) { const f32x4 v0 = acc[ai][bj][m][0], v1 = acc[ai][bj][m][1];
                    const float s = (v0[0] * v0[0] + v0[1] * v0[1]) + (v0[2] * v0[2] + v0[3] * v0[3]) + (v1[0] * v1[0] + v1[1] * v1[1]) + (v1[2] * v1[2] + v1[3] * v1[3]);
                    if (bj == 0) s0 = s; else s1 = s;
                    u32x4 w; w.x = cvt_pk_bf16(v0[0], v0[1]); w.y = cvt_pk_bf16(v0[2], v0[3]); w.z = cvt_pk_bf16(v1[0], v1[1]); w.w = cvt_pk_bf16(v1[2], v1[3]);
                    *(GAS u32x4*)(rowp + bj * HALF) = w; }
                if (u.pn >= 4) {
                    s0 += __shfl_xor(s0, 16); s0 += __shfl_xor(s0, 32); s1 += __shfl_xor(s1, 16); s1 += __shfl_xor(s1, 32);
                    if (fq == 0) {
                        if (u.pn == 4) ssq[(size_t)row * 12 + wc] = s0 + s1;
                        else { ssq[(size_t)row * 12 + 4 + wc] = s0; if (wc == 0) ssq[(size_t)row * 12 + 8] = s1; }
                    }
                }
            }
    }
};
struct EpiQ {
    static constexpr bool PERM = true;
    GAS bf16* Q; const GAS float* ssq;
    __device__ __forceinline__ void operator()(AccRef acc, const Unit& u, int wr, int wc, int fr, int fq) const {
        const int row0 = u.pm * BM + wr * 64 + fr, col0 = u.pn * BM + wc * 32 + 8 * fq;
#pragma unroll
        for (int ai = 0; ai < 2; ++ai)
#pragma unroll
            for (int m = 0; m < 4; ++m) { const int row = row0 + ai * HALF + m * 16; GAS bf16* rowp = Q + (size_t)row * 768 + col0;
                const f32x4 sp = *(const GAS f32x4*)(ssq + (size_t)row * 12);
                const float rs = __builtin_amdgcn_rsqf(((sp[0] + sp[1]) + (sp[2] + sp[3])) * (1.0f / QLORA) + EPS);
#pragma unroll
                for (int bj = 0; bj < 2; ++bj) { const f32x4 v0 = acc[ai][bj][m][0] * rs, v1 = acc[ai][bj][m][1] * rs;
                    u32x4 w; w.x = cvt_pk_bf16(v0[0], v0[1]); w.y = cvt_pk_bf16(v0[2], v0[3]); w.z = cvt_pk_bf16(v1[0], v1[1]); w.w = cvt_pk_bf16(v1[2], v1[3]);
                    *(GAS u32x4*)(rowp + bj * HALF) = w; }
            }
    }
};
struct EpiKV {
    static constexpr bool PERM = true;
    GAS bf16* Kb; GAS bf16* Vb; const GAS bf16* Z; const GAS float* ssq; const GAS float* gkn; const GAS float* ctab; const GAS float* stab;
    __device__ __forceinline__ void operator()(AccRef acc, const Unit& u, int wr, int wc, int fr, int fq) const {
        const int row0 = u.pm * BM + wr * 64 + fr; const int head = 2 * u.pn + (wc & 1);
        if (wc < 2) {
#pragma unroll
            for (int am = 0; am < 4; ++am) { const int ai = am >> 1, mb = 2 * (am & 1);
                asm volatile("" ::: "memory");
                f32x4 sp[2], cs[2], sn[2]; float ssr[2]; u32x2 r1[2], r2[2];
#pragma unroll
                for (int mm = 0; mm < 2; ++mm) { const int m = mm; const int row = row0 + ai * HALF + (mb + mm) * 16;
                    sp[m] = *(const GAS f32x4*)(ssq + (size_t)row * 12 + 4); ssr[m] = ssq[(size_t)row * 12 + 8];
                    r1[m] = *(const GAS u32x2*)(Z + (size_t)row * DINP + 1408 + 4 * fq); r2[m] = *(const GAS u32x2*)(Z + (size_t)row * DINP + 1424 + 4 * fq);
                    cs[m] = *(const GAS f32x4*)(ctab + (size_t)row * 16 + 4 * fq); sn[m] = *(const GAS f32x4*)(stab + (size_t)row * 16 + 4 * fq); }
                const f32x4 gr1 = *(const GAS f32x4*)(gkn + 64 + 4 * fq), gr2 = *(const GAS f32x4*)(gkn + 80 + 4 * fq);
                f32x4 g0v[2], g1v[2];
#pragma unroll
                for (int bj = 0; bj < 2; ++bj) { g0v[bj] = *(const GAS f32x4*)(gkn + bj * 32 + 8 * fq); g1v[bj] = *(const GAS f32x4*)(gkn + bj * 32 + 8 * fq + 4); }
#pragma unroll
                for (int mm = 0; mm < 2; ++mm) { const int m = mm; const int mi = mb + mm; const int row = row0 + ai * HALF + mi * 16;
                    const float rkv = __builtin_amdgcn_rsqf(((sp[m][0] + sp[m][1]) + (sp[m][2] + sp[m][3])) * (1.0f / KVLORA) + EPS);
                    f32x4 v[2][2]; float s = 0.f;
#pragma unroll
                    for (int bj = 0; bj < 2; ++bj)
#pragma unroll
                        for (int n = 0; n < 2; ++n) { v[bj][n] = acc[ai][bj][mi][n] * rkv; s += (v[bj][n][0] * v[bj][n][0] + v[bj][n][1] * v[bj][n][1]) + (v[bj][n][2] * v[bj][n][2] + v[bj][n][3] * v[bj][n][3]); }
                    s += __shfl_xor(s, 16); s += __shfl_xor(s, 32);
                    const float rk = __builtin_amdgcn_rsqf((s + ssr[m]) * (1.0f / QKH) + EPS);
                    GAS bf16* kp = Kb + (size_t)row * 768 + head * QKH;
#pragma unroll
                    for (int bj = 0; bj < 2; ++bj) { u32x4 w; const f32x4 g0 = g0v[bj] * rk, g1 = g1v[bj] * rk;
                        w.x = cvt_pk_bf16(v[bj][0][0] * g0[0], v[bj][0][1] * g0[1]); w.y = cvt_pk_bf16(v[bj][0][2] * g0[2], v[bj][0][3] * g0[3]);
                        w.z = cvt_pk_bf16(v[bj][1][0] * g1[0], v[bj][1][1] * g1[1]); w.w = cvt_pk_bf16(v[bj][1][2] * g1[2], v[bj][1][3] * g1[3]);
                        *(GAS u32x4*)(kp + bj * 32 + 8 * fq) = w; }
                    float x1[4] = {bflo(r1[m].x), bfhi(r1[m].x), bflo(r1[m].y), bfhi(r1[m].y)}, x2[4] = {bflo(r2[m].x), bfhi(r2[m].x), bflo(r2[m].y), bfhi(r2[m].y)};
                    float o1[4], o2[4];
#pragma unroll
                    for (int j = 0; j < 4; ++j) { const float a = x1[j] * rk * gr1[j], b = x2[j] * rk * gr2[j]; o1[j] = a * cs[m][j] - b * sn[m][j]; o2[j] = b * cs[m][j] + a * sn[m][j]; }
                    u32x2 w1, w2; w1.x = cvt_pk_bf16(o1[0], o1[1]); w1.y = cvt_pk_bf16(o1[2], o1[3]); w2.x = cvt_pk_bf16(o2[0], o2[1]); w2.y = cvt_pk_bf16(o2[2], o2[3]);
                    *(GAS u32x2*)(kp + 64 + 4 * fq) = w1; *(GAS u32x2*)(kp + 80 + 4 * fq) = w2;
                }
            }
        } else {
#pragma unroll
            for (int ai = 0; ai < 2; ++ai)
#pragma unroll
                for (int m = 0; m < 4; ++m) { const int row = row0 + ai * HALF + m * 16;
                    const f32x4 sp = *(const GAS f32x4*)(ssq + (size_t)row * 12 + 4);
                    const float rkv = __builtin_amdgcn_rsqf(((sp[0] + sp[1]) + (sp[2] + sp[3])) * (1.0f / KVLORA) + EPS);
                    GAS bf16* vp = Vb + (size_t)row * 512 + head * VH;
#pragma unroll
                    for (int bj = 0; bj < 2; ++bj) { const f32x4 v0 = acc[ai][bj][m][0] * rkv, v1 = acc[ai][bj][m][1] * rkv;
                        u32x4 w; w.x = cvt_pk_bf16(v0[0], v0[1]); w.y = cvt_pk_bf16(v0[2], v0[3]); w.z = cvt_pk_bf16(v1[0], v1[1]); w.w = cvt_pk_bf16(v1[2], v1[3]);
                        *(GAS u32x4*)(vp + bj * 32 + 8 * fq) = w; }
                }
        }
    }
};
struct EpiX1 {
    static constexpr bool PERM = true;
    const GAS float* x; GAS bf16* x1; const GAS float* gate;
    __device__ __forceinline__ void operator()(AccRef acc, const Unit& u, int wr, int wc, int fr, int fq) const {
        const int row0 = u.pm * BM + wr * 64 + fr, col0 = u.pn * BM + wc * 32 + 8 * fq; const int b = (u.pm * BM) / SEQ;
        f32x4 gv[2][2];
#pragma unroll
        for (int bj = 0; bj < 2; ++bj)
#pragma unroll
            for (int n = 0; n < 2; ++n) gv[bj][n] = *(const GAS f32x4*)(gate + (size_t)b * 6144 + col0 + bj * HALF + n * 4);
#pragma unroll
        for (int ai = 0; ai < 2; ++ai)
#pragma unroll
            for (int m = 0; m < 4; ++m) { const size_t off = (size_t)(row0 + ai * HALF + m * 16) * DM + col0;
#pragma unroll
                for (int bj = 0; bj < 2; ++bj) { const f32x4 x0 = __builtin_nontemporal_load((const GAS f32x4*)(x + off + bj * HALF)), x1v = __builtin_nontemporal_load((const GAS f32x4*)(x + off + bj * HALF + 4));
                    const f32x4 v0 = x0 + gv[bj][0] * acc[ai][bj][m][0], v1 = x1v + gv[bj][1] * acc[ai][bj][m][1];
                    u32x4 w; w.x = cvt_pk_bf16(v0[0], v0[1]); w.y = cvt_pk_bf16(v0[2], v0[3]); w.z = cvt_pk_bf16(v1[0], v1[1]); w.w = cvt_pk_bf16(v1[2], v1[3]);
                    *(GAS u32x4*)(x1 + off + bj * HALF) = w; }
                if (m == 3) asm volatile("" ::: "memory"); }
    }
};
struct EpiAct {
    static constexpr bool PERM = true;
    GAS unsigned char* act; const LAS float* biastab;
    __device__ __forceinline__ void operator()(AccRef acc, const Unit& u, int wr, int wc, int fr, int fq) const {
        const int row0 = u.pm * BM + wr * 64 + fr, col0 = u.pn * 128 + wc * 32 + 8 * fq;
        const LAS float* bp = biastab + u.par * 256 + wc * 32 + 8 * fq;
        f32x2 bg[4], bu[4];
#pragma unroll
        for (int q = 0; q < 4; ++q) { bg[q] = *(const LAS f32x2*)(bp + 2 * q); bu[q] = *(const LAS f32x2*)(bp + 128 + 2 * q); }
#pragma unroll
        for (int ai = 0; ai < 2; ++ai)
#pragma unroll
            for (int m = 0; m < 4; ++m) { GAS unsigned char* rowp = act + (size_t)(row0 + ai * HALF + m * 16) * DFF + col0;
                f32x2 o[4];
#pragma unroll
                for (int q = 0; q < 4; ++q) { const int n = q >> 1, j = 2 * (q & 1);
                    const f32x2 ga = {acc[ai][0][m][n][j], acc[ai][0][m][n][j + 1]}, ua = {acc[ai][1][m][n][j], acc[ai][1][m][n][j + 1]};
                    f32x2 gl = ga * 0.015625f + bg[q], li = ua * 0.015625f + bu[q];
                    gl.x = fminf(gl.x, 7.0f); gl.y = fminf(gl.y, 7.0f);
                    li.x = __builtin_amdgcn_fmed3f(li.x, -7.0f, 7.0f); li.y = __builtin_amdgcn_fmed3f(li.y, -7.0f, 7.0f);
                    const f32x2 ea = gl * (-1.702f * 1.4426950408889634f);
                    f32x2 den; den.x = __builtin_amdgcn_exp2f(ea.x); den.y = __builtin_amdgcn_exp2f(ea.y); den = den + 1.0f;
                    f32x2 sg; sg.x = __builtin_amdgcn_rcpf(den.x); sg.y = __builtin_amdgcn_rcpf(den.y);
                    o[q] = (li * 4.0f + 4.0f) * (gl * sg); }
                u32x2 w;
                { int t0 = 0; t0 = __builtin_amdgcn_cvt_pk_fp8_f32(o[0].x, o[0].y, t0, false); t0 = __builtin_amdgcn_cvt_pk_fp8_f32(o[1].x, o[1].y, t0, true); w.x = (unsigned)t0; }
                { int t1 = 0; t1 = __builtin_amdgcn_cvt_pk_fp8_f32(o[2].x, o[2].y, t1, false); t1 = __builtin_amdgcn_cvt_pk_fp8_f32(o[3].x, o[3].y, t1, true); w.y = (unsigned)t1; }
                *(GAS u32x2*)rowp = w; }
    }
};
struct EpiY {
    static constexpr bool PERM = true;
    GAS unsigned char* y4; const LAS float* biastab; const LAS unsigned* rowtab; const LAS int* tab;
    __device__ __forceinline__ void operator()(AccRef acc, const Unit& u, int wr, int wc, int fr, int fq) const {
        const int r0 = wr * 64 + fr, col0 = u.pn * BM + wc * 64 + 16 * fq; const int cnt = tab[33 + u.e];
        f32x4 bv[2][2];
#pragma unroll
        for (int bj = 0; bj < 2; ++bj)
#pragma unroll
            for (int n = 0; n < 2; ++n) bv[bj][n] = *(const LAS f32x4*)(biastab + u.par * 256 + wc * 64 + 16 * fq + 8 * bj + 4 * n);
        int ent[8]; float gg[8];
#pragma unroll
        for (int q = 0; q < 8; ++q) { const LAS unsigned* p = rowtab + (u.par * 256 + r0 + (q >> 2) * HALF + (q & 3) * 16) * 2; ent[q] = (int)p[0]; gg[q] = __builtin_bit_cast(float, p[1]); }
#pragma unroll
        for (int ai = 0; ai < 2; ++ai)
#pragma unroll
            for (int m = 0; m < 4; ++m) { const int pos = u.aux * BM + r0 + ai * HALF + m * 16;
                if (pos < cnt) { const float g = gg[ai * 4 + m]; GAS unsigned char* rowp = y4 + (size_t)ent[ai * 4 + m] * DM + col0;
                    u32x4 w;
#pragma unroll
                    for (int bj = 0; bj < 2; ++bj) { const f32x4 v0 = (acc[ai][bj][m][0] * 0.00390625f + bv[bj][0]) * g, v1 = (acc[ai][bj][m][1] * 0.00390625f + bv[bj][1]) * g;
                        w[2 * bj] = pk4_fp8(v0[0], v0[1], v0[2], v0[3]); w[2 * bj + 1] = pk4_fp8(v1[0], v1[1], v1[2], v1[3]); }
                    *(GAS u32x4*)rowp = w; } }
    }
};
template <> struct BRowMap<EpiY> { static constexpr int HALF_ROWS = 8; __device__ static __forceinline__ int map(int R) { const int wc = R >> 5, i = perm32(R & 31); return 64 * wc + 16 * (i >> 3) + (i & 7); } };
struct EpiLogit {
    static constexpr bool PERM = false;
    GAS float* logit; const GAS float* br;
    __device__ __forceinline__ void operator()(AccRef acc, const Unit& u, int wr, int wc, int fr, int fq) const {
        if (wc != 0) return;
        const int row0 = u.pm * BM + wr * 64 + fr;
        const f32x4 b0 = *(const GAS f32x4*)(br + 4 * fq), b1 = *(const GAS f32x4*)(br + 16 + 4 * fq);
#pragma unroll
        for (int ai = 0; ai < 2; ++ai)
#pragma unroll
            for (int m = 0; m < 4; ++m) { GAS float* rp = logit + (size_t)(row0 + ai * HALF + m * 16) * NEXP + 4 * fq;
                *(GAS f32x4*)rp = acc[ai][0][m][0] + b0; *(GAS f32x4*)(rp + 16) = acc[ai][0][m][1] + b1; }
    }
};
}

#define XB_TMO      128
#define XB_XCNT(j)  (256  + 64 * (j))
#define XB_XSUB(j)  (1280 + 64 * (j))
#define XB_XGEN(j)  (2304 + 64 * (j))
#define XB_TOP      3328
#define XB_TOPGEN   3392
#define XCD_BAR_WORDS 3456
#define XB_SPIN_CAP (1u << 18)
__device__ __forceinline__ unsigned xb_ld(unsigned* p)              { return __hip_atomic_load(p, __ATOMIC_RELAXED, __HIP_MEMORY_SCOPE_AGENT); }
__device__ __forceinline__ unsigned xb_add(unsigned* p, unsigned v) { return __hip_atomic_fetch_add(p, v, __ATOMIC_RELAXED, __HIP_MEMORY_SCOPE_AGENT); }
__device__ __forceinline__ unsigned xb_xcc_id() { return (unsigned)__builtin_amdgcn_s_getreg((3 << 11) | 20) & 0xFu; }
#define XB_SPIN(cond, bar) do { unsigned _sp = 0; while (cond) { __builtin_amdgcn_s_sleep(1); \
    if ((++_sp & 255u) == 0u) { if (xb_ld(&(bar)[XB_TMO])) break; if (_sp > XB_SPIN_CAP) { atomicAdd(&(bar)[XB_TMO], 1u); break; } } } } while (0)
struct XcdBarrier { unsigned* bar; unsigned x; volatile LAS unsigned* st; };
__device__ __forceinline__ XcdBarrier xcd_barrier_post(unsigned* bar, volatile LAS unsigned* st, bool leader) {
    XcdBarrier b; b.bar = bar; b.x = xb_xcc_id(); b.st = st;
    if (leader) (void)xb_add(&bar[XB_XCNT(b.x)], 1u);
    return b;
}
__device__ __forceinline__ void xcd_barrier_complete(unsigned* bar, unsigned x, unsigned& nloc, unsigned& nx) {
    const unsigned G = gridDim.x * gridDim.y * gridDim.z;
    unsigned sum, cnt, mine, sp = 0u;
    for (;;) {
        sum = 0u; cnt = 0u; mine = 0u;
#pragma unroll
        for (unsigned j = 0; j < 16; ++j) { const unsigned c = xb_ld(&bar[XB_XCNT(j)]); sum += c; cnt += (c > 0u) ? 1u : 0u; mine = (j == x) ? c : mine; }
        if (sum == G) break;
        __builtin_amdgcn_s_sleep(1);
        if ((++sp & 255u) == 0u) { if (xb_ld(&bar[XB_TMO])) break; if (sp > XB_SPIN_CAP) { atomicAdd(&bar[XB_TMO], 1u); break; } }
    }
    nloc = mine > 0u ? mine : 1u; nx = cnt > 0u ? cnt : 1u;
}
__device__ __forceinline__ void xcd_barrier(const XcdBarrier& b, bool leader) {
    asm volatile("s_waitcnt vmcnt(0)" ::: "memory");
    __syncthreads();
    if (leader) {
        unsigned* bar = b.bar;
        __builtin_amdgcn_s_waitcnt(0);
        unsigned nloc = b.st[0], nx = b.st[1];
        if (nloc == 0u) { xcd_barrier_complete(bar, b.x, nloc, nx); b.st[0] = nloc; b.st[1] = nx; }
        const unsigned old = xb_add(&bar[XB_XSUB(b.x)], 1u);
        const unsigned gen = old / nloc;
        if (old + 1u == (gen + 1u) * nloc) {
            __builtin_amdgcn_fence(__ATOMIC_RELEASE, "agent");
            asm volatile("s_waitcnt vmcnt(0)" ::: "memory");
            const unsigned og = xb_add(&bar[XB_TOP], 1u);
            const unsigned tg = og / nx;
            if (og + 1u == (tg + 1u) * nx) xb_add(&bar[XB_TOPGEN], 1u);
            else XB_SPIN(xb_ld(&bar[XB_TOPGEN]) == tg, bar);
            __builtin_amdgcn_fence(__ATOMIC_ACQUIRE, "agent");
            xb_add(&bar[XB_XGEN(b.x)], 1u);
            asm volatile("s_waitcnt vmcnt(0)" ::: "memory");
        } else {
            XB_SPIN(xb_ld(&bar[XB_XGEN(b.x)]) == gen, bar);
            __builtin_amdgcn_fence(__ATOMIC_ACQUIRE, "agent");
            asm volatile("s_waitcnt vmcnt(0)" ::: "memory");
        }
    }
    __syncthreads();
}

struct Frame {
    LAS unsigned char* lds;
    int tid, lane, wave, vcu, G;
    const float *x, *c; const int* pos; const float *w_ada, *b_ada, *g_mix, *w_in, *conv_w, *conv_b, *w_a, *b_a, *w_x, *b_x, *lam, *g_q_lat, *w_uq, *g_kv_lat, *w_ukv, *g_qn, *g_kn, *w_out, *g_ffn, *w_router, *b_router, *w1, *b1, *w2, *b2;
    float* out; unsigned char* ws; unsigned* ctl;
};
#define WSP(type, off) ((type*)(GAS type*)(F.ws + (off)))
#define WSG(type, off) ((GAS type*)(F.ws + (off)))
#define GG(type, p) ((const GAS type*)(p))

__device__ __forceinline__ void p0_mod_rope(Frame& F) {
    LAS float* sc = (LAS float*)F.lds; LAS float* red = (LAS float*)(F.lds + 32768);
    for (int i = F.tid; i < NB * DM; i += 512) { const float v = F.c[i]; sc[i] = v * sigmoidf_(v); }
    __syncthreads();
    float* mod = WSP(float, WS_MOD);
    for (int u = blockIdx.x; u < 192; u += F.G) {
        const int n = u * 32 + (F.lane & 31), k0 = F.wave * 128 + (F.lane >> 5) * 64;
        float acc[8];
#pragma unroll
        for (int b = 0; b < 8; ++b) acc[b] = 0.f;
#pragma unroll 16
        for (int kk = 0; kk < 64; ++kk) { const int k = k0 + kk; const float w = __builtin_nontemporal_load((const GAS float*)F.w_ada + (size_t)k * 6144 + n);
#pragma unroll
            for (int b = 0; b < 8; ++b) acc[b] += sc[b * DM + k] * w; }
#pragma unroll
        for (int b = 0; b < 8; ++b) acc[b] += __shfl_xor(acc[b], 32);
        if (F.lane < 32) {
#pragma unroll
            for (int b = 0; b < 8; ++b) red[(F.wave * 8 + b) * 32 + F.lane] = acc[b]; }
        __syncthreads();
        if (F.tid < 256) { const int b = F.tid >> 5, j = F.tid & 31; float s = 0.f;
#pragma unroll
            for (int w = 0; w < 8; ++w) s += red[(w * 8 + b) * 32 + j];
            mod[b * 6144 + u * 32 + j] = s + F.b_ada[u * 32 + j]; }
        __syncthreads();
    }
    float* ct = WSP(float, WS_COS); float* st = WSP(float, WS_SIN);
    for (int idx = blockIdx.x * 512 + F.tid; idx < T * 16; idx += F.G * 512) {
        const int t = idx >> 4, i = idx & 15; const float freq = exp2f(-(float)i * (13.287712379549449f / 16.0f));
        const float ang = (float)F.pos[t] * freq; double rev = (double)ang * 0.15915494309189535; rev -= floor(rev); const float rv = (float)rev;
        ct[idx] = __builtin_amdgcn_cosf(rv); st[idx] = __builtin_amdgcn_sinf(rv);
    }
}

__device__ __forceinline__ void transpose_item(const float* W, int ldw, int Ks, int scol0, const float* g, bf16* WT, int Kd, int n0, int k0, LAS float* scr, int lane, float cs = 1.0f) {
#pragma unroll 8
    for (int i = 0; i < 32; ++i) { const int kk = 2 * i + (lane >> 5), k = k0 + kk; float v = 0.f;
        if (scol0 >= 0 && k < Ks) { v = W[(size_t)k * ldw + scol0 + (lane & 31)] * cs; if (g) v *= g[k]; }
        scr[kk * 33 + (lane & 31)] = v; }
    LDS_WAIT(); asm volatile("" ::: "memory");
    const int c = lane & 7;
#pragma unroll
    for (int j = 0; j < 4; ++j) { const int n = (lane >> 3) + 8 * j; const LAS float* s = scr + (8 * c) * 33 + n;
        u32x4 o; o.x = pk2(s[0 * 33], s[1 * 33]); o.y = pk2(s[2 * 33], s[3 * 33]); o.z = pk2(s[4 * 33], s[5 * 33]); o.w = pk2(s[6 * 33], s[7 * 33]);
        *(u32x4*)(WT + (size_t)(n0 + n) * Kd + k0 + 8 * c) = o; }
    LDS_WAIT(); asm volatile("" ::: "memory");
}
__device__ __forceinline__ void transpose_item_fp8(const float* W, int ldw, int scol0, unsigned char* WT, int Kd, int n0, int k0, LAS float* scr, int lane) {
    const GAS float* Wg = (const GAS float*)W;
    f32x4 v[8];
#pragma unroll
    for (int i = 0; i < 8; ++i) v[i] = __builtin_nontemporal_load((const GAS f32x4*)(Wg + (size_t)(k0 + 8 * i + (lane >> 3)) * ldw + scol0 + 4 * (lane & 7)));
#pragma unroll
    for (int i = 0; i < 8; ++i) { LAS float* d = scr + (8 * i + (lane >> 3)) * 33 + 4 * (lane & 7); d[0] = v[i][0] * 64.0f; d[1] = v[i][1] * 64.0f; d[2] = v[i][2] * 64.0f; d[3] = v[i][3] * 64.0f; }
    LDS_WAIT(); asm volatile("" ::: "memory");
    const int c = lane & 3;
#pragma unroll
    for (int j = 0; j < 2; ++j) { const int n = (lane >> 2) + 16 * j; const LAS float* s = scr + (16 * c) * 33 + n;
        u32x4 o; o.x = pk4_fp8(s[0 * 33], s[1 * 33], s[2 * 33], s[3 * 33]); o.y = pk4_fp8(s[4 * 33], s[5 * 33], s[6 * 33], s[7 * 33]);
        o.z = pk4_fp8(s[8 * 33], s[9 * 33], s[10 * 33], s[11 * 33]); o.w = pk4_fp8(s[12 * 33], s[13 * 33], s[14 * 33], s[15 * 33]);
        __builtin_nontemporal_store(o, (GAS u32x4*)(WT + (size_t)(n0 + n) * Kd + k0 + 16 * c)); }
    LDS_WAIT(); asm volatile("" ::: "memory");
}
__device__ __forceinline__ void p1_convert_norm(Frame& F) {
    LAS float* scr = (LAS float*)(F.lds + F.wave * 16384);
    const int gw = F.vcu * 8 + F.wave, NGW = F.G * 8;
    constexpr int I_W1 = NEXP * 16 * 64, I_W2 = NEXP * 16 * 32, I_IN = 16 * 48, I_OUT = 16 * 32, I_UQ = 4 * 24, I_UKV = 4 * 32, I_AX = 32;
    constexpr int I_WR = 16 * 8;
    constexpr int NITEMS = I_W1 + I_W2 + I_IN + I_OUT + I_UQ + I_UKV + I_AX + I_WR;
    for (int it = gw; it < NITEMS; it += NGW) {
        int r = it;
        if (r < I_W1) { const int e = r >> 10, q = r & 1023, kb = q >> 6, ng = q & 63; const int pn = ng >> 3, bj = (ng >> 2) & 1, c32 = ng & 3;
            transpose_item_fp8(F.w1 + (size_t)e * 1024 * 2048, 2048, bj * 1024 + 128 * pn + 32 * c32, WSP(unsigned char, WS_W1) + (size_t)e * 2048 * 1024, 1024, ng * 32, kb * 64, scr, F.lane); continue; } r -= I_W1;
        if (r < I_W2) { const int e = r >> 9, q = r & 511, kb = q >> 5, ng = q & 31;
            transpose_item_fp8(F.w2 + (size_t)e * 1024 * 1024, 1024, ng * 32, WSP(unsigned char, WS_W2) + (size_t)e * 1024 * 1024, 1024, ng * 32, kb * 64, scr, F.lane); continue; } r -= I_W2;
        if (r < I_IN) { const int kb = r / 48, ng = r % 48;
            transpose_item(F.w_in, DIN, 1024, ng < 45 ? ng * 32 : -1, nullptr, WSP(bf16, WS_WIN), 1024, ng * 32, kb * 64, scr, F.lane); continue; } r -= I_IN;
        if (r < I_OUT) { const int kb = r >> 5, ng = r & 31;
            transpose_item(F.w_out, 1024, 1024, ng * 32, nullptr, WSP(bf16, WS_WOUT), 1024, ng * 32, kb * 64, scr, F.lane); continue; } r -= I_OUT;
        if (r < I_UQ) { const int kb = r / 24, ng = r % 24;
            transpose_item(F.w_uq, 768, 256, ng * 32, F.g_q_lat, WSP(bf16, WS_WUQ), 256, ng * 32, kb * 64, scr, F.lane); continue; } r -= I_UQ;
        if (r < I_UKV) { const int kb = r >> 5, ng = r & 31; const int pn = ng >> 3, bj = (ng >> 2) & 1, wc = ng & 3; const int head = 2 * pn + (wc & 1);
            transpose_item(F.w_ukv, 1024, 128, head * 128 + (wc < 2 ? 0 : 64) + 32 * bj, F.g_kv_lat, WSP(bf16, WS_WUKV), 256, ng * 32, kb * 64, scr, F.lane); continue; } r -= I_UKV;
        if (r >= I_AX) { r -= I_AX; const int kb = r >> 3, ng = r & 7;
            transpose_item(F.w_router, NEXP, 1024, ng == 0 ? 0 : -1, nullptr, WSP(bf16, WS_WR), 1024, ng * 32, kb * 64, scr, F.lane); continue; }
        { const int g = r >> 4, n = (r >> 1) & 7, ng = r & 1;
            transpose_item((g ? F.w_x : F.w_a) + (size_t)n * 64 * 64, 64, 64, ng * 32, nullptr, WSP(bf16, WS_WAX) + (size_t)(g * 8 + n) * 64 * 64, 64, ng * 32, 0, scr, F.lane, -1.4426950408889634f); }
    }
    const GAS float* mod = WSG(float, WS_MOD); GAS bf16* H = WSG(bf16, WS_H); const GAS float* X = GG(float, F.x); const GAS float* gm = GG(float, F.g_mix);
    for (int m0 = gw * 2; m0 < T; m0 += NGW * 2) {
        const int b = m0 / SEQ;
        f32x4 v[2][4]; float s[2] = {0.f, 0.f};
#pragma unroll
        for (int r = 0; r < 2; ++r)
#pragma unroll
            for (int j = 0; j < 4; ++j) v[r][j] = __builtin_nontemporal_load((const GAS f32x4*)(X + (size_t)(m0 + r) * DM) + F.lane + 64 * j);
#pragma unroll
        for (int r = 0; r < 2; ++r) {
#pragma unroll
            for (int j = 0; j < 4; ++j) s[r] += (v[r][j][0] * v[r][j][0] + v[r][j][1] * v[r][j][1]) + (v[r][j][2] * v[r][j][2] + v[r][j][3] * v[r][j][3]);
            const float rstd = 1.0f / sqrtf(wave_sum(s[r]) * (1.0f / DM) + EPS);
            GAS u32x2* o8 = (GAS u32x2*)(H + (size_t)(m0 + r) * DM) + F.lane;
#pragma unroll
            for (int j = 0; j < 4; ++j) { const int col = 256 * j + 4 * F.lane;
                const f32x4 g = *(const GAS f32x4*)(gm + col), sh = *(const GAS f32x4*)(mod + (size_t)b * 6144 + col), scl = *(const GAS f32x4*)(mod + (size_t)b * 6144 + 1024 + col);
                const f32x4 o = v[r][j] * rstd * g * (scl + 1.0f) + sh;
                u32x2 w; w.x = pk2(o[0], o[1]); w.y = pk2(o[2], o[3]); o8[64 * j] = w; } }
    }
}

constexpr int LRU_XROW = 144, LRU_WL = 15616;
template <bool PASS2>
__device__ __forceinline__ void lru_pass(Frame& F) {
    const int lane = F.lane, n = F.wave, r32 = lane & 31, hi = lane >> 5;
    LAS unsigned char* wl = F.lds + n * LRU_WL; LAS unsigned char* xs = wl; LAS unsigned char* xcs = wl + 5120; LAS float* cw = (LAS float*)(wl + 5120 + 4608); LAS unsigned char* ys = wl + 5120 + 4608 + 1280;
#pragma unroll
    for (int j = 0; j < 4; ++j) cw[j * 64 + lane] = F.conv_w[j * DLRU + 64 * n + lane];
    cw[256 + lane] = F.conv_b[64 * n + lane];
    const GAS bf16* Wt = WSG(bf16, WS_WAX);
    bf16x8 wfa[2][4], wfx[2][4];
#pragma unroll
    for (int oc = 0; oc < 2; ++oc)
#pragma unroll
        for (int ks = 0; ks < 4; ++ks) { wfa[oc][ks] = *(const GAS bf16x8*)(Wt + ((size_t)((0 * 8 + n) * 64 + 32 * oc + r32) * 64 + 16 * ks + 8 * hi)); wfx[oc][ks] = *(const GAS bf16x8*)(Wt + ((size_t)((1 * 8 + n) * 64 + 32 * oc + r32) * 64 + 16 * ks + 8 * hi)); }
    float ba[2], bx[2], sp8[2];
#pragma unroll
    for (int oc = 0; oc < 2; ++oc) { const int ch = 64 * n + 32 * oc + r32; ba[oc] = -1.4426950408889634f * F.b_a[ch]; bx[oc] = -1.4426950408889634f * F.b_x[ch]; sp8[oc] = -8.0f * 1.4426950408889634f * log1pf(expf(-F.lam[ch])); }
    const GAS bf16* Z = WSG(bf16, WS_Z); GAS float* agg = WSG(float, WS_AGG); GAS bf16* MIX = WSG(bf16, WS_MIX);
    const int gw = F.vcu * 8 + F.wave, NGW = F.G * 8;
    for (int pidx = gw >> 3; pidx < NB * 32; pidx += (NGW >> 3)) {
        const int b = pidx >> 5, ttp = pidx & 31; const size_t rowb = (size_t)b * SEQ;
        float c[2] = {0.f, 0.f};
        if constexpr (PASS2) {
            for (int tp0 = 0; tp0 < 2 * ttp; tp0 += 8) {
                f32x2 ah[8][2];
#pragma unroll
                for (int j = 0; j < 8; ++j) { const int tp = (tp0 + j < 2 * ttp) ? tp0 + j : 2 * ttp - 1;
#pragma unroll
                    for (int oc = 0; oc < 2; ++oc) ah[j][oc] = *(const GAS f32x2*)(agg + ((size_t)((b * 64 + tp) * DLRU) + 64 * n + 32 * oc + r32) * 2); }
#pragma unroll
                for (int j = 0; j < 8; ++j) { const bool ok = tp0 + j < 2 * ttp;
#pragma unroll
                    for (int oc = 0; oc < 2; ++oc) c[oc] = ok ? ah[j][oc].x * c[oc] + ah[j][oc].y : c[oc]; } }
        }
#pragma unroll 1
        for (int u2 = 0; u2 < 2; ++u2) {
            const int tt = 2 * ttp + u2, t0 = tt * 64;
            float aprod[2] = {1.f, 1.f};
            if constexpr (!PASS2) { c[0] = 0.f; c[1] = 0.f; }
#pragma unroll 1
            for (int tt2 = 0; tt2 < 2; ++tt2) {
                const int tb = t0 + 32 * tt2;
#pragma unroll
                for (int i = 0; i < 5; ++i) { const int row = i * 8 + (lane >> 3), ch = lane & 7; const int t = tb - 3 + row;
                    if (row < 35) { u32x4 v = (u32x4){0u, 0u, 0u, 0u}; if (t >= 0) v = *(const GAS u32x4*)(Z + (rowb + t) * DINP + 64 * n + ch * 8);
                        *(LAS u32x4*)(xs + row * LRU_XROW + ch * 16) = v; } }
                if constexpr (PASS2) {
#pragma unroll
                    for (int i = 0; i < 4; ++i) { const int row = i * 8 + (lane >> 3), ch = lane & 7;
                        *(LAS u32x4*)(ys + row * LRU_XROW + ch * 16) = *(const GAS u32x4*)(Z + (rowb + tb + row) * DINP + DLRU + 64 * n + ch * 8); }
                }
                bf16x8 af[4];
#pragma unroll
                for (int ks = 0; ks < 4; ++ks) { const int c0 = 16 * ks + 8 * hi;
                    float xc[8];
                    { const f32x4 b0 = *(const LAS f32x4*)(cw + 256 + c0), b1 = *(const LAS f32x4*)(cw + 256 + c0 + 4);
#pragma unroll
                      for (int q = 0; q < 4; ++q) { xc[q] = b0[q]; xc[4 + q] = b1[q]; } }
#pragma unroll
                    for (int j = 0; j < 4; ++j) { const u32x4 xv = *(const LAS u32x4*)(xs + (r32 + j) * LRU_XROW + c0 * 2);
                        const f32x4 w0 = *(const LAS f32x4*)(cw + j * 64 + c0), w1 = *(const LAS f32x4*)(cw + j * 64 + c0 + 4);
                        xc[0] += w0[0] * bflo(xv.x); xc[1] += w0[1] * bfhi(xv.x); xc[2] += w0[2] * bflo(xv.y); xc[3] += w0[3] * bfhi(xv.y);
                        xc[4] += w1[0] * bflo(xv.z); xc[5] += w1[1] * bfhi(xv.z); xc[6] += w1[2] * bflo(xv.w); xc[7] += w1[3] * bfhi(xv.w); }
                    u32x4 pk; pk.x = pk2(xc[0], xc[1]); pk.y = pk2(xc[2], xc[3]); pk.z = pk2(xc[4], xc[5]); pk.w = pk2(xc[6], xc[7]);
                    af[ks] = __builtin_bit_cast(bf16x8, pk);
                    *(LAS u32x4*)(xcs + r32 * LRU_XROW + c0 * 2) = pk; }
#pragma unroll
                for (int oc = 0; oc < 2; ++oc) {
                    asm volatile("" ::: "memory");
                    f32x16 da = {}, dx = {};
#pragma unroll
                    for (int ks = 0; ks < 4; ++ks) { da = __builtin_amdgcn_mfma_f32_32x32x16_bf16(af[ks], wfa[oc][ks], da, 0, 0, 0); dx = __builtin_amdgcn_mfma_f32_32x32x16_bf16(af[ks], wfx[oc][ks], dx, 0, 0, 0); }
                    float av[16], uv[16];
#pragma unroll
                    for (int r = 0; r < 16; ++r) { const int tl = crow(r, hi); const float xcv = bf2f(*(const LAS unsigned short*)(xcs + tl * LRU_XROW + (32 * oc + r32) * 2));
                        const float rg = __builtin_amdgcn_rcpf(1.0f + __builtin_amdgcn_exp2f(da[r] + ba[oc])), ig = __builtin_amdgcn_rcpf(1.0f + __builtin_amdgcn_exp2f(dx[r] + bx[oc])); const float a = __builtin_amdgcn_exp2f(rg * sp8[oc]);
                        av[r] = a; uv[r] = __builtin_amdgcn_sqrtf(fmaxf(1.0f - a * a, 0.f)) * ig * xcv; }
                    float As[4], Hs[4], cin[4];
#pragma unroll
                    for (int g = 0; g < 4; ++g) { float h = uv[4 * g]; float ap = av[4 * g];
#pragma unroll
                        for (int q = 1; q < 4; ++q) { h = av[4 * g + q] * h + uv[4 * g + q]; ap *= av[4 * g + q]; }
                        As[g] = ap; Hs[g] = h; }
                    float crun = c[oc];
#pragma unroll
                    for (int g = 0; g < 4; ++g) { const float o0 = As[g] * crun + Hs[g]; const float mid = __shfl_xor(o0, 32); const float ci = hi ? mid : crun; const float o1 = As[g] * ci + Hs[g];
                        const float fin = __shfl_xor(o1, 32); crun = hi ? o1 : fin; cin[g] = ci; }
                    c[oc] = crun;
                    if constexpr (!PASS2) { aprod[oc] *= (As[0] * As[1]) * (As[2] * As[3]); }
                    else {
#pragma unroll
                        for (int g = 0; g < 4; ++g) { float h = cin[g];
#pragma unroll
                            for (int q = 0; q < 4; ++q) { const int r = 4 * g + q; h = av[r] * h + uv[r];
                                LAS unsigned short* yp = (LAS unsigned short*)(ys + crow(r, hi) * LRU_XROW + (32 * oc + r32) * 2);
                                const float y = bf2f(*yp); const float ge = y * __builtin_amdgcn_rcpf(1.0f + __builtin_amdgcn_exp2f(y * (-2.3022082f + -0.1029432f * (y * y))));
                                *yp = (unsigned short)f2bf(ge * h); } }
                    }
                }
                if constexpr (PASS2) {
#pragma unroll
                    for (int i = 0; i < 4; ++i) { const int row = i * 8 + (lane >> 3), ch = lane & 7;
                        *(GAS u32x4*)(MIX + (rowb + tb + row) * DM + 64 * n + ch * 8) = *(const LAS u32x4*)(ys + row * LRU_XROW + ch * 16); }
                }
            }
            if constexpr (!PASS2) {
#pragma unroll
                for (int oc = 0; oc < 2; ++oc) { const float at = aprod[oc] * __shfl_xor(aprod[oc], 32);
                    if (hi == 0) *(GAS f32x2*)(agg + ((size_t)((b * 64 + tt) * DLRU) + 64 * n + 32 * oc + r32) * 2) = (f32x2){at, c[oc]}; }
            }
        }
    }
}

namespace att {
constexpr int KROW = 208, KTB = 64 * KROW, VROW = 192, VTB = 64 * VROW;
constexpr int OFF_K = 0, OFF_V = 2 * KTB, OFF_Q = 2 * KTB + 3 * VTB;
typedef short s16x4 __attribute__((ext_vector_type(4)));
__device__ __forceinline__ s16x4 vtr(const LAS unsigned char* p) { return __builtin_bit_cast(s16x4, __builtin_amdgcn_ds_read_tr16_b64_v4i16((LAS s16x4*)p)); }
__device__ __forceinline__ void unit(Frame& F, int b, int h, int qb, float MB) {
    const int tid = F.tid, lane = F.lane, w = F.wave, r32 = lane & 31, hi = lane >> 5;
    const GAS bf16* Qb = WSG(bf16, WS_Q); const GAS bf16* Kb = WSG(bf16, WS_K); const GAS bf16* Vb = WSG(bf16, WS_V); GAS bf16* MIX = WSG(bf16, WS_MIX);
    const GAS float* ct = WSG(float, WS_COS); const GAS float* st = WSG(float, WS_SIN); const GAS float* gqn = GG(float, F.g_qn);
    const size_t rowb = (size_t)b * SEQ; const int qrow = qb * 256 + w * 32 + r32; const size_t gr = rowb + qrow;
    bf16x8 qr[6];
    {
        float qf[6][8]; float ss = 0.f;
#pragma unroll
        for (int ks = 0; ks < 6; ++ks) { const u32x4 v = *(const GAS u32x4*)(Qb + gr * 768 + h * QKH + 16 * ks + 8 * hi);
            qf[ks][0] = bflo(v.x); qf[ks][1] = bfhi(v.x); qf[ks][2] = bflo(v.y); qf[ks][3] = bfhi(v.y); qf[ks][4] = bflo(v.z); qf[ks][5] = bfhi(v.z); qf[ks][6] = bflo(v.w); qf[ks][7] = bfhi(v.w);
#pragma unroll
            for (int j = 0; j < 8; ++j) ss += qf[ks][j] * qf[ks][j]; }
        ss += __shfl_xor(ss, 32);
        const float rs = __builtin_amdgcn_rsqf(ss * (1.0f / QKH) + EPS);
#pragma unroll
        for (int ks = 0; ks < 6; ++ks)
#pragma unroll
            for (int j = 0; j < 8; ++j) qf[ks][j] *= rs * gqn[16 * ks + 8 * hi + j];
#pragma unroll
        for (int j = 0; j < 8; ++j) { const float cs = ct[gr * 16 + 8 * hi + j], sn = st[gr * 16 + 8 * hi + j]; const float a = qf[4][j], bb = qf[5][j]; qf[4][j] = a * cs - bb * sn; qf[5][j] = bb * cs + a * sn; }
        const float sc = 0.10206207261596575f * 1.4426950408889634f;
#pragma unroll
        for (int ks = 0; ks < 6; ++ks) { u32x4 pk; pk.x = pk2(qf[ks][0] * sc, qf[ks][1] * sc); pk.y = pk2(qf[ks][2] * sc, qf[ks][3] * sc); pk.z = pk2(qf[ks][4] * sc, qf[ks][5] * sc); pk.w = pk2(qf[ks][6] * sc, qf[ks][7] * sc);
            qr[ks] = __builtin_bit_cast(bf16x8, pk); }
    }
    LAS unsigned char* qlds = F.lds + OFF_Q + w * 6144 + hi * 512 + r32 * 16;
#pragma unroll
    for (int ks = 0; ks < 6; ++ks) *(LAS bf16x8*)(qlds + ks * 1024) = qr[ks];
    const int NT = 4 * (qb + 1);
    const int kr1 = tid / 12, kc1 = tid % 12, kr2 = (512 + tid) / 12, kc2 = (512 + tid) % 12; const bool k2 = tid < 256;
    const int vr = tid >> 3, vc = tid & 7;
    const GAS char* kbase = (const GAS char*)(Kb + rowb * 768 + h * QKH); const GAS char* vbase_g = (const GAS char*)(Vb + rowb * 512 + h * VH);
    const unsigned ko1 = (unsigned)(kr1 * 768 + kc1 * 8) * 2u, ko2 = (unsigned)(kr2 * 768 + kc2 * 8) * 2u, vo1 = (unsigned)(vr * 512 + vc * 8) * 2u;
    LAS unsigned char* L = F.lds;
    u32x4 skA1, skA2 = (u32x4){0u, 0u, 0u, 0u}, svA;
#define ATT_BAR() do { __builtin_amdgcn_sched_barrier(0); asm volatile("s_waitcnt lgkmcnt(0)" ::: "memory"); __builtin_amdgcn_s_barrier(); asm volatile("" ::: "memory"); __builtin_amdgcn_sched_barrier(0); } while (0)
#define ATT_LOADK(X, t) do { const GAS char* kt_ = kbase + (size_t)(t) * (64 * 768 * 2); sk##X##1 = *(const GAS u32x4*)(kt_ + ko1); if (k2) sk##X##2 = *(const GAS u32x4*)(kt_ + ko2); } while (0)
#define ATT_LOADV(X, t) do { sv##X = *(const GAS u32x4*)(vbase_g + (size_t)(t) * (64 * 512 * 2) + vo1); } while (0)
#define ATT_WRITEK(X, buf) do { *(LAS u32x4*)(L + OFF_K + (buf) * KTB + kr1 * KROW + kc1 * 16) = sk##X##1; if (k2) *(LAS u32x4*)(L + OFF_K + (buf) * KTB + kr2 * KROW + kc2 * 16) = sk##X##2; } while (0)
#define ATT_WRITEV(X, voff) do { *(LAS u32x4*)(L + OFF_V + (voff) + vr * VROW + vc * 16) = sv##X; } while (0)
#define ATT_QK(S0, S1, buf) do { const LAS unsigned char* kb_ = L + OFF_K + (buf) * KTB + r32 * KROW + hi * 16; \
        _Pragma("unroll") for (int ks = 0; ks < 6; ++ks) { const bf16x8 a0 = *(const LAS bf16x8*)(kb_ + ks * 32), a1 = *(const LAS bf16x8*)(kb_ + 32 * KROW + ks * 32); \
            const bf16x8 qv = *(const LAS bf16x8*)(qlds + ks * 1024); \
            if (ks == 0) { S0 = __builtin_amdgcn_mfma_f32_32x32x16_bf16(a0, qv, f32x16{}, 0, 0, 0); S1 = __builtin_amdgcn_mfma_f32_32x32x16_bf16(a1, qv, f32x16{}, 0, 0, 0); } \
            else { S0 = __builtin_amdgcn_mfma_f32_32x32x16_bf16(a0, qv, S0, 0, 0, 0); S1 = __builtin_amdgcn_mfma_f32_32x32x16_bf16(a1, qv, S1, 0, 0, 0); } } } while (0)
#define ATT_PV(voff) do { const LAS unsigned char* vb = vbase + (voff); \
        _Pragma("unroll") for (int s4 = 0; s4 < 4; ++s4) { const bf16x8 pfv = __builtin_bit_cast(bf16x8, pf[s4]); \
            _Pragma("unroll") for (int d = 0; d < 2; ++d) { const LAS unsigned char* vp = vb + (16 * s4) * VROW + (32 * d) * 2; \
                const s16x4 lo = vtr(vp), hh = vtr(vp + 8 * VROW); \
                const bf16x8 vv = __builtin_shufflevector(lo, hh, 0, 1, 2, 3, 4, 5, 6, 7); \
                o[d] = __builtin_amdgcn_mfma_f32_32x32x16_bf16(vv, pfv, o[d], 0, 0, 0); } } } while (0)
    const float sh = fmaxf(MB - 100.0f, 0.f);
    { u32x4 skT1, skT2 = (u32x4){0u, 0u, 0u, 0u};
      ATT_LOADK(A, 0); ATT_LOADV(A, 0); ATT_LOADK(T, 1); ATT_WRITEK(A, 0); ATT_WRITEV(A, 0); ATT_WRITEK(T, 1); }
    for (int i = tid; i < VTB / 8; i += 512) *(LAS u32x2*)(L + OFF_V + 2 * VTB + i * 8) = (u32x2){0u, 0u};
    ATT_LOADK(A, 2); ATT_LOADV(A, 1);
    ATT_BAR();
    float lsum = 0.f; f32x16 o[2]; o[0] = f32x16{}; o[1] = f32x16{};
    const int wq_max = qb * 256 + w * 32 + 31;
    f32x16 pa0, pa1, pb0 = f32x16{}, pb1 = f32x16{};
    u32x4 pf[4]; pf[0] = pf[1] = pf[2] = pf[3] = (u32x4){0u, 0u, 0u, 0u};
    ATT_QK(pa0, pa1, 0);
    const LAS unsigned char* vbase = L + OFF_V + (4 * hi + ((lane & 15) >> 2)) * VROW + (16 * ((lane >> 4) & 1) + 4 * (lane & 3)) * 2;
    int vprev = 2 * VTB, vcur = 0, vnext = VTB;
#ifndef ATT_DUP
#define ATT_DUP 0
#endif
#ifndef ATT_HINT_MODE
#define ATT_HINT_MODE 3
#endif
#if ATT_HINT_MODE == 0
#define ATT_HINT(C) do {} while (0)
#elif ATT_HINT_MODE == 1
#define ATT_HINT(C) do { if (C) { _Pragma("unroll") for (int i_ = 0; i_ < 20; ++i_) { __builtin_amdgcn_sched_group_barrier(0x008, 1, 0); __builtin_amdgcn_sched_group_barrier(0x002, 5, 0); } } } while (0)
#elif ATT_HINT_MODE == 3
#define ATT_HINT(C) do { if (C) { __builtin_amdgcn_sched_group_barrier(0x100, 6, 0); \
        _Pragma("unroll") for (int i_ = 0; i_ < 6; ++i_) { __builtin_amdgcn_sched_group_barrier(0x008, 1, 0); __builtin_amdgcn_sched_group_barrier(0x002, 5, 0); __builtin_amdgcn_sched_group_barrier(0x008, 1, 0); __builtin_amdgcn_sched_group_barrier(0x100, 3, 0); __builtin_amdgcn_sched_group_barrier(0x002, 5, 0); } \
        _Pragma("unroll") for (int i_ = 0; i_ < 8; ++i_) { __builtin_amdgcn_sched_group_barrier(0x008, 1, 0); __builtin_amdgcn_sched_group_barrier(0x100, 2, 0); __builtin_amdgcn_sched_group_barrier(0x002, 6, 0); } } } while (0)
#elif ATT_HINT_MODE == 2
#define ATT_HINT(C) do { if (C) { __builtin_amdgcn_sched_group_barrier(0x100, 18, 0); \
        _Pragma("unroll") for (int i_ = 0; i_ < 12; ++i_) { __builtin_amdgcn_sched_group_barrier(0x008, 1, 0); if (i_ < 8) __builtin_amdgcn_sched_group_barrier(0x100, 2, 0); __builtin_amdgcn_sched_group_barrier(0x002, 4, 0); } \
        _Pragma("unroll") for (int i_ = 0; i_ < 8; ++i_) { __builtin_amdgcn_sched_group_barrier(0x008, 1, 0); __builtin_amdgcn_sched_group_barrier(0x002, 6, 0); } } } while (0)
#endif
#define ATT_STEP(t, P0, P1, N0, N1, CLEAN) do { const int buf = (t) & 1; \
        if (CLEAN || (((t) + 1 < NT) && (64 * ((t) + 1) <= wq_max))) ATT_QK(N0, N1, buf ^ 1); \
        if (CLEAN || (64 * ((t) - 1) <= wq_max)) ATT_PV(vprev); \
        if (CLEAN || (64 * (t) <= wq_max)) { \
            if (!CLEAN && (t) >= 4 * qb) { const int kv0 = 64 * (t) + 4 * hi; \
                _Pragma("unroll") for (int r = 0; r < 16; ++r) { const int kv = kv0 + (r & 3) + 8 * (r >> 2); if (kv > qrow) P0[r] = -1e30f; if (kv + 32 > qrow) P1[r] = -1e30f; } } \
            if (!CLEAN) { if (sh > 0.f) { _Pragma("unroll") for (int r = 0; r < 16; ++r) { P0[r] -= sh; P1[r] -= sh; } } } \
            f32x2 ps0 = {0.f, 0.f}, ps1 = {0.f, 0.f}, ps2 = {0.f, 0.f}, ps3 = {0.f, 0.f};     \
            _Pragma("unroll") for (int r = 0; r < 16; ++r) { P0[r] = __builtin_amdgcn_exp2f(P0[r]); P1[r] = __builtin_amdgcn_exp2f(P1[r]); } \
            _Pragma("unroll") for (int r = 0; r < 16; r += 4) { ps0 += (f32x2){P0[r], P0[r + 1]}; ps1 += (f32x2){P0[r + 2], P0[r + 3]}; ps2 += (f32x2){P1[r], P1[r + 1]}; ps3 += (f32x2){P1[r + 2], P1[r + 3]}; } \
            { const f32x2 pt = (ps0 + ps1) + (ps2 + ps3); lsum += pt.x + pt.y; } \
            _Pragma("unroll") for (int s = 0; s < 2; ++s) { \
                pf[s].x = cvt_pk_bf16(P0[8 * s + 0], P0[8 * s + 1]); pf[s].y = cvt_pk_bf16(P0[8 * s + 2], P0[8 * s + 3]); pf[s].z = cvt_pk_bf16(P0[8 * s + 4], P0[8 * s + 5]); pf[s].w = cvt_pk_bf16(P0[8 * s + 6], P0[8 * s + 7]); \
                pf[2 + s].x = cvt_pk_bf16(P1[8 * s + 0], P1[8 * s + 1]); pf[2 + s].y = cvt_pk_bf16(P1[8 * s + 2], P1[8 * s + 3]); pf[2 + s].z = cvt_pk_bf16(P1[8 * s + 4], P1[8 * s + 5]); pf[2 + s].w = cvt_pk_bf16(P1[8 * s + 6], P1[8 * s + 7]); } \
        } else { pf[0] = pf[1] = pf[2] = pf[3] = (u32x4){0u, 0u, 0u, 0u}; } \
        ATT_HINT(CLEAN); \
        ATT_WRITEK(A, buf); \
        ATT_WRITEV(A, vnext); \
        if (ATT_DUP && CLEAN) { asm volatile("" ::: "memory"); ATT_WRITEK(A, buf); ATT_WRITEV(A, vnext); asm volatile("" ::: "memory"); \
            ATT_LOADK(A, ((t) + 3 < NT) ? (t) + 3 : NT - 1); ATT_LOADV(A, ((t) + 2 < NT) ? (t) + 2 : NT - 1); asm volatile("" : "+v"(skA1), "+v"(skA2), "+v"(svA)); } \
        ATT_LOADK(A, ((t) + 3 < NT) ? (t) + 3 : NT - 1); \
        ATT_LOADV(A, ((t) + 2 < NT) ? (t) + 2 : NT - 1); \
        ATT_BAR(); \
        { const int tmp_ = vprev; vprev = vcur; vcur = vnext; vnext = tmp_; } } while (0)
    int t = 0;
    if (sh == 0.f) for (; t < 4 * qb; t += 2) { ATT_STEP(t, pa0, pa1, pb0, pb1, 1); ATT_STEP(t + 1, pb0, pb1, pa0, pa1, 1); }
    for (; t < NT; t += 2) { ATT_STEP(t, pa0, pa1, pb0, pb1, 0); ATT_STEP(t + 1, pb0, pb1, pa0, pa1, 0); }
    if (64 * (NT - 1) <= wq_max) ATT_PV(vprev);
    ATT_BAR();
#undef ATT_STEP
#undef ATT_HINT
#undef ATT_BAR
#undef ATT_PV
#undef ATT_LOADK
#undef ATT_LOADV
#undef ATT_WRITEK
#undef ATT_WRITEV
#undef ATT_QK
    lsum += __shfl_xor(lsum, 32);
    const float inv = 1.0f / lsum;
    GAS bf16* op = MIX + gr * DM + DLRU + h * VH;
#pragma unroll
    for (int d = 0; d < 2; ++d)
#pragma unroll
        for (int g = 0; g < 4; ++g) { u32x2 wv; wv.x = cvt_pk_bf16(o[d][4 * g] * inv, o[d][4 * g + 1] * inv); wv.y = cvt_pk_bf16(o[d][4 * g + 2] * inv, o[d][4 * g + 3] * inv);
            *(GAS u32x2*)(op + 32 * d + 8 * g + 4 * hi) = wv; }
}
__device__ __forceinline__ void phase(Frame& F) {
    float gq = 0.f, gk = 0.f;
    for (int i = 0; i < QKH; ++i) { gq = fmaxf(gq, fabsf(F.g_qn[i])); gk = fmaxf(gk, fabsf(F.g_kn[i])); }
    const float MB = 9.797958971f * 1.4426950408889634f * gq * gk * 1.02f;
    for (int pi = F.vcu; pi < 512; pi += F.G) {
        const int bh = pi >> 3, s = pi & 7;
        unit(F, bh >> 3, bh & 7, 15 - s, MB);
        unit(F, bh >> 3, bh & 7, s, MB);
    }
}
}

__device__ __forceinline__ void p6a_norm(Frame& F) {
    const GAS float* mod = WSG(float, WS_MOD); GAS unsigned char* H2 = WSG(unsigned char, WS_H2); GAS bf16* H2B = WSG(bf16, WS_H2B);
    const GAS float* gf = GG(float, F.g_ffn); const GAS bf16* X1 = WSG(bf16, WS_X1B);
    const int gw = F.vcu * 8 + F.wave, NGW = F.G * 8, lane = F.lane;
    for (int m0 = gw * 2; m0 < T; m0 += NGW * 2) {
        const int b = m0 / SEQ;
        u32x4 xr[2][2];
#pragma unroll
        for (int r = 0; r < 2; ++r)
#pragma unroll
            for (int h = 0; h < 2; ++h) xr[r][h] = *(const GAS u32x4*)(X1 + (size_t)(m0 + r) * DM + 16 * lane + 8 * h);
        f32x4 G[4], S[4];
#pragma unroll
        for (int q = 0; q < 4; ++q) { const int col = 16 * lane + 4 * q; const f32x4 g = *(const GAS f32x4*)(gf + col), sc = *(const GAS f32x4*)(mod + (size_t)b * 6144 + 4096 + col);
            G[q] = g * (sc + 1.0f); S[q] = *(const GAS f32x4*)(mod + (size_t)b * 6144 + 3072 + col); }
#pragma unroll
        for (int r = 0; r < 2; ++r) { f32x4 v[4];
#pragma unroll
            for (int h = 0; h < 2; ++h) { v[2 * h] = (f32x4){bflo(xr[r][h].x), bfhi(xr[r][h].x), bflo(xr[r][h].y), bfhi(xr[r][h].y)}; v[2 * h + 1] = (f32x4){bflo(xr[r][h].z), bfhi(xr[r][h].z), bflo(xr[r][h].w), bfhi(xr[r][h].w)}; }
            float s = 0.f;
#pragma unroll
            for (int q = 0; q < 4; ++q) s += (v[q][0] * v[q][0] + v[q][1] * v[q][1]) + (v[q][2] * v[q][2] + v[q][3] * v[q][3]);
            const float rstd = 1.0f / sqrtf(wave_sum(s) * (1.0f / DM) + EPS);
            u32x4 o8, ob[2];
#pragma unroll
            for (int q = 0; q < 4; ++q) { const f32x4 hv = v[q] * rstd * G[q] + S[q];
                o8[q] = pk4_fp8(hv[0], hv[1], hv[2], hv[3]);
                ob[q >> 1][2 * (q & 1)] = cvt_pk_bf16(hv[0], hv[1]); ob[q >> 1][2 * (q & 1) + 1] = cvt_pk_bf16(hv[2], hv[3]); }
            *(GAS u32x4*)(H2 + (size_t)(m0 + r) * DM + 16 * lane) = o8;
            *(GAS u32x4*)(H2B + (size_t)(m0 + r) * DM + 16 * lane) = ob[0]; *(GAS u32x4*)(H2B + (size_t)(m0 + r) * DM + 16 * lane + 8) = ob[1]; }
    }
}
__device__ __forceinline__ void p6c_topk(Frame& F) {
    LAS int* hist = (LAS int*)(F.lds + TAB_OFF); LAS int* base = hist + 32;
    const GAS float* logit = WSG(float, WS_LOGIT); GAS int* list = WSG(int, WS_LIST); GAS float* gates = WSG(float, WS_GATES);
    unsigned* gcount = F.ctl + CW_CNT;
    for (int chunk = blockIdx.x; chunk < T / 128; chunk += F.G) {
        if (F.tid < 32) hist[F.tid] = 0;
        __syncthreads();
        const int row = chunk * 128 + F.tid; const bool act = F.tid < 128;
        int se[4] = {0, 0, 0, 0}, lp[4] = {0, 0, 0, 0}; float gk[4] = {0.f, 0.f, 0.f, 0.f};
        if (act) {
            float v[32];
#pragma unroll
            for (int q = 0; q < 8; ++q) { const f32x4 t = *(const GAS f32x4*)(logit + (size_t)row * NEXP + 4 * q); v[4 * q] = t[0]; v[4 * q + 1] = t[1]; v[4 * q + 2] = t[2]; v[4 * q + 3] = t[3]; }
            float sv[4];
#pragma unroll
            for (int k = 0; k < 4; ++k) { float best = v[0]; int bi = 0;
#pragma unroll
                for (int e = 1; e < 32; ++e) { const bool gt = v[e] > best; best = gt ? v[e] : best; bi = gt ? e : bi; }
                sv[k] = best; se[k] = bi;
#pragma unroll
                for (int e = 0; e < 32; ++e) v[e] = (e == bi) ? -3.0e38f : v[e]; }
            const float t1 = fast_exp(sv[1] - sv[0]), t2 = fast_exp(sv[2] - sv[0]), t3 = fast_exp(sv[3] - sv[0]); const float rinv = 1.0f / (1.0f + t1 + t2 + t3);
            gk[0] = rinv; gk[1] = t1 * rinv; gk[2] = t2 * rinv; gk[3] = t3 * rinv;
#pragma unroll
            for (int k = 0; k < 4; ++k) lp[k] = __hip_atomic_fetch_add(hist + se[k], 1, __ATOMIC_RELAXED, __HIP_MEMORY_SCOPE_WORKGROUP);
        }
        __syncthreads();
        if (F.tid < 32) base[F.tid] = (int)__hip_atomic_fetch_add(gcount + F.tid, (unsigned)hist[F.tid], RLX_AGENT);
        __syncthreads();
        if (act) {
#pragma unroll
            for (int k = 0; k < 4; ++k) { const int ent = row * 4 + k; list[(size_t)se[k] * T + base[se[k]] + lp[k]] = ent; gates[ent] = gk[k]; }
        }
        __syncthreads();
    }
}

__device__ __forceinline__ void moe_tables(Frame& F) {
    LAS int* tab = (LAS int*)(F.lds + TAB_OFF);
    if (F.tid == 0) { int acc = 0;
        for (int e = 0; e < NEXP; ++e) { const int c = (int)__hip_atomic_load(F.ctl + CW_CNT + e, RLX_AGENT); tab[e] = acc; tab[33 + e] = c; acc += (c + 255) >> 8; }
        tab[32] = acc; }
    __syncthreads();
}

__device__ __forceinline__ void p9_combine(Frame& F) {
    const GAS float* mod = WSG(float, WS_MOD); const GAS unsigned char* Y4 = WSG(unsigned char, WS_Y4); GAS float* O = (GAS float*)F.out; const GAS bf16* X1 = WSG(bf16, WS_X1B);
    const int gw = F.vcu * 8 + F.wave, NGW = F.G * 8, lane = F.lane;
    for (int m0 = gw * 2; m0 < T; m0 += NGW * 2) {
        const int b = m0 / SEQ;
        u32x4 y[2][4], xr[2][2];
#pragma unroll
        for (int r = 0; r < 2; ++r) {
#pragma unroll
            for (int k = 0; k < 4; ++k) y[r][k] = *(const GAS u32x4*)(Y4 + ((size_t)(m0 + r) * 4 + k) * DM + 16 * lane);
#pragma unroll
            for (int h = 0; h < 2; ++h) xr[r][h] = *(const GAS u32x4*)(X1 + (size_t)(m0 + r) * DM + 16 * lane + 8 * h); }
        f32x4 g2[4];
#pragma unroll
        for (int q = 0; q < 4; ++q) g2[q] = *(const GAS f32x4*)(mod + (size_t)b * 6144 + 5120 + 16 * lane + 4 * q) * 0.0625f;
#pragma unroll
        for (int r = 0; r < 2; ++r)
#pragma unroll
            for (int q = 0; q < 4; ++q) { f32x4 s = (f32x4){0.f, 0.f, 0.f, 0.f};
#pragma unroll
                for (int k = 0; k < 4; ++k) { const int w = (int)y[r][k][q]; const f32x2 lo = __builtin_amdgcn_cvt_pk_f32_fp8(w, false), hi2 = __builtin_amdgcn_cvt_pk_f32_fp8(w, true); s[0] += lo[0]; s[1] += lo[1]; s[2] += hi2[0]; s[3] += hi2[1]; }
                const unsigned w0 = xr[r][q >> 1][2 * (q & 1)], w1 = xr[r][q >> 1][2 * (q & 1) + 1];
                const f32x4 xv = (f32x4){bflo(w0), bfhi(w0), bflo(w1), bfhi(w1)};
                *(GAS f32x4*)(O + (size_t)(m0 + r) * DM + 16 * lane + 4 * q) = xv + g2[q] * s; }
    }
}

struct Args { const void* in[28]; float* out; unsigned char* ws; int ph_lo, ph_hi; };
__global__ void __launch_bounds__(512, 2) mega_fwd(Args args) {
    extern __shared__ __attribute__((aligned(16))) unsigned char lds_raw[];
    Frame F;
    F.lds = (LAS unsigned char*)lds_raw;
    F.wave = __builtin_amdgcn_readfirstlane((int)threadIdx.x >> 6); F.lane = lane_id(); F.tid = F.wave * 64 + F.lane;
    F.G = gridDim.x; { const int bx = blockIdx.x; F.vcu = (F.G % 8 == 0) ? (bx % 8) * (F.G / 8) + bx / 8 : bx; }
    F.x = F.c = F.w_ada = F.b_ada = F.g_mix = F.w_in = F.conv_w = F.conv_b = F.w_a = F.b_a = F.w_x = F.b_x = F.lam = F.g_q_lat = F.w_uq = F.g_kv_lat = F.w_ukv = F.g_qn = F.g_kn = F.w_out = F.g_ffn = F.w_router = F.b_router = F.w1 = F.b1 = F.w2 = F.b2 = nullptr; F.pos = nullptr;
#define LDIN(field, idx) F.field = (decltype(F.field))(GAS void*)args.in[idx]
#define PH_BEGIN() do { unsigned char* w_ = args.ws; asm volatile("" : "+s"(w_)); F.ws = (unsigned char*)(GAS unsigned char*)w_; F.ctl = (unsigned*)(F.ws + WS_CTL); F.lane = lane_id(); F.tid = F.wave * 64 + F.lane; } while (0)
    F.out = (float*)(GAS float*)args.out; F.ws = (unsigned char*)(GAS unsigned char*)args.ws; F.ctl = (unsigned*)(F.ws + WS_CTL);
    for (int u = F.tid; u < (LDS_BYTES - LDSCTL_OFF) / 4; u += 512) ((LAS unsigned*)(F.lds + LDSCTL_OFF))[u] = 0u;
    __syncthreads();
    const int lo = args.ph_lo, hi = args.ph_hi;
    const bool multi = (hi - lo) > 1;
    XcdBarrier bar; bar.bar = F.ctl + CW_BAR; bar.x = 0; bar.st = nullptr;
    if (multi) bar = xcd_barrier_post(F.ctl + CW_BAR, (volatile LAS unsigned*)(F.lds + MISC_OFF), F.tid == 0);
#ifndef PH_MASK
#define PH_MASK 0xfff
#endif
#define IN(k) ((((PH_MASK) >> (k)) & 1) && lo <= (k) && (k) < hi)
#define LEADER() (F.wave == 0 && lane_id() == 0)
#define SEAM(k) do { if (IN(k) && IN((k) + 1)) xcd_barrier(bar, LEADER()); } while (0)

    if (IN(0)) { PH_BEGIN(); LDIN(c, 1); LDIN(pos, 2); LDIN(w_ada, 3); LDIN(b_ada, 4); p0_mod_rope(F); SEAM(0); }
    if (IN(1)) { PH_BEGIN(); LDIN(x, 0); LDIN(g_mix, 5); LDIN(w_in, 6); LDIN(w_router, 22); LDIN(w_a, 9); LDIN(w_x, 11); LDIN(g_q_lat, 14); LDIN(w_uq, 15); LDIN(g_kv_lat, 16); LDIN(w_ukv, 17); LDIN(w_out, 20); LDIN(w1, 24); LDIN(w2, 26);
        p1_convert_norm(F); SEAM(1); }
    if (IN(2)) { PH_BEGIN();
        pg8::DenseSched S; S.init(WSG(bf16, WS_H), DM, WSG(bf16, WS_WIN), DM, T, DINP, F.G, (int)blockIdx.x);
        pg8::EpiZ E{WSG(bf16, WS_Z), WSG(float, WS_SSQ)};
        pg8::gemm_phase<pg8::EpiZ, pg8::DenseSched, true>(F.lds, DM * 2, S, E, F.wave);
        SEAM(2);
    }
    if (IN(3)) { PH_BEGIN();
        LDIN(conv_w, 7); LDIN(conv_b, 8); LDIN(b_a, 10); LDIN(b_x, 12); LDIN(lam, 13); LDIN(g_kn, 19);
#ifndef P3_PARTS
#define P3_PARTS 7
#endif
        if (P3_PARTS & 1) { pg8::DenseSched S; S.init(WSG(bf16, WS_Z) + 1024, DINP, WSG(bf16, WS_WUQ), 256, T, 768, F.G, (int)blockIdx.x);
          pg8::EpiQ E{WSG(bf16, WS_Q), WSG(float, WS_SSQ)};
          pg8::gemm_phase<pg8::EpiQ, pg8::DenseSched, true>(F.lds, 512, S, E, F.wave); }
        if (P3_PARTS & 2) { pg8::DenseSched S; S.init(WSG(bf16, WS_Z) + 1280, DINP, WSG(bf16, WS_WUKV), 256, T, 1024, F.G, (int)blockIdx.x);
          pg8::EpiKV E{WSG(bf16, WS_K), WSG(bf16, WS_V), WSG(bf16, WS_Z), WSG(float, WS_SSQ), GG(float, F.g_kn), WSG(float, WS_COS), WSG(float, WS_SIN)};
          pg8::gemm_phase<pg8::EpiKV, pg8::DenseSched, true>(F.lds, 512, S, E, F.wave); }
#ifndef P3_LRU_REP
#define P3_LRU_REP 1
#endif
        if (P3_PARTS & 4) for (int rr_ = 0; rr_ < P3_LRU_REP; ++rr_) lru_pass<false>(F);
        SEAM(3);
    }
    if (IN(4)) { PH_BEGIN();
        LDIN(conv_w, 7); LDIN(conv_b, 8); LDIN(b_a, 10); LDIN(b_x, 12); LDIN(lam, 13); LDIN(g_qn, 18); LDIN(g_kn, 19);
#ifndef P4_PARTS
#define P4_PARTS 3
#endif
#ifndef P4_LRU_REP
#define P4_LRU_REP 1
#endif
        if (P4_PARTS & 1) for (int rr_ = 0; rr_ < P4_LRU_REP; ++rr_) lru_pass<true>(F);
        __syncthreads();
        if (P4_PARTS & 2) att::phase(F);
        SEAM(4);
    }
    if (IN(5)) { PH_BEGIN();
        LDIN(x, 0);
        pg8::DenseSched S; S.init(WSG(bf16, WS_MIX), DM, WSG(bf16, WS_WOUT), DM, T, DM, F.G, (int)blockIdx.x);
        pg8::EpiX1 E{GG(float, F.x), WSG(bf16, WS_X1B), WSG(float, WS_MOD) + 2048};
        pg8::gemm_phase<pg8::EpiX1, pg8::DenseSched, true>(F.lds, DM * 2, S, E, F.wave);
        SEAM(5);
    }
    if (IN(6)) { PH_BEGIN(); LDIN(g_ffn, 21); p6a_norm(F); SEAM(6); }
    if (IN(7)) { PH_BEGIN(); LDIN(b_router, 23);
        pg8::DenseSched S; S.init(WSG(bf16, WS_H2B), DM, WSG(bf16, WS_WR), DM, T, 256, F.G, (int)blockIdx.x);
        pg8::EpiLogit E{WSG(float, WS_LOGIT), GG(float, F.b_router)};
        pg8::gemm_phase<pg8::EpiLogit, pg8::DenseSched, true>(F.lds, DM * 2, S, E, F.wave);
        SEAM(7); }
    if (IN(8)) { PH_BEGIN(); p6c_topk(F); SEAM(8); }
    if (IN(9)) { PH_BEGIN();
        LDIN(b1, 25);
        moe_tables(F);
        pg8::MoeSched<8, true> S{(const LAS int*)(F.lds + TAB_OFF), WSG(int, WS_LIST), WSG(unsigned char, WS_H2), WSG(unsigned char, WS_W1), F.G, F.vcu, (size_t)2048 * 1024, nullptr, nullptr, GG(float, F.b1), (LAS float*)(F.lds + BIASTAB_OFF)};
        pg8::EpiAct E{WSG(unsigned char, WS_ACT), (const LAS float*)(F.lds + BIASTAB_OFF)};
        pg8::gemm_phase<pg8::EpiAct, pg8::MoeSched<8, true>, true, true>(F.lds, DM, S, E, F.wave);
        SEAM(9);
    }
    if (IN(10)) { PH_BEGIN();
        LDIN(b2, 27);
        moe_tables(F);
        pg8::MoeSched<4, false> S{(const LAS int*)(F.lds + TAB_OFF), WSG(int, WS_LIST), WSG(unsigned char, WS_ACT), WSG(unsigned char, WS_W2), F.G, F.vcu, (size_t)1024 * 1024, WSG(float, WS_GATES), (LAS unsigned*)(F.lds + ROWTAB_OFF), GG(float, F.b2), (LAS float*)(F.lds + BIASTAB_OFF)};
        pg8::EpiY E{WSG(unsigned char, WS_Y4), (const LAS float*)(F.lds + BIASTAB_OFF), (const LAS unsigned*)(F.lds + ROWTAB_OFF), (const LAS int*)(F.lds + TAB_OFF)};
        pg8::gemm_phase<pg8::EpiY, pg8::MoeSched<4, false>, true, true>(F.lds, DFF, S, E, F.wave);
        SEAM(10);
    }
    if (IN(11)) { PH_BEGIN(); p9_combine(F); }
#undef IN
#undef SEAM
}

extern "C" void kernel_launch(void* const* d_in, const int* in_sizes, int n_in, void* d_out, int out_size, void* d_ws, size_t ws_size, hipStream_t stream) {
    static int grid = 0;
    if (grid == 0) {
        if (n_in != 28 || out_size != T * DM || ws_size < WS_END) { fprintf(stderr, "kernel_launch: unexpected shapes (n_in %d out %d ws %zu)\n", n_in, out_size, ws_size); grid = -1; return; }
        int dev = 0, cus = 0, per_cu = 0;
        if (hipGetDevice(&dev) != hipSuccess || hipDeviceGetAttribute(&cus, hipDeviceAttributeMultiprocessorCount, dev) != hipSuccess) { grid = -1; return; }
        if (hipFuncSetAttribute((const void*)mega_fwd, hipFuncAttributeMaxDynamicSharedMemorySize, LDS_BYTES) != hipSuccess) { fprintf(stderr, "kernel_launch: hipFuncSetAttribute failed\n"); grid = -1; return; }
        if (hipOccupancyMaxActiveBlocksPerMultiprocessor(&per_cu, (const void*)mega_fwd, 512, LDS_BYTES) != hipSuccess || per_cu < 1) { fprintf(stderr, "kernel_launch: occupancy query says %d blocks per CU\n", per_cu); per_cu = 1; }
        (void)hipGetLastError();
        grid = cus;
    }
    if (grid < 0) return;
    (void)hipMemsetAsync((char*)d_ws + WS_CTL, 0, CTL_ZERO_BYTES, stream);
    Args a{};
    for (int i = 0; i < 28; ++i) a.in[i] = d_in[i];
    a.out = (float*)d_out; a.ws = (unsigned char*)d_ws;
    constexpr int NPH = MK_LAST_PHASE;
    if (MK_N_LAUNCHES == 1) { a.ph_lo = 0; a.ph_hi = NPH; hipLaunchKernelGGL(mega_fwd, dim3(grid), dim3(512), LDS_BYTES, stream, a); }
    else { for (int p = 0; p < NPH; ++p) { const int reps = (p == PROBE_PHASE) ? PROBE_REP : 1;
            for (int r = 0; r < reps; ++r) { if (r > 0 && p == 8) (void)hipMemsetAsync((char*)d_ws + WS_CTL, 0, CTL_ZERO_BYTES, stream);
                a.ph_lo = p; a.ph_hi = p + 1; hipLaunchKernelGGL(mega_fwd, dim3(grid), dim3(512), LDS_BYTES, stream, a); } } }
}
```

```cpp
#include <hip/hip_runtime.h>
#include <cstdio>
#include <cstdint>

#ifndef MK_N_LAUNCHES
#define MK_N_LAUNCHES 1
#endif
#ifndef PROBE_PHASE
#define PROBE_PHASE -1
#endif
#ifndef PROBE_REP
#define PROBE_REP 3
#endif
#ifndef MK_LAST_PHASE
#define MK_LAST_PHASE 12
#endif

#define LAS __attribute__((address_space(3)))
#define GAS __attribute__((address_space(1)))
typedef unsigned short bf16;
typedef short bf16x8 __attribute__((ext_vector_type(8)));
typedef float f32x4 __attribute__((ext_vector_type(4)));
typedef float f32x16 __attribute__((ext_vector_type(16)));
typedef unsigned u32x4 __attribute__((ext_vector_type(4)));
typedef unsigned u32x2 __attribute__((ext_vector_type(2)));
typedef float f32x2 __attribute__((ext_vector_type(2)));
typedef int v4i __attribute__((ext_vector_type(4)));
typedef int v8i __attribute__((ext_vector_type(8)));

constexpr int NB = 8, SEQ = 4096, DM = 1024, T = NB * SEQ;
constexpr int DLRU = 512, NHEAD = 8, QKH = 96, VH = 64, QLORA = 256, KVLORA = 128, DIN = 1440, DINP = 1536;
constexpr int NEXP = 32, TOPK = 4, DFF = 1024;
constexpr float EPS = 1e-6f;
constexpr int ACT_ROWS = T * TOPK + NEXP * 256;

constexpr size_t MiB = 1u << 20;
constexpr size_t WS_CTL = 0, CTL_ZERO_BYTES = 64 * 1024;
constexpr size_t WS_MOD = 1 * MiB;
constexpr size_t WS_COS = 2 * MiB, WS_SIN = 4 * MiB;
constexpr size_t WS_SSQ = 6 * MiB;
constexpr size_t WS_AGG = 8 * MiB;
constexpr size_t WS_WAX = 10 * MiB;
constexpr size_t WS_LIST = 12 * MiB;
constexpr size_t WS_GATES = 16 * MiB;
constexpr size_t WS_WUQ = 17 * MiB;
constexpr size_t WS_WUKV = 18 * MiB;
constexpr size_t WS_WIN = 20 * MiB;
constexpr size_t WS_WOUT = 24 * MiB;
constexpr size_t WS_WR = 26 * MiB;
constexpr size_t WS_LOGIT = 28 * MiB;
constexpr size_t WS_W2 = 32 * MiB;
constexpr size_t WS_W1 = 96 * MiB;
constexpr size_t WS_H = 224 * MiB;
constexpr size_t WS_Z = 288 * MiB;
constexpr size_t WS_Q = 384 * MiB;
constexpr size_t WS_K = 432 * MiB;
constexpr size_t WS_V = 480 * MiB;
constexpr size_t WS_ACT = 224 * MiB;
constexpr size_t WS_MIX = 512 * MiB;
constexpr size_t WS_H2 = 576 * MiB;
constexpr size_t WS_Y4 = 640 * MiB;
constexpr size_t WS_H2B = 768 * MiB;
constexpr size_t WS_X1B = 832 * MiB;
constexpr size_t WS_END = 896 * MiB;
static_assert(WS_ACT + (size_t)ACT_ROWS * 1024 * 2 <= WS_MIX, "act overlay");
constexpr int CW_BAR = 1024;
constexpr int CW_CNT = 8192;

constexpr int RING_BYTES = 131072;
constexpr int LDSCTL_OFF = RING_BYTES;
constexpr int MISC_OFF = LDSCTL_OFF + 64;
constexpr int TAB_OFF = LDSCTL_OFF + 256;
constexpr int ROWTAB_OFF = LDSCTL_OFF + 1024;
constexpr int BIASTAB_OFF = LDSCTL_OFF + 5120;
constexpr int LDS_BYTES = 147456;

#define RLX_AGENT __ATOMIC_RELAXED, __HIP_MEMORY_SCOPE_AGENT
#define LDS_WAIT() asm volatile("s_waitcnt lgkmcnt(0)" ::: "memory")
typedef __bf16 bf16x2_t __attribute__((ext_vector_type(2)));
__device__ __forceinline__ unsigned cvt_pk_bf16(float lo, float hi) { const f32x2 v = {lo, hi}; const bf16x2_t b = __builtin_convertvector(v, bf16x2_t); return __builtin_bit_cast(unsigned, b); }
__device__ __forceinline__ unsigned f2bf(float f) { return cvt_pk_bf16(f, f) & 0xffffu; }
__device__ __forceinline__ unsigned pk2(float lo, float hi) { return cvt_pk_bf16(lo, hi); }
__device__ __forceinline__ float bf2f(unsigned short v) { return __builtin_bit_cast(float, (unsigned)v << 16); }
__device__ __forceinline__ float bflo(unsigned w) { return __builtin_bit_cast(float, w << 16); }
__device__ __forceinline__ float bfhi(unsigned w) { return __builtin_bit_cast(float, w & 0xffff0000u); }
__device__ __forceinline__ float clamp448(float v) { return __builtin_amdgcn_fmed3f(v, -448.0f, 448.0f); }
__device__ __forceinline__ unsigned pk4_fp8(float a, float b, float c, float d) { int w = 0; w = __builtin_amdgcn_cvt_pk_fp8_f32(clamp448(a), clamp448(b), w, false); w = __builtin_amdgcn_cvt_pk_fp8_f32(clamp448(c), clamp448(d), w, true); return (unsigned)w; }
__device__ __forceinline__ float fast_exp(float v) { return __builtin_amdgcn_exp2f(v * 1.4426950408889634f); }
__device__ __forceinline__ float sigmoidf_(float v) { return __builtin_amdgcn_rcpf(1.0f + fast_exp(-v)); }
__device__ __forceinline__ float wave_sum(float v) {
#pragma unroll
    for (int o = 1; o < 64; o <<= 1) v += __shfl_xor(v, o);
    return v;
}
__device__ __forceinline__ float wave_max(float v) {
#pragma unroll
    for (int o = 1; o < 64; o <<= 1) v = fmaxf(v, __shfl_xor(v, o));
    return v;
}
__device__ __forceinline__ int wave_min_i(int v) {
#pragma unroll
    for (int o = 1; o < 64; o <<= 1) { int t = __shfl_xor(v, o); v = t < v ? t : v; }
    return v;
}
__device__ __forceinline__ int lane_id() { int l; asm volatile("v_mbcnt_lo_u32_b32 %0, -1, 0\n\tv_mbcnt_hi_u32_b32 %0, -1, %0" : "=v"(l)); __builtin_assume(l >= 0 && l < 64); return l; }
__device__ __forceinline__ int crow(int r, int hi) { return (r & 3) + 8 * (r >> 2) + 4 * hi; }

#ifndef MOE_DUPK
#define MOE_DUPK 0
#endif
#ifndef MOE_DUPE
#define MOE_DUPE 0
#endif
namespace pg8 {
constexpr int BM = 256, BK = 64, HALF = 128, HTB = HALF * BK * 2, STAGE_BYTES = 8 * HTB, NXCD = 8, WGM = 8;
template <int SW> __device__ __forceinline__ int lds_byte(int r, int kb) { const int st = (r >> 4) * 2 + (kb >> 6), rr = r & 15, ob = rr * 64 + (kb & 63); return st * 1024 + (ob ^ (((ob >> 9) & 1) << SW)); }
template <int SW> __device__ __forceinline__ void stage_rc(int b, int& R, int& CB) { const int st = b / 1024, sb = b % 1024, swz = sb ^ (((sb >> 9) & 1) << SW); R = (st >> 1) * 16 + swz / 64; CB = (st & 1) * 64 + (swz % 64); }
__device__ __forceinline__ int perm32(int rho) { const int n = rho >> 4, i = rho & 15; return 8 * (i >> 2) + 4 * n + (i & 3); }

struct Unit { int pm, pn, e, aux, par; };

struct DenseSched {
    static constexpr bool VAROFF = false, VAROFF_OR_MOE = false, HAS_PREFETCH = false;
    const GAS bf16* A; const GAS bf16* Bt; int lda, K, nM, nN, nwg, G, c;
    __device__ __forceinline__ void init(const GAS bf16* A_, int lda_, const GAS bf16* Bt_, int K_, int M, int N, int G_, int c_) { A = A_; lda = lda_; Bt = Bt_; K = K_; nM = M / BM; nN = N / BM; nwg = nM * nN; G = G_; c = c_; }
    __device__ __forceinline__ bool next(int i, Unit& u) const {
        const long L = (long)i * G + c; if (L >= nwg) return false;
        int wgid = (int)L; { const int q = nwg / NXCD, r = nwg % NXCD, xcd = wgid % NXCD, off = wgid / NXCD; wgid = (xcd < r ? xcd * (q + 1) : r * (q + 1) + (xcd - r) * q) + off; }
        const int nig = WGM * nN, gid = wgid / nig, fm = gid * WGM, gsz = (nM - fm) < WGM ? (nM - fm) : WGM;
        u.pm = fm + ((wgid % nig) % gsz); u.pn = (wgid % nig) / gsz; u.e = 0; u.aux = 0; u.par = 0; return true;
    }
    __device__ __forceinline__ const GAS char* baseA(const Unit& u) const { return (const GAS char*)(A + (size_t)u.pm * BM * lda); }
    __device__ __forceinline__ const GAS char* baseB(const Unit& u) const { return (const GAS char*)(Bt + (size_t)u.pn * BM * K); }
    __device__ __forceinline__ void offsA(const Unit&, const int (&R)[2], const int (&CB)[2], unsigned (&vo)[2][2]) const {
#pragma unroll
        for (int h = 0; h < 2; ++h)
#pragma unroll
            for (int i = 0; i < 2; ++i) vo[h][i] = (unsigned)((h * HALF + R[i]) * lda * 2 + CB[i]);
    }
};

template <int NN, bool GATHER> struct MoeSched {
    const LAS int* tab; const GAS int* list; const GAS unsigned char* A; const GAS unsigned char* Bt; int G, v; size_t bstride;
    static constexpr int PMT = 32 / NN; static constexpr bool VAROFF = GATHER, VAROFF_OR_MOE = true, HAS_PREFETCH = true;
    const GAS float* gates; LAS unsigned* rowtab; const GAS float* bias; LAS float* biastab;
    __device__ __forceinline__ void prefetch(const Unit& u, int tid) const {
        if (tid < 256) {
            const int bcol = GATHER ? ((tid < 128) ? (u.pn * 128 + tid) : (1024 + u.pn * 128 + tid - 128)) : (u.pn * BM + tid);
            biastab[u.par * 256 + tid] = bias[(size_t)u.e * (GATHER ? 2048 : 1024) + bcol];
            if constexpr (!GATHER) { const int cnt = tab[33 + u.e]; const int pos = u.aux * BM + tid; const int pc = pos < cnt ? pos : cnt - 1; const int ent = list[(size_t)u.e * T + pc]; const float g = 16.0f * gates[ent];
                LAS unsigned* p = rowtab + (u.par * 256 + tid) * 2; p[0] = (unsigned)ent; p[1] = __builtin_bit_cast(unsigned, g); } } }
    __device__ __forceinline__ bool next(int i0, Unit& u) const {
        const int i = MOE_DUPK ? (i0 >> 1) : i0;
        const int L = i * G + v, gq = L >> 5, w = L & 31, gmt = gq * PMT + (w % PMT), Mt = tab[32];
        if (gmt >= Mt) return false;
        int e = 0;
        for (int j = 1; j < 32; ++j) e += (tab[j] <= gmt) ? 1 : 0;
        u.pm = gmt; u.pn = w / PMT; u.e = e; u.aux = gmt - tab[e]; u.par = i0 & 1; return true;
    }
    __device__ __forceinline__ const GAS char* baseA(const Unit& u) const { return GATHER ? (const GAS char*)A : (const GAS char*)(A + (size_t)u.pm * BM * 1024); }
    __device__ __forceinline__ const GAS char* baseB(const Unit& u) const { return (const GAS char*)(Bt + (size_t)u.e * bstride + (size_t)u.pn * BM * 1024); }
    __device__ __forceinline__ void offsA(const Unit& u, const int (&R)[2], const int (&C)[2], unsigned (&vo)[2][2]) const {
        if constexpr (GATHER) {
            const int cnt = tab[33 + u.e];
#pragma unroll
            for (int h = 0; h < 2; ++h)
#pragma unroll
                for (int i = 0; i < 2; ++i) { const int pos = u.aux * BM + h * HALF + R[i]; const int pc = pos < cnt ? pos : cnt - 1;
                    const int tok = list[(size_t)u.e * T + pc] >> 2; vo[h][i] = (unsigned)(tok * 1024 + C[i]); }
        } else {
#pragma unroll
            for (int h = 0; h < 2; ++h)
#pragma unroll
                for (int i = 0; i < 2; ++i) vo[h][i] = (unsigned)((h * HALF + R[i]) * 1024 + C[i]);
        }
    }
};

template <class Epi> struct BRowMap { static constexpr int HALF_ROWS = HALF; __device__ static __forceinline__ int map(int R) { return Epi::PERM ? ((R & ~31) + perm32(R & 31)) : R; } };
template <class Epi> __device__ __forceinline__ constexpr int bhalf_rows() { return BRowMap<Epi>::HALF_ROWS; }
template <class Epi> __device__ __forceinline__ int brow_of(int R) { return BRowMap<Epi>::map(R); }
template <class Epi, class Sched, bool ALIGN_EPI, bool FP8 = false>
__device__ __forceinline__ void gemm_phase(LAS unsigned char* lds, const int KB, const Sched& S, const Epi& E, const int wid) {
    const int lane = lane_id(), tid = wid * 64 + lane, wr = wid >> 2, wc = wid & 3, fr = lane & 15, fq = lane >> 4;
    constexpr int SW = FP8 ? 4 : 5;
    int nt = KB / 128; asm volatile("" : "+s"(nt));
    unsigned voffB[2];
#define PG8_RC() int Rp[2], Cp[2]; _Pragma("unroll") for (int i = 0; i < 2; ++i) { int t_ = tid; asm volatile("" : "+v"(t_)); stage_rc<SW>(t_ * 16 + i * 8192, Rp[i], Cp[i]); }
    { PG8_RC();
#pragma unroll
      for (int i = 0; i < 2; ++i) { const int Rb = brow_of<Epi>(Rp[i]); voffB[i] = (unsigned)(Rb * KB + Cp[i]); } }
    const size_t kstep = (size_t)128;
    const size_t hstepB = (size_t)bhalf_rows<Epi>() * KB;
    const unsigned ldsw = (unsigned)wid * 1024u;
    int aoffk[2], boffk[2];
#pragma unroll
    for (int k = 0; k < 2; ++k) { const int kb = FP8 ? (32 * fq + 16 * k) : (16 * fq + 64 * k); aoffk[k] = lds_byte<SW>(wr * 64 + fr, kb); boffk[k] = lds_byte<SW>(wc * 32 + fr, kb); }
#define PG8_SA(b, h) (((b) * 2 + (h)) * HTB)
#define PG8_SB(b, h) ((4 + (b) * 2 + (h)) * HTB)
#define PG8_STAGE(bufoff, gbase, voff) do { _Pragma("unroll") for (int _i = 0; _i < 2; ++_i) \
        __builtin_amdgcn_global_load_lds((const GAS unsigned*)((gbase) + (voff)[_i]), (LAS unsigned*)(lds + (bufoff) + ldsw + _i * 8192), 16, 0, 0); } while (0)
#define PG8_LD16(off) (*(const LAS v4i*)(lds + (off)))
#define PG8_LDA(dst, b, h) do { _Pragma("unroll") for (int m = 0; m < 4; ++m) { if constexpr (FP8) dst##8[m] = __builtin_shufflevector(PG8_LD16(PG8_SA(b, h) + aoffk[0] + m * 2048), PG8_LD16(PG8_SA(b, h) + aoffk[1] + m * 2048), 0, 1, 2, 3, 4, 5, 6, 7); \
        else { _Pragma("unroll") for (int k = 0; k < 2; ++k) dst[m][k] = *(const LAS bf16x8*)(lds + PG8_SA(b, h) + aoffk[k] + m * 2048); } } } while (0)
#define PG8_LDB(dst, b, h) do { _Pragma("unroll") for (int n = 0; n < 2; ++n) { if constexpr (FP8) dst##8[n] = __builtin_shufflevector(PG8_LD16(PG8_SB(b, h) + boffk[0] + n * 2048), PG8_LD16(PG8_SB(b, h) + boffk[1] + n * 2048), 0, 1, 2, 3, 4, 5, 6, 7); \
        else { _Pragma("unroll") for (int k = 0; k < 2; ++k) dst[n][k] = *(const LAS bf16x8*)(lds + PG8_SB(b, h) + boffk[k] + n * 2048); } } } while (0)
#define PG8_MMA(ai, bj, At, Bt) do { __builtin_amdgcn_s_setprio(1); \
        if constexpr (FP8) { _Pragma("unroll") for (int m = 0; m < 4; ++m) _Pragma("unroll") for (int n = 0; n < 2; ++n) \
            asm volatile("v_mfma_f32_16x16x128_f8f6f4 %0, %1, %2, %0" : "+v"(acc[ai][bj][m][n]) : "v"(Bt##8[n]), "v"(At##8[m])); } \
        else { _Pragma("unroll") for (int m = 0; m < 4; ++m) _Pragma("unroll") for (int n = 0; n < 2; ++n) _Pragma("unroll") for (int k = 0; k < 2; ++k) \
            acc[ai][bj][m][n] = __builtin_amdgcn_mfma_f32_16x16x32_bf16(Bt[n][k], At[m][k], acc[ai][bj][m][n], 0, 0, 0); } \
        __builtin_amdgcn_s_setprio(0); } while (0)
#define PG8_WAIT_V(n) asm volatile("s_waitcnt vmcnt(" #n ")" ::: "memory")
#define PG8_WAIT_L(n) asm volatile("s_waitcnt lgkmcnt(" #n ")" ::: "memory")
#define PG8_BAR __builtin_amdgcn_s_barrier()
#define PG8_SCHED __builtin_amdgcn_sched_barrier(0)
    Unit cur, nxt; int ui = 0;
    if (!S.next(0, cur)) return;
    f32x4 acc[2][2][4][2];
#pragma unroll
    for (int a = 0; a < 2; ++a)
#pragma unroll
        for (int b = 0; b < 2; ++b)
#pragma unroll
            for (int m = 0; m < 4; ++m)
#pragma unroll
                for (int n = 0; n < 2; ++n) acc[a][b][m][n] = (f32x4){0.f, 0.f, 0.f, 0.f};
    bf16x8 At[4][2], B0[2][2], B1[2][2]; v8i At8[4], B08[2], B18[2];
    unsigned voA[2][2], vnA[2][2];
    { PG8_RC(); S.offsA(cur, Rp, Cp, voA); }
    if constexpr (Sched::HAS_PREFETCH) S.prefetch(cur, tid);
    const GAS char* cA = S.baseA(cur); const GAS char* cB = S.baseB(cur);
    PG8_STAGE(PG8_SB(0, 0), cB, voffB); PG8_STAGE(PG8_SB(0, 1), cB + hstepB, voffB); PG8_STAGE(PG8_SA(0, 0), cA, voA[0]); PG8_STAGE(PG8_SA(0, 1), cA, voA[1]);
    if (wr == 1) PG8_BAR;
    PG8_WAIT_V(2); PG8_BAR;
    PG8_STAGE(PG8_SB(1, 0), cB + kstep, voffB); PG8_STAGE(PG8_SA(1, 0), cA + kstep, voA[0]); PG8_STAGE(PG8_SB(1, 1), cB + hstepB + kstep, voffB);
    PG8_WAIT_V(6); PG8_BAR;
    for (;;) {
        const bool has_next = S.next(ui + 1, nxt);
        const GAS char* nA = has_next ? S.baseA(nxt) : cA; const GAS char* nB = has_next ? S.baseB(nxt) : cB;
        if constexpr (Sched::VAROFF) { if (has_next) { PG8_RC(); S.offsA(nxt, Rp, Cp, vnA); } }
        if (!Sched::VAROFF || !has_next) {
#pragma unroll
            for (int h = 0; h < 2; ++h)
#pragma unroll
                for (int i = 0; i < 2; ++i) vnA[h][i] = voA[h][i];
        }
#pragma unroll 1
        for (int t = 0; t < nt; t += 2) {
            const bool last = (t == nt - 2);
            asm volatile("" : "+v"(voffB[0]), "+v"(voffB[1]), "+v"(voA[0][0]), "+v"(voA[0][1]), "+v"(voA[1][0]), "+v"(voA[1][1]));
            const GAS char* a1 = cA + (size_t)(t + 1) * kstep;
            const GAS char* a2 = last ? nA : cA + (size_t)(t + 2) * kstep; const GAS char* b2 = last ? nB : cB + (size_t)(t + 2) * kstep;
            const GAS char* a3 = a2 + kstep; const GAS char* b3 = b2 + kstep;
            unsigned o0[2], o1[2];
#pragma unroll
            for (int i = 0; i < 2; ++i) { o0[i] = voA[0][i]; o1[i] = voA[1][i]; }
            if constexpr (Sched::VAROFF) { if (last) {
#pragma unroll
                for (int i = 0; i < 2; ++i) { o0[i] = vnA[0][i]; o1[i] = vnA[1][i]; } } }
            PG8_LDB(B0, 0, 0); PG8_LDB(B1, 0, 1); PG8_SCHED; PG8_LDA(At, 0, 0); PG8_STAGE(PG8_SA(1, 1), a1, voA[1]);
            PG8_WAIT_V(8); PG8_WAIT_L(0); PG8_BAR; PG8_MMA(0, 0, At, B0); PG8_MMA(0, 1, At, B1); PG8_BAR; PG8_SCHED;
            PG8_LDA(At, 0, 1); PG8_STAGE(PG8_SB(0, 0), b2, voffB); PG8_STAGE(PG8_SB(0, 1), b2 + hstepB, voffB); PG8_STAGE(PG8_SA(0, 0), a2, o0);
            PG8_WAIT_V(8); PG8_WAIT_L(0); PG8_BAR; PG8_MMA(1, 0, At, B0); PG8_MMA(1, 1, At, B1); PG8_BAR; PG8_SCHED;
            PG8_LDB(B0, 1, 0); PG8_LDB(B1, 1, 1); PG8_SCHED; PG8_LDA(At, 1, 0); PG8_STAGE(PG8_SA(0, 1), a2, o1);
            PG8_WAIT_V(8); PG8_WAIT_L(0); PG8_BAR; PG8_MMA(0, 0, At, B0); PG8_MMA(0, 1, At, B1); PG8_BAR; PG8_SCHED;
            PG8_LDA(At, 1, 1); PG8_STAGE(PG8_SB(1, 0), b3, voffB); PG8_STAGE(PG8_SB(1, 1), b3 + hstepB, voffB); PG8_STAGE(PG8_SA(1, 0), a3, o0);
            PG8_WAIT_V(8); PG8_WAIT_L(0); PG8_BAR; PG8_MMA(1, 0, At, B0); PG8_MMA(1, 1, At, B1); PG8_BAR; PG8_SCHED;
        }
        if constexpr (ALIGN_EPI) { if (wr == 0) PG8_BAR; }
        if constexpr (FP8) asm volatile("s_nop 15\n\ts_nop 7" ::: "memory");
        if (!(MOE_DUPK && Sched::VAROFF_OR_MOE && !(ui & 1))) E(acc, cur, wr, wc, fr, fq);
        if (MOE_DUPE && Sched::VAROFF_OR_MOE) { asm volatile("" ::: "memory"); E(acc, cur, wr, wc, fr, fq); }
        if (!has_next) break;
#pragma unroll
        for (int a = 0; a < 2; ++a)
#pragma unroll
            for (int b = 0; b < 2; ++b)
#pragma unroll
                for (int m = 0; m < 4; ++m)
#pragma unroll
                    for (int n = 0; n < 2; ++n) acc[a][b][m][n] = (f32x4){0.f, 0.f, 0.f, 0.f};
        cur = nxt; cA = nA; cB = nB; ++ui;
        if constexpr (Sched::HAS_PREFETCH) S.prefetch(cur, wid * 64 + lane_id());
#pragma unroll
        for (int h = 0; h < 2; ++h)
#pragma unroll
            for (int i = 0; i < 2; ++i) voA[h][i] = vnA[h][i];
        if constexpr (ALIGN_EPI) { if (wr == 1) PG8_BAR; }
    }
    PG8_WAIT_V(0);
    if constexpr (!ALIGN_EPI) { if (wr == 0) PG8_BAR; }
    PG8_BAR;
#undef PG8_SA
#undef PG8_SB
#undef PG8_STAGE
#undef PG8_LDA
#undef PG8_LDB
#undef PG8_MMA
#undef PG8_LD16
#undef PG8_RC
#undef PG8_WAIT_V
#undef PG8_WAIT_L
#undef PG8_BAR
#undef PG8_SCHED
}

typedef const f32x4 (&AccRef)[2][2][4][2];

struct EpiZ {
    static constexpr bool PERM = true;
    GAS bf16* Z; GAS float* ssq;
    __device__ __forceinline__ void operator()(AccRef acc, const Unit& u, int wr, int wc, int fr, int fq) const {
        const int row0 = u.pm * BM + wr * 64 + fr, col0 = u.pn * BM + wc * 32 + 8 * fq;
#pragma unroll
        for (int ai = 0; ai < 2; ++ai)
#pragma unroll
            for (int m = 0; m < 4; ++m) { const int row = row0 + ai * HALF + m * 16; GAS bf16* rowp = Z + (size_t)row * DINP + col0;
                float s0 = 0.f, s1 = 0.f;
#pragma unroll
                for (int bj = 0; bj < 2; ++bj) { const f32x4 v0 = acc[ai][bj][m][0], v1 = acc[ai][bj][m][1];
                    const float s = (v0[0] * v0[0] + v0[1] * v0[1]) + (v0[2] * v0[2] + v0[3] * v0[3]) + (v1[0] * v1[0] + v1[1] * v1[1]) + (v1[2] * v1[2] + v1[3] * v1[3]);
                    if (bj == 0) s0 = s; else s1 = s;
                    u32x4 w; w.x = cvt_pk_bf16(v0[0], v0[1]); w.y = cvt_pk_bf16(v0[2], v0[3]); w.z = cvt_pk_bf16(v1[0], v1[1]); w.w = cvt_pk_bf16(v1[2], v1[3]);
                    *(GAS u32x4*)(rowp + bj * HALF) = w; }
                if (u.pn >= 4) {
                    s0 += __shfl_xor(s0, 16); s0 += __shfl_xor(s0, 32); s1 += __shfl_xor(s1, 16); s1 += __shfl_xor(s1, 32);
                    if (fq == 0) {
                        if (u.pn == 4) ssq[(size_t)row * 12 + wc] = s0 + s1;
                        else { ssq[(size_t)row * 12 + 4 + wc] = s0; if (wc == 0) ssq[(size_t)row * 12 + 8] = s1; }
                    }
                }
            }
    }
};
struct EpiQ {
    static constexpr bool PERM = true;
    GAS bf16* Q; const GAS float* ssq;
    __device__ __forceinline__ void operator()(AccRef acc, const Unit& u, int wr, int wc, int fr, int fq) const {
        const int row0 = u.pm * BM + wr * 64 + fr, col0 = u.pn * BM + wc * 32 + 8 * fq;
#pragma unroll
        for (int ai = 0; ai < 2; ++ai)
#pragma unroll
            for (int m = 0; m < 4; ++m) { const int row = row0 + ai * HALF + m * 16; GAS bf16* rowp = Q + (size_t)row * 768 + col0;
                const f32x4 sp = *(const GAS f32x4*)(ssq + (size_t)row * 12);
                const float rs = __builtin_amdgcn_rsqf(((sp[0] + sp[1]) + (sp[2] + sp[3])) * (1.0f / QLORA) + EPS);
#pragma unroll
                for (int bj = 0; bj < 2; ++bj) { const f32x4 v0 = acc[ai][bj][m][0] * rs, v1 = acc[ai][bj][m][1] * rs;
                    u32x4 w; w.x = cvt_pk_bf16(v0[0], v0[1]); w.y = cvt_pk_bf16(v0[2], v0[3]); w.z = cvt_pk_bf16(v1[0], v1[1]); w.w = cvt_pk_bf16(v1[2], v1[3]);
                    *(GAS u32x4*)(rowp + bj * HALF) = w; }
            }
    }
};
struct EpiKV {
    static constexpr bool PERM = true;
    GAS bf16* Kb; GAS bf16* Vb; const GAS bf16* Z; const GAS float* ssq; const GAS float* gkn; const GAS float* ctab; const GAS float* stab;
    __device__ __forceinline__ void operator()(AccRef acc, const Unit& u, int wr, int wc, int fr, int fq) const {
        const int row0 = u.pm * BM + wr * 64 + fr; const int head = 2 * u.pn + (wc & 1);
        if (wc < 2) {
#pragma unroll
            for (int am = 0; am < 4; ++am) { const int ai = am >> 1, mb = 2 * (am & 1);
                asm volatile("" ::: "memory");
                f32x4 sp[2], cs[2], sn[2]; float ssr[2]; u32x2 r1[2], r2[2];
#pragma unroll
                for (int mm = 0; mm < 2; ++mm) { const int m = mm; const int row = row0 + ai * HALF + (mb + mm) * 16;
                    sp[m] = *(const GAS f32x4*)(ssq + (size_t)row * 12 + 4); ssr[m] = ssq[(size_t)row * 12 + 8];
                    r1[m] = *(const GAS u32x2*)(Z + (size_t)row * DINP + 1408 + 4 * fq); r2[m] = *(const GAS u32x2*)(Z + (size_t)row * DINP + 1424 + 4 * fq);
                    cs[m] = *(const GAS f32x4*)(ctab + (size_t)row * 16 + 4 * fq); sn[m] = *(const GAS f32x4*)(stab + (size_t)row * 16 + 4 * fq); }
                const f32x4 gr1 = *(const GAS f32x4*)(gkn + 64 + 4 * fq), gr2 = *(const GAS f32x4*)(gkn + 80 + 4 * fq);
                f32x4 g0v[2], g1v[2];
#pragma unroll
                for (int bj = 0; bj < 2; ++bj) { g0v[bj] = *(const GAS f32x4*)(gkn + bj * 32 + 8 * fq); g1v[bj] = *(const GAS f32x4*)(gkn + bj * 32 + 8 * fq + 4); }
#pragma unroll
                for (int mm = 0; mm < 2; ++mm) { const int m = mm; const int mi = mb + mm; const int row = row0 + ai * HALF + mi * 16;
                    const float rkv = __builtin_amdgcn_rsqf(((sp[m][0] + sp[m][1]) + (sp[m][2] + sp[m][3])) * (1.0f / KVLORA) + EPS);
                    f32x4 v[2][2]; float s = 0.f;
#pragma unroll
                    for (int bj = 0; bj < 2; ++bj)
#pragma unroll
                        for (int n = 0; n < 2; ++n) { v[bj][n] = acc[ai][bj][mi][n] * rkv; s += (v[bj][n][0] * v[bj][n][0] + v[bj][n][1] * v[bj][n][1]) + (v[bj][n][2] * v[bj][n][2] + v[bj][n][3] * v[bj][n][3]); }
                    s += __shfl_xor(s, 16); s += __shfl_xor(s, 32);
                    const float rk = __builtin_amdgcn_rsqf((s + ssr[m]) * (1.0f / QKH) + EPS);
                    GAS bf16* kp = Kb + (size_t)row * 768 + head * QKH;
#pragma unroll
                    for (int bj = 0; bj < 2; ++bj) { u32x4 w; const f32x4 g0 = g0v[bj] * rk, g1 = g1v[bj] * rk;
                        w.x = cvt_pk_bf16(v[bj][0][0] * g0[0], v[bj][0][1] * g0[1]); w.y = cvt_pk_bf16(v[bj][0][2] * g0[2], v[bj][0][3] * g0[3]);
                        w.z = cvt_pk_bf16(v[bj][1][0] * g1[0], v[bj][1][1] * g1[1]); w.w = cvt_pk_bf16(v[bj][1][2] * g1[2], v[bj][1][3] * g1[3]);
                        *(GAS u32x4*)(kp + bj * 32 + 8 * fq) = w; }
                    float x1[4] = {bflo(r1[m].x), bfhi(r1[m].x), bflo(r1[m].y), bfhi(r1[m].y)}, x2[4] = {bflo(r2[m].x), bfhi(r2[m].x), bflo(r2[m].y), bfhi(r2[m].y)};
                    float o1[4], o2[4];
#pragma unroll
                    for (int j = 0; j < 4; ++j) { const float a = x1[j] * rk * gr1[j], b = x2[j] * rk * gr2[j]; o1[j] = a * cs[m][j] - b * sn[m][j]; o2[j] = b * cs[m][j] + a * sn[m][j]; }
                    u32x2 w1, w2; w1.x = cvt_pk_bf16(o1[0], o1[1]); w1.y = cvt_pk_bf16(o1[2], o1[3]); w2.x = cvt_pk_bf16(o2[0], o2[1]); w2.y = cvt_pk_bf16(o2[2], o2[3]);
                    *(GAS u32x2*)(kp + 64 + 4 * fq) = w1; *(GAS u32x2*)(kp + 80 + 4 * fq) = w2;
                }
            }
        } else {
#pragma unroll
            for (int ai = 0; ai < 2; ++ai)
#pragma unroll
                for (int m = 0; m < 4; ++m) { const int row = row0 + ai * HALF + m * 16;
                    const f32x4 sp = *(const GAS f32x4*)(ssq + (size_t)row * 12 + 4);
                    const float rkv = __builtin_amdgcn_rsqf(((sp[0] + sp[1]) + (sp[2] + sp[3])) * (1.0f / KVLORA) + EPS);
                    GAS bf16* vp = Vb + (size_t)row * 512 + head * VH;
#pragma unroll
                    for (int bj = 0; bj < 2; ++bj) { const f32x4 v0 = acc[ai][bj][m][0] * rkv, v1 = acc[ai][bj][m][1] * rkv;
                        u32x4 w; w.x = cvt_pk_bf16(v0[0], v0[1]); w.y = cvt_pk_bf16(v0[2], v0[3]); w.z = cvt_pk_bf16(v1[0], v1[1]); w.w = cvt_pk_bf16(v1[2], v1[3]);
                        *(GAS u32x4*)(vp + bj * 32 + 8 * fq) = w; }
                }
        }
    }
};
struct EpiX1 {
    static constexpr bool PERM = true;
    const GAS float* x; GAS bf16* x1; const GAS float* gate;
    __device__ __forceinline__ void operator()(AccRef acc, const Unit& u, int wr, int wc, int fr, int fq) const {
        const int row0 = u.pm * BM + wr * 64 + fr, col0 = u.pn * BM + wc * 32 + 8 * fq; const int b = (u.pm * BM) / SEQ;
        f32x4 gv[2][2];
#pragma unroll
        for (int bj = 0; bj < 2; ++bj)
#pragma unroll
            for (int n = 0; n < 2; ++n) gv[bj][n] = *(const GAS f32x4*)(gate + (size_t)b * 6144 + col0 + bj * HALF + n * 4);
#pragma unroll
        for (int ai = 0; ai < 2; ++ai)
#pragma unroll
            for (int m = 0; m < 4; ++m) { const size_t off = (size_t)(row0 + ai * HALF + m * 16) * DM + col0;
#pragma unroll
                for (int bj = 0; bj < 2; ++bj) { const f32x4 x0 = __builtin_nontemporal_load((const GAS f32x4*)(x + off + bj * HALF)), x1v = __builtin_nontemporal_load((const GAS f32x4*)(x + off + bj * HALF + 4));
                    const f32x4 v0 = x0 + gv[bj][0] * acc[ai][bj][m][0], v1 = x1v + gv[bj][1] * acc[ai][bj][m][1];
                    u32x4 w; w.x = cvt_pk_bf16(v0[0], v0[1]); w.y = cvt_pk_bf16(v0[2], v0[3]); w.z = cvt_pk_bf16(v1[0], v1[1]); w.w = cvt_pk_bf16(v1[2], v1[3]);
                    *(GAS u32x4*)(x1 + off + bj * HALF) = w; }
                if (m == 3) asm volatile("" ::: "memory"); }
    }
};
struct EpiAct {
    static constexpr bool PERM = true;
    GAS unsigned char* act; const LAS float* biastab;
    __device__ __forceinline__ void operator()(AccRef acc, const Unit& u, int wr, int wc, int fr, int fq) const {
        const int row0 = u.pm * BM + wr * 64 + fr, col0 = u.pn * 128 + wc * 32 + 8 * fq;
        const LAS float* bp = biastab + u.par * 256 + wc * 32 + 8 * fq;
        f32x2 bg[4], bu[4];
#pragma unroll
        for (int q = 0; q < 4; ++q) { bg[q] = *(const LAS f32x2*)(bp + 2 * q); bu[q] = *(const LAS f32x2*)(bp + 128 + 2 * q); }
#pragma unroll
        for (int ai = 0; ai < 2; ++ai)
#pragma unroll
            for (int m = 0; m < 4; ++m) { GAS unsigned char* rowp = act + (size_t)(row0 + ai * HALF + m * 16) * DFF + col0;
                f32x2 o[4];
#pragma unroll
                for (int q = 0; q < 4; ++q) { const int n = q >> 1, j = 2 * (q & 1);
                    const f32x2 ga = {acc[ai][0][m][n][j], acc[ai][0][m][n][j + 1]}, ua = {acc[ai][1][m][n][j], acc[ai][1][m][n][j + 1]};
                    f32x2 gl = ga * 0.015625f + bg[q], li = ua * 0.015625f + bu[q];
                    gl.x = fminf(gl.x, 7.0f); gl.y = fminf(gl.y, 7.0f);
                    li.x = __builtin_amdgcn_fmed3f(li.x, -7.0f, 7.0f); li.y = __builtin_amdgcn_fmed3f(li.y, -7.0f, 7.0f);
                    const f32x2 ea = gl * (-1.702f * 1.4426950408889634f);
                    f32x2 den; den.x = __builtin_amdgcn_exp2f(ea.x); den.y = __builtin_amdgcn_exp2f(ea.y); den = den + 1.0f;
                    f32x2 sg; sg.x = __builtin_amdgcn_rcpf(den.x); sg.y = __builtin_amdgcn_rcpf(den.y);
                    o[q] = (li * 4.0f + 4.0f) * (gl * sg); }
                u32x2 w;
                { int t0 = 0; t0 = __builtin_amdgcn_cvt_pk_fp8_f32(o[0].x, o[0].y, t0, false); t0 = __builtin_amdgcn_cvt_pk_fp8_f32(o[1].x, o[1].y, t0, true); w.x = (unsigned)t0; }
                { int t1 = 0; t1 = __builtin_amdgcn_cvt_pk_fp8_f32(o[2].x, o[2].y, t1, false); t1 = __builtin_amdgcn_cvt_pk_fp8_f32(o[3].x, o[3].y, t1, true); w.y = (unsigned)t1; }
                *(GAS u32x2*)rowp = w; }
    }
};
struct EpiY {
    static constexpr bool PERM = true;
    GAS unsigned char* y4; const LAS float* biastab; const LAS unsigned* rowtab; const LAS int* tab;
    __device__ __forceinline__ void operator()(AccRef acc, const Unit& u, int wr, int wc, int fr, int fq) const {
        const int r0 = wr * 64 + fr, col0 = u.pn * BM + wc * 64 + 16 * fq; const int cnt = tab[33 + u.e];
        f32x4 bv[2][2];
#pragma unroll
        for (int bj = 0; bj < 2; ++bj)
#pragma unroll
            for (int n = 0; n < 2; ++n) bv[bj][n] = *(const LAS f32x4*)(biastab + u.par * 256 + wc * 64 + 16 * fq + 8 * bj + 4 * n);
        int ent[8]; float gg[8];
#pragma unroll
        for (int q = 0; q < 8; ++q) { const LAS unsigned* p = rowtab + (u.par * 256 + r0 + (q >> 2) * HALF + (q & 3) * 16) * 2; ent[q] = (int)p[0]; gg[q] = __builtin_bit_cast(float, p[1]); }
#pragma unroll
        for (int ai = 0; ai < 2; ++ai)
#pragma unroll
            for (int m = 0; m < 4; ++m) { const int pos = u.aux * BM + r0 + ai * HALF + m * 16;
                if (pos < cnt) { const float g = gg[ai * 4 + m]; GAS unsigned char* rowp = y4 + (size_t)ent[ai * 4 + m] * DM + col0;
                    u32x4 w;
#pragma unroll
                    for (int bj = 0; bj < 2; ++bj) { const f32x4 v0 = (acc[ai][bj][m][0] * 0.00390625f + bv[bj][0]) * g, v1 = (acc[ai][bj][m][1] * 0.00390625f + bv[bj][1]) * g;
                        w[2 * bj] = pk4_fp8(v0[0], v0[1], v0[2], v0[3]); w[2 * bj + 1] = pk4_fp8(v1[0], v1[1], v1[2], v1[3]); }
                    *(GAS u32x4*)rowp = w; } }
    }
};
template <> struct BRowMap<EpiY> { static constexpr int HALF_ROWS = 8; __device__ static __forceinline__ int map(int R) { const int wc = R >> 5, i = perm32(R & 31); return 64 * wc + 16 * (i >> 3) + (i & 7); } };
struct EpiLogit {
    static constexpr bool PERM = false;
    GAS float* logit; const GAS float* br;
    __device__ __forceinline__ void operator()(AccRef acc, const Unit& u, int wr, int wc, int fr, int fq) const {
        if (wc != 0) return;
        const int row0 = u.pm * BM + wr * 64 + fr;
        const f32x4 b0 = *(const GAS f32x4*)(br + 4 * fq), b1 = *(const GAS f32x4*)(br + 16 + 4 * fq);
#pragma unroll
        for (int ai = 0; ai < 2; ++ai)
#pragma unroll
            for (int m = 0; m < 4; ++m) { GAS float* rp = logit + (size_t)(row0 + ai * HALF + m * 16) * NEXP + 4 * fq;
                *(GAS f32x4*)rp = acc[ai][0][m][0] + b0; *(GAS f32x4*)(rp + 16) = acc[ai][0][m][1] + b1; }
    }
};
}

#define XB_TMO      128
#define XB_XCNT(j)  (256  + 64 * (j))
#define XB_XSUB(j)  (1280 + 64 * (j))
#define XB_XGEN(j)  (2304 + 64 * (j))
#define XB_TOP      3328
#define XB_TOPGEN   3392
#define XCD_BAR_WORDS 3456
#define XB_SPIN_CAP (1u << 18)
__device__ __forceinline__ unsigned xb_ld(unsigned* p)              { return __hip_atomic_load(p, __ATOMIC_RELAXED, __HIP_MEMORY_SCOPE_AGENT); }
__device__ __forceinline__ unsigned xb_add(unsigned* p, unsigned v) { return __hip_atomic_fetch_add(p, v, __ATOMIC_RELAXED, __HIP_MEMORY_SCOPE_AGENT); }
__device__ __forceinline__ unsigned xb_xcc_id() { return (unsigned)__builtin_amdgcn_s_getreg((3 << 11) | 20) & 0xFu; }
#define XB_SPIN(cond, bar) do { unsigned _sp = 0; while (cond) { __builtin_amdgcn_s_sleep(1); \
    if ((++_sp & 255u) == 0u) { if (xb_ld(&(bar)[XB_TMO])) break; if (_sp > XB_SPIN_CAP) { atomicAdd(&(bar)[XB_TMO], 1u); break; } } } } while (0)
struct XcdBarrier { unsigned* bar; unsigned x; volatile LAS unsigned* st; };
__device__ __forceinline__ XcdBarrier xcd_barrier_post(unsigned* bar, volatile LAS unsigned* st, bool leader) {
    XcdBarrier b; b.bar = bar; b.x = xb_xcc_id(); b.st = st;
    if (leader) (void)xb_add(&bar[XB_XCNT(b.x)], 1u);
    return b;
}
__device__ __forceinline__ void xcd_barrier_complete(unsigned* bar, unsigned x, unsigned& nloc, unsigned& nx) {
    const unsigned G = gridDim.x * gridDim.y * gridDim.z;
    unsigned sum, cnt, mine, sp = 0u;
    for (;;) {
        sum = 0u; cnt = 0u; mine = 0u;
#pragma unroll
        for (unsigned j = 0; j < 16; ++j) { const unsigned c = xb_ld(&bar[XB_XCNT(j)]); sum += c; cnt += (c > 0u) ? 1u : 0u; mine = (j == x) ? c : mine; }
        if (sum == G) break;
        __builtin_amdgcn_s_sleep(1);
        if ((++sp & 255u) == 0u) { if (xb_ld(&bar[XB_TMO])) break; if (sp > XB_SPIN_CAP) { atomicAdd(&bar[XB_TMO], 1u); break; } }
    }
    nloc = mine > 0u ? mine : 1u; nx = cnt > 0u ? cnt : 1u;
}
__device__ __forceinline__ void xcd_barrier(const XcdBarrier& b, bool leader) {
    asm volatile("s_waitcnt vmcnt(0)" ::: "memory");
    __syncthreads();
    if (leader) {
        unsigned* bar = b.bar;
        __builtin_amdgcn_s_waitcnt(0);
        unsigned nloc = b.st[0], nx = b.st[1];
        if (nloc == 0u) { xcd_barrier_complete(bar, b.x, nloc, nx); b.st[0] = nloc; b.st[1] = nx; }
        const unsigned old = xb_add(&bar[XB_XSUB(b.x)], 1u);
        const unsigned gen = old / nloc;
        if (old + 1u == (gen + 1u) * nloc) {
            __builtin_amdgcn_fence(__ATOMIC_RELEASE, "agent");
            asm volatile("s_waitcnt vmcnt(0)" ::: "memory");
            const unsigned og = xb_add(&bar[XB_TOP], 1u);
            const unsigned tg = og / nx;
            if (og + 1u == (tg + 1u) * nx) xb_add(&bar[XB_TOPGEN], 1u);
            else XB_SPIN(xb_ld(&bar[XB_TOPGEN]) == tg, bar);
            __builtin_amdgcn_fence(__ATOMIC_ACQUIRE, "agent");
            xb_add(&bar[XB_XGEN(b.x)], 1u);
            asm volatile("s_waitcnt vmcnt(0)" ::: "memory");
        } else {
            XB_SPIN(xb_ld(&bar[XB_XGEN(b.x)]) == gen, bar);
            __builtin_amdgcn_fence(__ATOMIC_ACQUIRE, "agent");
            asm volatile("s_waitcnt vmcnt(0)" ::: "memory");
        }
    }
    __syncthreads();
}

struct Frame {
    LAS unsigned char* lds;
    int tid, lane, wave, vcu, G;
    const float *x, *c; const int* pos; const float *w_ada, *b_ada, *g_mix, *w_in, *conv_w, *conv_b, *w_a, *b_a, *w_x, *b_x, *lam, *g_q_lat, *w_uq, *g_kv_lat, *w_ukv, *g_qn, *g_kn, *w_out, *g_ffn, *w_router, *b_router, *w1, *b1, *w2, *b2;
    float* out; unsigned char* ws; unsigned* ctl;
};
#define WSP(type, off) ((type*)(GAS type*)(F.ws + (off)))
#define WSG(type, off) ((GAS type*)(F.ws + (off)))
#define GG(type, p) ((const GAS type*)(p))

__device__ __forceinline__ void p0_mod_rope(Frame& F) {
    LAS float* sc = (LAS float*)F.lds; LAS float* red = (LAS float*)(F.lds + 32768);
    for (int i = F.tid; i < NB * DM; i += 512) { const float v = F.c[i]; sc[i] = v * sigmoidf_(v); }
    __syncthreads();
    float* mod = WSP(float, WS_MOD);
    for (int u = blockIdx.x; u < 192; u += F.G) {
        const int n = u * 32 + (F.lane & 31), k0 = F.wave * 128 + (F.lane >> 5) * 64;
        float acc[8];
#pragma unroll
        for (int b = 0; b < 8; ++b) acc[b] = 0.f;
#pragma unroll 16
        for (int kk = 0; kk < 64; ++kk) { const int k = k0 + kk; const float w = __builtin_nontemporal_load((const GAS float*)F.w_ada + (size_t)k * 6144 + n);
#pragma unroll
            for (int b = 0; b < 8; ++b) acc[b] += sc[b * DM + k] * w; }
#pragma unroll
        for (int b = 0; b < 8; ++b) acc[b] += __shfl_xor(acc[b], 32);
        if (F.lane < 32) {
#pragma unroll
            for (int b = 0; b < 8; ++b) red[(F.wave * 8 + b) * 32 + F.lane] = acc[b]; }
        __syncthreads();
        if (F.tid < 256) { const int b = F.tid >> 5, j = F.tid & 31; float s = 0.f;
#pragma unroll
            for (int w = 0; w < 8; ++w) s += red[(w * 8 + b) * 32 + j];
            mod[b * 6144 + u * 32 + j] = s + F.b_ada[u * 32 + j]; }
        __syncthreads();
    }
    float* ct = WSP(float, WS_COS); float* st = WSP(float, WS_SIN);
    for (int idx = blockIdx.x * 512 + F.tid; idx < T * 16; idx += F.G * 512) {
        const int t = idx >> 4, i = idx & 15; const float freq = exp2f(-(float)i * (13.287712379549449f / 16.0f));
        const float ang = (float)F.pos[t] * freq; double rev = (double)ang * 0.15915494309189535; rev -= floor(rev); const float rv = (float)rev;
        ct[idx] = __builtin_amdgcn_cosf(rv); st[idx] = __builtin_amdgcn_sinf(rv);
    }
}

__device__ __forceinline__ void transpose_item(const float* W, int ldw, int Ks, int scol0, const float* g, bf16* WT, int Kd, int n0, int k0, LAS float* scr, int lane, float cs = 1.0f) {
#pragma unroll 8
    for (int i = 0; i < 32; ++i) { const int kk = 2 * i + (lane >> 5), k = k0 + kk; float v = 0.f;
        if (scol0 >= 0 && k < Ks) { v = W[(size_t)k * ldw + scol0 + (lane & 31)] * cs; if (g) v *= g[k]; }
        scr[kk * 33 + (lane & 31)] = v; }
    LDS_WAIT(); asm volatile("" ::: "memory");
    const int c = lane & 7;
#pragma unroll
    for (int j = 0; j < 4; ++j) { const int n = (lane >> 3) + 8 * j; const LAS float* s = scr + (8 * c) * 33 + n;
        u32x4 o; o.x = pk2(s[0 * 33], s[1 * 33]); o.y = pk2(s[2 * 33], s[3 * 33]); o.z = pk2(s[4 * 33], s[5 * 33]); o.w = pk2(s[6 * 33], s[7 * 33]);
        *(u32x4*)(WT + (size_t)(n0 + n) * Kd + k0 + 8 * c) = o; }
    LDS_WAIT(); asm volatile("" ::: "memory");
}
__device__ __forceinline__ void transpose_item_fp8(const float* W, int ldw, int scol0, unsigned char* WT, int Kd, int n0, int k0, LAS float* scr, int lane) {
    const GAS float* Wg = (const GAS float*)W;
    f32x4 v[8];
#pragma unroll
    for (int i = 0; i < 8; ++i) v[i] = __builtin_nontemporal_load((const GAS f32x4*)(Wg + (size_t)(k0 + 8 * i + (lane >> 3)) * ldw + scol0 + 4 * (lane & 7)));
#pragma unroll
    for (int i = 0; i < 8; ++i) { LAS float* d = scr + (8 * i + (lane >> 3)) * 33 + 4 * (lane & 7); d[0] = v[i][0] * 64.0f; d[1] = v[i][1] * 64.0f; d[2] = v[i][2] * 64.0f; d[3] = v[i][3] * 64.0f; }
    LDS_WAIT(); asm volatile("" ::: "memory");
    const int c = lane & 3;
#pragma unroll
    for (int j = 0; j < 2; ++j) { const int n = (lane >> 2) + 16 * j; const LAS float* s = scr + (16 * c) * 33 + n;
        u32x4 o; o.x = pk4_fp8(s[0 * 33], s[1 * 33], s[2 * 33], s[3 * 33]); o.y = pk4_fp8(s[4 * 33], s[5 * 33], s[6 * 33], s[7 * 33]);
        o.z = pk4_fp8(s[8 * 33], s[9 * 33], s[10 * 33], s[11 * 33]); o.w = pk4_fp8(s[12 * 33], s[13 * 33], s[14 * 33], s[15 * 33]);
        __builtin_nontemporal_store(o, (GAS u32x4*)(WT + (size_t)(n0 + n) * Kd + k0 + 16 * c)); }
    LDS_WAIT(); asm volatile("" ::: "memory");
}
__device__ __forceinline__ void p1_convert_norm(Frame& F) {
    LAS float* scr = (LAS float*)(F.lds + F.wave * 16384);
    const int gw = F.vcu * 8 + F.wave, NGW = F.G * 8;
    constexpr int I_W1 = NEXP * 16 * 64, I_W2 = NEXP * 16 * 32, I_IN = 16 * 48, I_OUT = 16 * 32, I_UQ = 4 * 24, I_UKV = 4 * 32, I_AX = 32;
    constexpr int I_WR = 16 * 8;
    constexpr int NITEMS = I_W1 + I_W2 + I_IN + I_OUT + I_UQ + I_UKV + I_AX + I_WR;
    for (int it = gw; it < NITEMS; it += NGW) {
        int r = it;
        if (r < I_W1) { const int e = r >> 10, q = r & 1023, kb = q >> 6, ng = q & 63; const int pn = ng >> 3, bj = (ng >> 2) & 1, c32 = ng & 3;
            transpose_item_fp8(F.w1 + (size_t)e * 1024 * 2048, 2048, bj * 1024 + 128 * pn + 32 * c32, WSP(unsigned char, WS_W1) + (size_t)e * 2048 * 1024, 1024, ng * 32, kb * 64, scr, F.lane); continue; } r -= I_W1;
        if (r < I_W2) { const int e = r >> 9, q = r & 511, kb = q >> 5, ng = q & 31;
            transpose_item_fp8(F.w2 + (size_t)e * 1024 * 1024, 1024, ng * 32, WSP(unsigned char, WS_W2) + (size_t)e * 1024 * 1024, 1024, ng * 32, kb * 64, scr, F.lane); continue; } r -= I_W2;
        if (r < I_IN) { const int kb = r / 48, ng = r % 48;
            transpose_item(F.w_in, DIN, 1024, ng < 45 ? ng * 32 : -1, nullptr, WSP(bf16, WS_WIN), 1024, ng * 32, kb * 64, scr, F.lane); continue; } r -= I_IN;
        if (r < I_OUT) { const int kb = r >> 5, ng = r & 31;
            transpose_item(F.w_out, 1024, 1024, ng * 32, nullptr, WSP(bf16, WS_WOUT), 1024, ng * 32, kb * 64, scr, F.lane); continue; } r -= I_OUT;
        if (r < I_UQ) { const int kb = r / 24, ng = r % 24;
            transpose_item(F.w_uq, 768, 256, ng * 32, F.g_q_lat, WSP(bf16, WS_WUQ), 256, ng * 32, kb * 64, scr, F.lane); continue; } r -= I_UQ;
        if (r < I_UKV) { const int kb = r >> 5, ng = r & 31; const int pn = ng >> 3, bj = (ng >> 2) & 1, wc = ng & 3; const int head = 2 * pn + (wc & 1);
            transpose_item(F.w_ukv, 1024, 128, head * 128 + (wc < 2 ? 0 : 64) + 32 * bj, F.g_kv_lat, WSP(bf16, WS_WUKV), 256, ng * 32, kb * 64, scr, F.lane); continue; } r -= I_UKV;
        if (r >= I_AX) { r -= I_AX; const int kb = r >> 3, ng = r & 7;
            transpose_item(F.w_router, NEXP, 1024, ng == 0 ? 0 : -1, nullptr, WSP(bf16, WS_WR), 1024, ng * 32, kb * 64, scr, F.lane); continue; }
        { const int g = r >> 4, n = (r >> 1) & 7, ng = r & 1;
            transpose_item((g ? F.w_x : F.w_a) + (size_t)n * 64 * 64, 64, 64, ng * 32, nullptr, WSP(bf16, WS_WAX) + (size_t)(g * 8 + n) * 64 * 64, 64, ng * 32, 0, scr, F.lane, -1.4426950408889634f); }
    }
    const GAS float* mod = WSG(float, WS_MOD); GAS bf16* H = WSG(bf16, WS_H); const GAS float* X = GG(float, F.x); const GAS float* gm = GG(float, F.g_mix);
    for (int m0 = gw * 2; m0 < T; m0 += NGW * 2) {
        const int b = m0 / SEQ;
        f32x4 v[2][4]; float s[2] = {0.f, 0.f};
#pragma unroll
        for (int r = 0; r < 2; ++r)
#pragma unroll
            for (int j = 0; j < 4; ++j) v[r][j] = __builtin_nontemporal_load((const GAS f32x4*)(X + (size_t)(m0 + r) * DM) + F.lane + 64 * j);
#pragma unroll
        for (int r = 0; r < 2; ++r) {
#pragma unroll
            for (int j = 0; j < 4; ++j) s[r] += (v[r][j][0] * v[r][j][0] + v[r][j][1] * v[r][j][1]) + (v[r][j][2] * v[r][j][2] + v[r][j][3] * v[r][j][3]);
            const float rstd = 1.0f / sqrtf(wave_sum(s[r]) * (1.0f / DM) + EPS);
            GAS u32x2* o8 = (GAS u32x2*)(H + (size_t)(m0 + r) * DM) + F.lane;
#pragma unroll
            for (int j = 0; j < 4; ++j) { const int col = 256 * j + 4 * F.lane;
                const f32x4 g = *(const GAS f32x4*)(gm + col), sh = *(const GAS f32x4*)(mod + (size_t)b * 6144 + col), scl = *(const GAS f32x4*)(mod + (size_t)b * 6144 + 1024 + col);
                const f32x4 o = v[r][j] * rstd * g * (scl + 1.0f) + sh;
                u32x2 w; w.x = pk2(o[0], o[1]); w.y = pk2(o[2], o[3]); o8[64 * j] = w; } }
    }
}

constexpr int LRU_XROW = 144, LRU_WL = 15616;
template <bool PASS2>
__device__ __forceinline__ void lru_pass(Frame& F) {
    const int lane = F.lane, n = F.wave, r32 = lane & 31, hi = lane >> 5;
    LAS unsigned char* wl = F.lds + n * LRU_WL; LAS unsigned char* xs = wl; LAS unsigned char* xcs = wl + 5120; LAS float* cw = (LAS float*)(wl + 5120 + 4608); LAS unsigned char* ys = wl + 5120 + 4608 + 1280;
#pragma unroll
    for (int j = 0; j < 4; ++j) cw[j * 64 + lane] = F.conv_w[j * DLRU + 64 * n + lane];
    cw[256 + lane] = F.conv_b[64 * n + lane];
    const GAS bf16* Wt = WSG(bf16, WS_WAX);
    bf16x8 wfa[2][4], wfx[2][4];
#pragma unroll
    for (int oc = 0; oc < 2; ++oc)
#pragma unroll
        for (int ks = 0; ks < 4; ++ks) { wfa[oc][ks] = *(const GAS bf16x8*)(Wt + ((size_t)((0 * 8 + n) * 64 + 32 * oc + r32) * 64 + 16 * ks + 8 * hi)); wfx[oc][ks] = *(const GAS bf16x8*)(Wt + ((size_t)((1 * 8 + n) * 64 + 32 * oc + r32) * 64 + 16 * ks + 8 * hi)); }
    float ba[2], bx[2], sp8[2];
#pragma unroll
    for (int oc = 0; oc < 2; ++oc) { const int ch = 64 * n + 32 * oc + r32; ba[oc] = -1.4426950408889634f * F.b_a[ch]; bx[oc] = -1.4426950408889634f * F.b_x[ch]; sp8[oc] = -8.0f * 1.4426950408889634f * log1pf(expf(-F.lam[ch])); }
    const GAS bf16* Z = WSG(bf16, WS_Z); GAS float* agg = WSG(float, WS_AGG); GAS bf16* MIX = WSG(bf16, WS_MIX);
    const int gw = F.vcu * 8 + F.wave, NGW = F.G * 8;
    for (int pidx = gw >> 3; pidx < NB * 32; pidx += (NGW >> 3)) {
        const int b = pidx >> 5, ttp = pidx & 31; const size_t rowb = (size_t)b * SEQ;
        float c[2] = {0.f, 0.f};
        if constexpr (PASS2) {
            for (int tp0 = 0; tp0 < 2 * ttp; tp0 += 8) {
                f32x2 ah[8][2];
#pragma unroll
                for (int j = 0; j < 8; ++j) { const int tp = (tp0 + j < 2 * ttp) ? tp0 + j : 2 * ttp - 1;
#pragma unroll
                    for (int oc = 0; oc < 2; ++oc) ah[j][oc] = *(const GAS f32x2*)(agg + ((size_t)((b * 64 + tp) * DLRU) + 64 * n + 32 * oc + r32) * 2); }
#pragma unroll
                for (int j = 0; j < 8; ++j) { const bool ok = tp0 + j < 2 * ttp;
#pragma unroll
                    for (int oc = 0; oc < 2; ++oc) c[oc] = ok ? ah[j][oc].x * c[oc] + ah[j][oc].y : c[oc]; } }
        }
#pragma unroll 1
        for (int u2 = 0; u2 < 2; ++u2) {
            const int tt = 2 * ttp + u2, t0 = tt * 64;
            float aprod[2] = {1.f, 1.f};
            if constexpr (!PASS2) { c[0] = 0.f; c[1] = 0.f; }
#pragma unroll 1
            for (int tt2 = 0; tt2 < 2; ++tt2) {
                const int tb = t0 + 32 * tt2;
#pragma unroll
                for (int i = 0; i < 5; ++i) { const int row = i * 8 + (lane >> 3), ch = lane & 7; const int t = tb - 3 + row;
                    if (row < 35) { u32x4 v = (u32x4){0u, 0u, 0u, 0u}; if (t >= 0) v = *(const GAS u32x4*)(Z + (rowb + t) * DINP + 64 * n + ch * 8);
                        *(LAS u32x4*)(xs + row * LRU_XROW + ch * 16) = v; } }
                if constexpr (PASS2) {
#pragma unroll
                    for (int i = 0; i < 4; ++i) { const int row = i * 8 + (lane >> 3), ch = lane & 7;
                        *(LAS u32x4*)(ys + row * LRU_XROW + ch * 16) = *(const GAS u32x4*)(Z + (rowb + tb + row) * DINP + DLRU + 64 * n + ch * 8); }
                }
                bf16x8 af[4];
#pragma unroll
                for (int ks = 0; ks < 4; ++ks) { const int c0 = 16 * ks + 8 * hi;
                    float xc[8];
                    { const f32x4 b0 = *(const LAS f32x4*)(cw + 256 + c0), b1 = *(const LAS f32x4*)(cw + 256 + c0 + 4);
#pragma unroll
                      for (int q = 0; q < 4; ++q) { xc[q] = b0[q]; xc[4 + q] = b1[q]; } }
#pragma unroll
                    for (int j = 0; j < 4; ++j) { const u32x4 xv = *(const LAS u32x4*)(xs + (r32 + j) * LRU_XROW + c0 * 2);
                        const f32x4 w0 = *(const LAS f32x4*)(cw + j * 64 + c0), w1 = *(const LAS f32x4*)(cw + j * 64 + c0 + 4);
                        xc[0] += w0[0] * bflo(xv.x); xc[1] += w0[1] * bfhi(xv.x); xc[2] += w0[2] * bflo(xv.y); xc[3] += w0[3] * bfhi(xv.y);
                        xc[4] += w1[0] * bflo(xv.z); xc[5] += w1[1] * bfhi(xv.z); xc[6] += w1[2] * bflo(xv.w); xc[7] += w1[3] * bfhi(xv.w); }
                    u32x4 pk; pk.x = pk2(xc[0], xc[1]); pk.y = pk2(xc[2], xc[3]); pk.z = pk2(xc[4], xc[5]); pk.w = pk2(xc[6], xc[7]);
                    af[ks] = __builtin_bit_cast(bf16x8, pk);
                    *(LAS u32x4*)(xcs + r32 * LRU_XROW + c0 * 2) = pk; }
#pragma unroll
                for (int oc = 0; oc < 2; ++oc) {
                    f32x16 da = {}, dx = {};
#pragma unroll
                    for (int ks = 0; ks < 4; ++ks) { da = __builtin_amdgcn_mfma_f32_32x32x16_bf16(af[ks], wfa[oc][ks], da, 0, 0, 0); dx = __builtin_amdgcn_mfma_f32_32x32x16_bf16(af[ks], wfx[oc][ks], dx, 0, 0, 0); }
                    float av[16], uv[16];
#pragma unroll
                    for (int r = 0; r < 16; ++r) { const int tl = crow(r, hi); const float xcv = bf2f(*(const LAS unsigned short*)(xcs + tl * LRU_XROW + (32 * oc + r32) * 2));
                        const float rg = __builtin_amdgcn_rcpf(1.0f + __builtin_amdgcn_exp2f(da[r] + ba[oc])), ig = __builtin_amdgcn_rcpf(1.0f + __builtin_amdgcn_exp2f(dx[r] + bx[oc])); const float a = __builtin_amdgcn_exp2f(rg * sp8[oc]);
                        av[r] = a; uv[r] = __builtin_amdgcn_sqrtf(fmaxf(1.0f - a * a, 0.f)) * ig * xcv; }
                    float As[4], Hs[4], cin[4];
#pragma unroll
                    for (int g = 0; g < 4; ++g) { float h = uv[4 * g]; float ap = av[4 * g];
#pragma unroll
                        for (int q = 1; q < 4; ++q) { h = av[4 * g + q] * h + uv[4 * g + q]; ap *= av[4 * g + q]; }
                        As[g] = ap; Hs[g] = h; }
                    float crun = c[oc];
#pragma unroll
                    for (int g = 0; g < 4; ++g) { const float o0 = As[g] * crun + Hs[g]; const float mid = __shfl_xor(o0, 32); const float ci = hi ? mid : crun; const float o1 = As[g] * ci + Hs[g];
                        const float fin = __shfl_xor(o1, 32); crun = hi ? o1 : fin; cin[g] = ci; }
                    c[oc] = crun;
                    if constexpr (!PASS2) { aprod[oc] *= (As[0] * As[1]) * (As[2] * As[3]); }
                    else {
#pragma unroll
                        for (int g = 0; g < 4; ++g) { float h = cin[g];
#pragma unroll
                            for (int q = 0; q < 4; ++q) { const int r = 4 * g + q; h = av[r] * h + uv[r];
                                LAS unsigned short* yp = (LAS unsigned short*)(ys + crow(r, hi) * LRU_XROW + (32 * oc + r32) * 2);
                                const float y = bf2f(*yp); const float ge = y * __builtin_amdgcn_rcpf(1.0f + __builtin_amdgcn_exp2f(y * (-2.3022082f + -0.1029432f * (y * y))));
                                *yp = (unsigned short)f2bf(ge * h); } }
                    }
                }
                if constexpr (PASS2) {
#pragma unroll
                    for (int i = 0; i < 4; ++i) { const int row = i * 8 + (lane >> 3), ch = lane & 7;
                        *(GAS u32x4*)(MIX + (rowb + tb + row) * DM + 64 * n + ch * 8) = *(const LAS u32x4*)(ys + row * LRU_XROW + ch * 16); }
                }
            }
            if constexpr (!PASS2) {
#pragma unroll
                for (int oc = 0; oc < 2; ++oc) { const float at = aprod[oc] * __shfl_xor(aprod[oc], 32);
                    if (hi == 0) *(GAS f32x2*)(agg + ((size_t)((b * 64 + tt) * DLRU) + 64 * n + 32 * oc + r32) * 2) = (f32x2){at, c[oc]}; }
            }
        }
    }
}

namespace att {
constexpr int KROW = 208, KTB = 64 * KROW, VROW = 192, VTB = 64 * VROW;
constexpr int OFF_K = 0, OFF_V = 2 * KTB, OFF_Q = 2 * KTB + 3 * VTB;
typedef short s16x4 __attribute__((ext_vector_type(4)));
__device__ __forceinline__ s16x4 vtr(const LAS unsigned char* p) { return __builtin_bit_cast(s16x4, __builtin_amdgcn_ds_read_tr16_b64_v4i16((LAS s16x4*)p)); }
__device__ __forceinline__ void unit(Frame& F, int b, int h, int qb, float MB) {
    const int tid = F.tid, lane = F.lane, w = F.wave, r32 = lane & 31, hi = lane >> 5;
    const GAS bf16* Qb = WSG(bf16, WS_Q); const GAS bf16* Kb = WSG(bf16, WS_K); const GAS bf16* Vb = WSG(bf16, WS_V); GAS bf16* MIX = WSG(bf16, WS_MIX);
    const GAS float* ct = WSG(float, WS_COS); const GAS float* st = WSG(float, WS_SIN); const GAS float* gqn = GG(float, F.g_qn);
    const size_t rowb = (size_t)b * SEQ; const int qrow = qb * 256 + w * 32 + r32; const size_t gr = rowb + qrow;
    bf16x8 qr[6];
    {
        float qf[6][8]; float ss = 0.f;
#pragma unroll
        for (int ks = 0; ks < 6; ++ks) { const u32x4 v = *(const GAS u32x4*)(Qb + gr * 768 + h * QKH + 16 * ks + 8 * hi);
            qf[ks][0] = bflo(v.x); qf[ks][1] = bfhi(v.x); qf[ks][2] = bflo(v.y); qf[ks][3] = bfhi(v.y); qf[ks][4] = bflo(v.z); qf[ks][5] = bfhi(v.z); qf[ks][6] = bflo(v.w); qf[ks][7] = bfhi(v.w);
#pragma unroll
            for (int j = 0; j < 8; ++j) ss += qf[ks][j] * qf[ks][j]; }
        ss += __shfl_xor(ss, 32);
        const float rs = __builtin_amdgcn_rsqf(ss * (1.0f / QKH) + EPS);
#pragma unroll
        for (int ks = 0; ks < 6; ++ks)
#pragma unroll
            for (int j = 0; j < 8; ++j) qf[ks][j] *= rs * gqn[16 * ks + 8 * hi + j];
#pragma unroll
        for (int j = 0; j < 8; ++j) { const float cs = ct[gr * 16 + 8 * hi + j], sn = st[gr * 16 + 8 * hi + j]; const float a = qf[4][j], bb = qf[5][j]; qf[4][j] = a * cs - bb * sn; qf[5][j] = bb * cs + a * sn; }
        const float sc = 0.10206207261596575f * 1.4426950408889634f;
#pragma unroll
        for (int ks = 0; ks < 6; ++ks) { u32x4 pk; pk.x = pk2(qf[ks][0] * sc, qf[ks][1] * sc); pk.y = pk2(qf[ks][2] * sc, qf[ks][3] * sc); pk.z = pk2(qf[ks][4] * sc, qf[ks][5] * sc); pk.w = pk2(qf[ks][6] * sc, qf[ks][7] * sc);
            qr[ks] = __builtin_bit_cast(bf16x8, pk); }
    }
    LAS unsigned char* qlds = F.lds + OFF_Q + w * 6144 + hi * 512 + r32 * 16;
#pragma unroll
    for (int ks = 0; ks < 6; ++ks) *(LAS bf16x8*)(qlds + ks * 1024) = qr[ks];
    const int NT = 4 * (qb + 1);
    const int kr1 = tid / 12, kc1 = tid % 12, kr2 = (512 + tid) / 12, kc2 = (512 + tid) % 12; const bool k2 = tid < 256;
    const int vr = tid >> 3, vc = tid & 7;
    const GAS char* kbase = (const GAS char*)(Kb + rowb * 768 + h * QKH); const GAS char* vbase_g = (const GAS char*)(Vb + rowb * 512 + h * VH);
    const unsigned ko1 = (unsigned)(kr1 * 768 + kc1 * 8) * 2u, ko2 = (unsigned)(kr2 * 768 + kc2 * 8) * 2u, vo1 = (unsigned)(vr * 512 + vc * 8) * 2u;
    LAS unsigned char* L = F.lds;
    u32x4 skA1, skA2 = (u32x4){0u, 0u, 0u, 0u}, svA;
#define ATT_BAR() do { __builtin_amdgcn_sched_barrier(0); asm volatile("s_waitcnt lgkmcnt(0)" ::: "memory"); __builtin_amdgcn_s_barrier(); asm volatile("" ::: "memory"); __builtin_amdgcn_sched_barrier(0); } while (0)
#define ATT_LOADK(X, t) do { const GAS char* kt_ = kbase + (size_t)(t) * (64 * 768 * 2); sk##X##1 = *(const GAS u32x4*)(kt_ + ko1); if (k2) sk##X##2 = *(const GAS u32x4*)(kt_ + ko2); } while (0)
#define ATT_LOADV(X, t) do { sv##X = *(const GAS u32x4*)(vbase_g + (size_t)(t) * (64 * 512 * 2) + vo1); } while (0)
#define ATT_WRITEK(X, buf) do { *(LAS u32x4*)(L + OFF_K + (buf) * KTB + kr1 * KROW + kc1 * 16) = sk##X##1; if (k2) *(LAS u32x4*)(L + OFF_K + (buf) * KTB + kr2 * KROW + kc2 * 16) = sk##X##2; } while (0)
#define ATT_WRITEV(X, voff) do { *(LAS u32x4*)(L + OFF_V + (voff) + vr * VROW + vc * 16) = sv##X; } while (0)
#define ATT_QK(S0, S1, buf) do { const LAS unsigned char* kb_ = L + OFF_K + (buf) * KTB + r32 * KROW + hi * 16; \
        _Pragma("unroll") for (int ks = 0; ks < 6; ++ks) { const bf16x8 a0 = *(const LAS bf16x8*)(kb_ + ks * 32), a1 = *(const LAS bf16x8*)(kb_ + 32 * KROW + ks * 32); \
            const bf16x8 qv = *(const LAS bf16x8*)(qlds + ks * 1024); \
            if (ks == 0) { S0 = __builtin_amdgcn_mfma_f32_32x32x16_bf16(a0, qv, f32x16{}, 0, 0, 0); S1 = __builtin_amdgcn_mfma_f32_32x32x16_bf16(a1, qv, f32x16{}, 0, 0, 0); } \
            else { S0 = __builtin_amdgcn_mfma_f32_32x32x16_bf16(a0, qv, S0, 0, 0, 0); S1 = __builtin_amdgcn_mfma_f32_32x32x16_bf16(a1, qv, S1, 0, 0, 0); } } } while (0)
#define ATT_PV(voff) do { const LAS unsigned char* vb = vbase + (voff); \
        _Pragma("unroll") for (int s4 = 0; s4 < 4; ++s4) { const bf16x8 pfv = __builtin_bit_cast(bf16x8, pf[s4]); \
            _Pragma("unroll") for (int d = 0; d < 2; ++d) { const LAS unsigned char* vp = vb + (16 * s4) * VROW + (32 * d) * 2; \
                const s16x4 lo = vtr(vp), hh = vtr(vp + 8 * VROW); \
                const bf16x8 vv = __builtin_shufflevector(lo, hh, 0, 1, 2, 3, 4, 5, 6, 7); \
                o[d] = __builtin_amdgcn_mfma_f32_32x32x16_bf16(vv, pfv, o[d], 0, 0, 0); } } } while (0)
    const float sh = fmaxf(MB - 100.0f, 0.f);
    { u32x4 skT1, skT2 = (u32x4){0u, 0u, 0u, 0u};
      ATT_LOADK(A, 0); ATT_LOADV(A, 0); ATT_LOADK(T, 1); ATT_WRITEK(A, 0); ATT_WRITEV(A, 0); ATT_WRITEK(T, 1); }
    for (int i = tid; i < VTB / 8; i += 512) *(LAS u32x2*)(L + OFF_V + 2 * VTB + i * 8) = (u32x2){0u, 0u};
    ATT_LOADK(A, 2); ATT_LOADV(A, 1);
    ATT_BAR();
    float lsum = 0.f; f32x16 o[2]; o[0] = f32x16{}; o[1] = f32x16{};
    const int wq_max = qb * 256 + w * 32 + 31;
    f32x16 pa0, pa1, pb0 = f32x16{}, pb1 = f32x16{};
    u32x4 pf[4]; pf[0] = pf[1] = pf[2] = pf[3] = (u32x4){0u, 0u, 0u, 0u};
    ATT_QK(pa0, pa1, 0);
    const LAS unsigned char* vbase = L + OFF_V + (4 * hi + ((lane & 15) >> 2)) * VROW + (16 * ((lane >> 4) & 1) + 4 * (lane & 3)) * 2;
    int vprev = 2 * VTB, vcur = 0, vnext = VTB;
#ifndef ATT_DUP
#define ATT_DUP 0
#endif
#ifndef ATT_HINT_MODE
#define ATT_HINT_MODE 3
#endif
#if ATT_HINT_MODE == 0
#define ATT_HINT(C) do {} while (0)
#elif ATT_HINT_MODE == 1
#define ATT_HINT(C) do { if (C) { _Pragma("unroll") for (int i_ = 0; i_ < 20; ++i_) { __builtin_amdgcn_sched_group_barrier(0x008, 1, 0); __builtin_amdgcn_sched_group_barrier(0x002, 5, 0); } } } while (0)
#elif ATT_HINT_MODE == 3
#define ATT_HINT(C) do { if (C) { __builtin_amdgcn_sched_group_barrier(0x100, 6, 0); \
        _Pragma("unroll") for (int i_ = 0; i_ < 6; ++i_) { __builtin_amdgcn_sched_group_barrier(0x008, 1, 0); __builtin_amdgcn_sched_group_barrier(0x002, 5, 0); __builtin_amdgcn_sched_group_barrier(0x008, 1, 0); __builtin_amdgcn_sched_group_barrier(0x100, 3, 0); __builtin_amdgcn_sched_group_barrier(0x002, 5, 0); } \
        _Pragma("unroll") for (int i_ = 0; i_ < 8; ++i_) { __builtin_amdgcn_sched_group_barrier(0x008, 1, 0); __builtin_amdgcn_sched_group_barrier(0x100, 2, 0); __builtin_amdgcn_sched_group_barrier(0x002, 6, 0); } } } while (0)
#elif ATT_HINT_MODE == 2
#define ATT_HINT(C) do { if (C) { __builtin_amdgcn_sched_group_barrier(0x100, 18, 0); \
        _Pragma("unroll") for (int i_ = 0; i_ < 12; ++i_) { __builtin_amdgcn_sched_group_barrier(0x008, 1, 0); if (i_ < 8) __builtin_amdgcn_sched_group_barrier(0x100, 2, 0); __builtin_amdgcn_sched_group_barrier(0x002, 4, 0); } \
        _Pragma("unroll") for (int i_ = 0; i_ < 8; ++i_) { __builtin_amdgcn_sched_group_barrier(0x008, 1, 0); __builtin_amdgcn_sched_group_barrier(0x002, 6, 0); } } } while (0)
#endif
#define ATT_STEP(t, P0, P1, N0, N1, CLEAN) do { const int buf = (t) & 1; \
        if (CLEAN || (((t) + 1 < NT) && (64 * ((t) + 1) <= wq_max))) ATT_QK(N0, N1, buf ^ 1); \
        if (CLEAN || (64 * ((t) - 1) <= wq_max)) ATT_PV(vprev); \
        if (CLEAN || (64 * (t) <= wq_max)) { \
            if (!CLEAN && (t) >= 4 * qb) { const int kv0 = 64 * (t) + 4 * hi; \
                _Pragma("unroll") for (int r = 0; r < 16; ++r) { const int kv = kv0 + (r & 3) + 8 * (r >> 2); if (kv > qrow) P0[r] = -1e30f; if (kv + 32 > qrow) P1[r] = -1e30f; } } \
            if (!CLEAN) { if (sh > 0.f) { _Pragma("unroll") for (int r = 0; r < 16; ++r) { P0[r] -= sh; P1[r] -= sh; } } } \
            f32x2 ps0 = {0.f, 0.f}, ps1 = {0.f, 0.f}, ps2 = {0.f, 0.f}, ps3 = {0.f, 0.f};     \
            _Pragma("unroll") for (int r = 0; r < 16; ++r) { P0[r] = __builtin_amdgcn_exp2f(P0[r]); P1[r] = __builtin_amdgcn_exp2f(P1[r]); } \
            _Pragma("unroll") for (int r = 0; r < 16; r += 4) { ps0 += (f32x2){P0[r], P0[r + 1]}; ps1 += (f32x2){P0[r + 2], P0[r + 3]}; ps2 += (f32x2){P1[r], P1[r + 1]}; ps3 += (f32x2){P1[r + 2], P1[r + 3]}; } \
            { const f32x2 pt = (ps0 + ps1) + (ps2 + ps3); lsum += pt.x + pt.y; } \
            _Pragma("unroll") for (int s = 0; s < 2; ++s) { \
                pf[s].x = cvt_pk_bf16(P0[8 * s + 0], P0[8 * s + 1]); pf[s].y = cvt_pk_bf16(P0[8 * s + 2], P0[8 * s + 3]); pf[s].z = cvt_pk_bf16(P0[8 * s + 4], P0[8 * s + 5]); pf[s].w = cvt_pk_bf16(P0[8 * s + 6], P0[8 * s + 7]); \
                pf[2 + s].x = cvt_pk_bf16(P1[8 * s + 0], P1[8 * s + 1]); pf[2 + s].y = cvt_pk_bf16(P1[8 * s + 2], P1[8 * s + 3]); pf[2 + s].z = cvt_pk_bf16(P1[8 * s + 4], P1[8 * s + 5]); pf[2 + s].w = cvt_pk_bf16(P1[8 * s + 6], P1[8 * s + 7]); } \
        } else { pf[0] = pf[1] = pf[2] = pf[3] = (u32x4){0u, 0u, 0u, 0u}; } \
        ATT_HINT(CLEAN); \
        ATT_WRITEK(A, buf); \
        ATT_WRITEV(A, vnext); \
        if (ATT_DUP && CLEAN) { asm volatile("" ::: "memory"); ATT_WRITEK(A, buf); ATT_WRITEV(A, vnext); asm volatile("" ::: "memory"); \
            ATT_LOADK(A, ((t) + 3 < NT) ? (t) + 3 : NT - 1); ATT_LOADV(A, ((t) + 2 < NT) ? (t) + 2 : NT - 1); asm volatile("" : "+v"(skA1), "+v"(skA2), "+v"(svA)); } \
        ATT_LOADK(A, ((t) + 3 < NT) ? (t) + 3 : NT - 1); \
        ATT_LOADV(A, ((t) + 2 < NT) ? (t) + 2 : NT - 1); \
        ATT_BAR(); \
        { const int tmp_ = vprev; vprev = vcur; vcur = vnext; vnext = tmp_; } } while (0)
    int t = 0;
    if (sh == 0.f) for (; t < 4 * qb; t += 2) { ATT_STEP(t, pa0, pa1, pb0, pb1, 1); ATT_STEP(t + 1, pb0, pb1, pa0, pa1, 1); }
    for (; t < NT; t += 2) { ATT_STEP(t, pa0, pa1, pb0, pb1, 0); ATT_STEP(t + 1, pb0, pb1, pa0, pa1, 0); }
    if (64 * (NT - 1) <= wq_max) ATT_PV(vprev);
    ATT_BAR();
#undef ATT_STEP
#undef ATT_HINT
#undef ATT_BAR
#undef ATT_PV
#undef ATT_LOADK
#undef ATT_LOADV
#undef ATT_WRITEK
#undef ATT_WRITEV
#undef ATT_QK
    lsum += __shfl_xor(lsum, 32);
    const float inv = 1.0f / lsum;
    GAS bf16* op = MIX + gr * DM + DLRU + h * VH;
#pragma unroll
    for (int d = 0; d < 2; ++d)
#pragma unroll
        for (int g = 0; g < 4; ++g) { u32x2 wv; wv.x = cvt_pk_bf16(o[d][4 * g] * inv, o[d][4 * g + 1] * inv); wv.y = cvt_pk_bf16(o[d][4 * g + 2] * inv, o[d][4 * g + 3] * inv);
            *(GAS u32x2*)(op + 32 * d + 8 * g + 4 * hi) = wv; }
}
__device__ __forceinline__ void phase(Frame& F) {
    float gq = 0.f, gk = 0.f;
    for (int i = 0; i < QKH; ++i) { gq = fmaxf(gq, fabsf(F.g_qn[i])); gk = fmaxf(gk, fabsf(F.g_kn[i])); }
    const float MB = 9.797958971f * 1.4426950408889634f * gq * gk * 1.02f;
    for (int pi = F.vcu; pi < 512; pi += F.G) {
        const int bh = pi >> 3, s = pi & 7;
        unit(F, bh >> 3, bh & 7, 15 - s, MB);
        unit(F, bh >> 3, bh & 7, s, MB);
    }
}
}

__device__ __forceinline__ void p6a_norm(Frame& F) {
    const GAS float* mod = WSG(float, WS_MOD); GAS unsigned char* H2 = WSG(unsigned char, WS_H2); GAS bf16* H2B = WSG(bf16, WS_H2B);
    const GAS float* gf = GG(float, F.g_ffn); const GAS bf16* X1 = WSG(bf16, WS_X1B);
    const int gw = F.vcu * 8 + F.wave, NGW = F.G * 8, lane = F.lane;
    for (int m0 = gw * 2; m0 < T; m0 += NGW * 2) {
        const int b = m0 / SEQ;
        u32x4 xr[2][2];
#pragma unroll
        for (int r = 0; r < 2; ++r)
#pragma unroll
            for (int h = 0; h < 2; ++h) xr[r][h] = *(const GAS u32x4*)(X1 + (size_t)(m0 + r) * DM + 16 * lane + 8 * h);
        f32x4 G[4], S[4];
#pragma unroll
        for (int q = 0; q < 4; ++q) { const int col = 16 * lane + 4 * q; const f32x4 g = *(const GAS f32x4*)(gf + col), sc = *(const GAS f32x4*)(mod + (size_t)b * 6144 + 4096 + col);
            G[q] = g * (sc + 1.0f); S[q] = *(const GAS f32x4*)(mod + (size_t)b * 6144 + 3072 + col); }
#pragma unroll
        for (int r = 0; r < 2; ++r) { f32x4 v[4];
#pragma unroll
            for (int h = 0; h < 2; ++h) { v[2 * h] = (f32x4){bflo(xr[r][h].x), bfhi(xr[r][h].x), bflo(xr[r][h].y), bfhi(xr[r][h].y)}; v[2 * h + 1] = (f32x4){bflo(xr[r][h].z), bfhi(xr[r][h].z), bflo(xr[r][h].w), bfhi(xr[r][h].w)}; }
            float s = 0.f;
#pragma unroll
            for (int q = 0; q < 4; ++q) s += (v[q][0] * v[q][0] + v[q][1] * v[q][1]) + (v[q][2] * v[q][2] + v[q][3] * v[q][3]);
            const float rstd = 1.0f / sqrtf(wave_sum(s) * (1.0f / DM) + EPS);
            u32x4 o8, ob[2];
#pragma unroll
            for (int q = 0; q < 4; ++q) { const f32x4 hv = v[q] * rstd * G[q] + S[q];
                o8[q] = pk4_fp8(hv[0], hv[1], hv[2], hv[3]);
                ob[q >> 1][2 * (q & 1)] = cvt_pk_bf16(hv[0], hv[1]); ob[q >> 1][2 * (q & 1) + 1] = cvt_pk_bf16(hv[2], hv[3]); }
            *(GAS u32x4*)(H2 + (size_t)(m0 + r) * DM + 16 * lane) = o8;
            *(GAS u32x4*)(H2B + (size_t)(m0 + r) * DM + 16 * lane) = ob[0]; *(GAS u32x4*)(H2B + (size_t)(m0 + r) * DM + 16 * lane + 8) = ob[1]; }
    }
}
__device__ __forceinline__ void p6c_topk(Frame& F) {
    LAS int* hist = (LAS int*)(F.lds + TAB_OFF); LAS int* base = hist + 32;
    const GAS float* logit = WSG(float, WS_LOGIT); GAS int* list = WSG(int, WS_LIST); GAS float* gates = WSG(float, WS_GATES);
    unsigned* gcount = F.ctl + CW_CNT;
    for (int chunk = blockIdx.x; chunk < T / 128; chunk += F.G) {
        if (F.tid < 32) hist[F.tid] = 0;
        __syncthreads();
        const int row = chunk * 128 + F.tid; const bool act = F.tid < 128;
        int se[4] = {0, 0, 0, 0}, lp[4] = {0, 0, 0, 0}; float gk[4] = {0.f, 0.f, 0.f, 0.f};
        if (act) {
            float v[32];
#pragma unroll
            for (int q = 0; q < 8; ++q) { const f32x4 t = *(const GAS f32x4*)(logit + (size_t)row * NEXP + 4 * q); v[4 * q] = t[0]; v[4 * q + 1] = t[1]; v[4 * q + 2] = t[2]; v[4 * q + 3] = t[3]; }
            float sv[4];
#pragma unroll
            for (int k = 0; k < 4; ++k) { float best = v[0]; int bi = 0;
#pragma unroll
                for (int e = 1; e < 32; ++e) { const bool gt = v[e] > best; best = gt ? v[e] : best; bi = gt ? e : bi; }
                sv[k] = best; se[k] = bi;
#pragma unroll
                for (int e = 0; e < 32; ++e) v[e] = (e == bi) ? -3.0e38f : v[e]; }
            const float t1 = fast_exp(sv[1] - sv[0]), t2 = fast_exp(sv[2] - sv[0]), t3 = fast_exp(sv[3] - sv[0]); const float rinv = 1.0f / (1.0f + t1 + t2 + t3);
            gk[0] = rinv; gk[1] = t1 * rinv; gk[2] = t2 * rinv; gk[3] = t3 * rinv;
#pragma unroll
            for (int k = 0; k < 4; ++k) lp[k] = __hip_atomic_fetch_add(hist + se[k], 1, __ATOMIC_RELAXED, __HIP_MEMORY_SCOPE_WORKGROUP);
        }
        __syncthreads();
        if (F.tid < 32) base[F.tid] = (int)__hip_atomic_fetch_add(gcount + F.tid, (unsigned)hist[F.tid], RLX_AGENT);
        __syncthreads();
        if (act) {
#pragma unroll
            for (int k = 0; k < 4; ++k) { const int ent = row * 4 + k; list[(size_t)se[k] * T + base[se[k]] + lp[k]] = ent; gates[ent] = gk[k]; }
        }
        __syncthreads();
    }
}

__device__ __forceinline__ void moe_tables(Frame& F) {
    LAS int* tab = (LAS int*)(F.lds + TAB_OFF);
    if (F.tid == 0) { int acc = 0;
        for (int e = 0; e < NEXP; ++e) { const int c = (int)__hip_atomic_load(F.ctl + CW_CNT + e, RLX_AGENT); tab[e] = acc; tab[33 + e] = c; acc += (c + 255) >> 8; }
        tab[32] = acc; }
    __syncthreads();
}

__device__ __forceinline__ void p9_combine(Frame& F) {
    const GAS float* mod = WSG(float, WS_MOD); const GAS unsigned char* Y4 = WSG(unsigned char, WS_Y4); GAS float* O = (GAS float*)F.out; const GAS bf16* X1 = WSG(bf16, WS_X1B);
    const int gw = F.vcu * 8 + F.wave, NGW = F.G * 8, lane = F.lane;
    for (int m0 = gw * 2; m0 < T; m0 += NGW * 2) {
        const int b = m0 / SEQ;
        u32x4 y[2][4], xr[2][2];
#pragma unroll
        for (int r = 0; r < 2; ++r) {
#pragma unroll
            for (int k = 0; k < 4; ++k) y[r][k] = *(const GAS u32x4*)(Y4 + ((size_t)(m0 + r) * 4 + k) * DM + 16 * lane);
#pragma unroll
            for (int h = 0; h < 2; ++h) xr[r][h] = *(const GAS u32x4*)(X1 + (size_t)(m0 + r) * DM + 16 * lane + 8 * h); }
        f32x4 g2[4];
#pragma unroll
        for (int q = 0; q < 4; ++q) g2[q] = *(const GAS f32x4*)(mod + (size_t)b * 6144 + 5120 + 16 * lane + 4 * q) * 0.0625f;
#pragma unroll
        for (int r = 0; r < 2; ++r)
#pragma unroll
            for (int q = 0; q < 4; ++q) { f32x4 s = (f32x4){0.f, 0.f, 0.f, 0.f};
#pragma unroll
                for (int k = 0; k < 4; ++k) { const int w = (int)y[r][k][q]; const f32x2 lo = __builtin_amdgcn_cvt_pk_f32_fp8(w, false), hi2 = __builtin_amdgcn_cvt_pk_f32_fp8(w, true); s[0] += lo[0]; s[1] += lo[1]; s[2] += hi2[0]; s[3] += hi2[1]; }
                const unsigned w0 = xr[r][q >> 1][2 * (q & 1)], w1 = xr[r][q >> 1][2 * (q & 1) + 1];
                const f32x4 xv = (f32x4){bflo(w0), bfhi(w0), bflo(w1), bfhi(w1)};
                *(GAS f32x4*)(O + (size_t)(m0 + r) * DM + 16 * lane + 4 * q) = xv + g2[q] * s; }
    }
}

struct Args { const void* in[28]; float* out; unsigned char* ws; int ph_lo, ph_hi; };
__global__ void __launch_bounds__(512, 2) mega_fwd(Args args) {
    extern __shared__ __attribute__((aligned(16))) unsigned char lds_raw[];
    Frame F;
    F.lds = (LAS unsigned char*)lds_raw;
    F.wave = __builtin_amdgcn_readfirstlane((int)threadIdx.x >> 6); F.lane = lane_id(); F.tid = F.wave * 64 + F.lane;
    F.G = gridDim.x; { const int bx = blockIdx.x; F.vcu = (F.G % 8 == 0) ? (bx % 8) * (F.G / 8) + bx / 8 : bx; }
    F.x = F.c = F.w_ada = F.b_ada = F.g_mix = F.w_in = F.conv_w = F.conv_b = F.w_a = F.b_a = F.w_x = F.b_x = F.lam = F.g_q_lat = F.w_uq = F.g_kv_lat = F.w_ukv = F.g_qn = F.g_kn = F.w_out = F.g_ffn = F.w_router = F.b_router = F.w1 = F.b1 = F.w2 = F.b2 = nullptr; F.pos = nullptr;
#define LDIN(field, idx) F.field = (decltype(F.field))(GAS void*)args.in[idx]
#define PH_BEGIN() do { unsigned char* w_ = args.ws; asm volatile("" : "+s"(w_)); F.ws = (unsigned char*)(GAS unsigned char*)w_; F.ctl = (unsigned*)(F.ws + WS_CTL); F.lane = lane_id(); F.tid = F.wave * 64 + F.lane; } while (0)
    F.out = (float*)(GAS float*)args.out; F.ws = (unsigned char*)(GAS unsigned char*)args.ws; F.ctl = (unsigned*)(F.ws + WS_CTL);
    for (int u = F.tid; u < (LDS_BYTES - LDSCTL_OFF) / 4; u += 512) ((LAS unsigned*)(F.lds + LDSCTL_OFF))[u] = 0u;
    __syncthreads();
    const int lo = args.ph_lo, hi = args.ph_hi;
    const bool multi = (hi - lo) > 1;
    XcdBarrier bar; bar.bar = F.ctl + CW_BAR; bar.x = 0; bar.st = nullptr;
    if (multi) bar = xcd_barrier_post(F.ctl + CW_BAR, (volatile LAS unsigned*)(F.lds + MISC_OFF), F.tid == 0);
#ifndef PH_MASK
#define PH_MASK 0xfff
#endif
#define IN(k) ((((PH_MASK) >> (k)) & 1) && lo <= (k) && (k) < hi)
#define LEADER() (F.wave == 0 && lane_id() == 0)
#define SEAM(k) do { if (IN(k) && IN((k) + 1)) xcd_barrier(bar, LEADER()); } while (0)

    if (IN(0)) { PH_BEGIN(); LDIN(c, 1); LDIN(pos, 2); LDIN(w_ada, 3); LDIN(b_ada, 4); p0_mod_rope(F); SEAM(0); }
    if (IN(1)) { PH_BEGIN(); LDIN(x, 0); LDIN(g_mix, 5); LDIN(w_in, 6); LDIN(w_router, 22); LDIN(w_a, 9); LDIN(w_x, 11); LDIN(g_q_lat, 14); LDIN(w_uq, 15); LDIN(g_kv_lat, 16); LDIN(w_ukv, 17); LDIN(w_out, 20); LDIN(w1, 24); LDIN(w2, 26);
        p1_convert_norm(F); SEAM(1); }
    if (IN(2)) { PH_BEGIN();
        pg8::DenseSched S; S.init(WSG(bf16, WS_H), DM, WSG(bf16, WS_WIN), DM, T, DINP, F.G, (int)blockIdx.x);
        pg8::EpiZ E{WSG(bf16, WS_Z), WSG(float, WS_SSQ)};
        pg8::gemm_phase<pg8::EpiZ, pg8::DenseSched, true>(F.lds, DM * 2, S, E, F.wave);
        SEAM(2);
    }
    if (IN(3)) { PH_BEGIN();
        LDIN(conv_w, 7); LDIN(conv_b, 8); LDIN(b_a, 10); LDIN(b_x, 12); LDIN(lam, 13); LDIN(g_kn, 19);
#ifndef P3_PARTS
#define P3_PARTS 7
#endif
        if (P3_PARTS & 1) { pg8::DenseSched S; S.init(WSG(bf16, WS_Z) + 1024, DINP, WSG(bf16, WS_WUQ), 256, T, 768, F.G, (int)blockIdx.x);
          pg8::EpiQ E{WSG(bf16, WS_Q), WSG(float, WS_SSQ)};
          pg8::gemm_phase<pg8::EpiQ, pg8::DenseSched, true>(F.lds, 512, S, E, F.wave); }
        if (P3_PARTS & 2) { pg8::DenseSched S; S.init(WSG(bf16, WS_Z) + 1280, DINP, WSG(bf16, WS_WUKV), 256, T, 1024, F.G, (int)blockIdx.x);
          pg8::EpiKV E{WSG(bf16, WS_K), WSG(bf16, WS_V), WSG(bf16, WS_Z), WSG(float, WS_SSQ), GG(float, F.g_kn), WSG(float, WS_COS), WSG(float, WS_SIN)};
          pg8::gemm_phase<pg8::EpiKV, pg8::DenseSched, true>(F.lds, 512, S, E, F.wave); }
#ifndef P3_LRU_REP
#define P3_LRU_REP 1
#endif
        if (P3_PARTS & 4) for (int rr_ = 0; rr_ < P3_LRU_REP; ++rr_) lru_pass<false>(F);
        SEAM(3);
    }
    if (IN(4)) { PH_BEGIN();
        LDIN(conv_w, 7); LDIN(conv_b, 8); LDIN(b_a, 10); LDIN(b_x, 12); LDIN(lam, 13); LDIN(g_qn, 18); LDIN(g_kn, 19);
#ifndef P4_PARTS
#define P4_PARTS 3
#endif
#ifndef P4_LRU_REP
#define P4_LRU_REP 1
#endif
        if (P4_PARTS & 1) for (int rr_ = 0; rr_ < P4_LRU_REP; ++rr_) lru_pass<true>(F);
        __syncthreads();
        if (P4_PARTS & 2) att::phase(F);
        SEAM(4);
    }
    if (IN(5)) { PH_BEGIN();
        LDIN(x, 0);
        pg8::DenseSched S; S.init(WSG(bf16, WS_MIX), DM, WSG(bf16, WS_WOUT), DM, T, DM, F.G, (int)blockIdx.x);
        pg8::EpiX1 E{GG(float, F.x), WSG(bf16, WS_X1B), WSG(float, WS_MOD) + 2048};
        pg8::gemm_phase<pg8::EpiX1, pg8::DenseSched, true>(F.lds, DM * 2, S, E, F.wave);
        SEAM(5);
    }
    if (IN(6)) { PH_BEGIN(); LDIN(g_ffn, 21); p6a_norm(F); SEAM(6); }
    if (IN(7)) { PH_BEGIN(); LDIN(b_router, 23);
        pg8::DenseSched S; S.init(WSG(bf16, WS_H2B), DM, WSG(bf16, WS_WR), DM, T, 256, F.G, (int)blockIdx.x);
        pg8::EpiLogit E{WSG(float, WS_LOGIT), GG(float, F.b_router)};
        pg8::gemm_phase<pg8::EpiLogit, pg8::DenseSched, true>(F.lds, DM * 2, S, E, F.wave);
        SEAM(7); }
    if (IN(8)) { PH_BEGIN(); p6c_topk(F); SEAM(8); }
    if (IN(9)) { PH_BEGIN();
        LDIN(b1, 25);
        moe_tables(F);
        pg8::MoeSched<8, true> S{(const LAS int*)(F.lds + TAB_OFF), WSG(int, WS_LIST), WSG(unsigned char, WS_H2), WSG(unsigned char, WS_W1), F.G, F.vcu, (size_t)2048 * 1024, nullptr, nullptr, GG(float, F.b1), (LAS float*)(F.lds + BIASTAB_OFF)};
        pg8::EpiAct E{WSG(unsigned char, WS_ACT), (const LAS float*)(F.lds + BIASTAB_OFF)};
        pg8::gemm_phase<pg8::EpiAct, pg8::MoeSched<8, true>, true, true>(F.lds, DM, S, E, F.wave);
        SEAM(9);
    }
    if (IN(10)) { PH_BEGIN();
        LDIN(b2, 27);
        moe_tables(F);
        pg8::MoeSched<4, false> S{(const LAS int*)(F.lds + TAB_OFF), WSG(int, WS_LIST), WSG(unsigned char, WS_ACT), WSG(unsigned char, WS_W2), F.G, F.vcu, (size_t)1024 * 1024, WSG(float, WS_GATES), (LAS unsigned*)(F.lds + ROWTAB_OFF), GG(float, F.b2), (LAS float*)(F.lds + BIASTAB_OFF)};
        pg8::EpiY E{WSG(unsigned char, WS_Y4), (const LAS float*)(F.lds + BIASTAB_OFF), (const LAS unsigned*)(F.lds + ROWTAB_OFF), (const LAS int*)(F.lds + TAB_OFF)};
        pg8::gemm_phase<pg8::EpiY, pg8::MoeSched<4, false>, true, true>(F.lds, DFF, S, E, F.wave);
        SEAM(10);
    }
    if (IN(11)) { PH_BEGIN(); p9_combine(F); }
#undef IN
#undef SEAM
}

extern "C" void kernel_launch(void* const* d_in, const int* in_sizes, int n_in, void* d_out, int out_size, void* d_ws, size_t ws_size, hipStream_t stream) {
    static int grid = 0;
    if (grid == 0) {
        if (n_in != 28 || out_size != T * DM || ws_size < WS_END) { fprintf(stderr, "kernel_launch: unexpected shapes (n_in %d out %d ws %zu)\n", n_in, out_size, ws_size); grid = -1; return; }
        int dev = 0, cus = 0, per_cu = 0;
        if (hipGetDevice(&dev) != hipSuccess || hipDeviceGetAttribute(&cus, hipDeviceAttributeMultiprocessorCount, dev) != hipSuccess) { grid = -1; return; }
        if (hipFuncSetAttribute((const void*)mega_fwd, hipFuncAttributeMaxDynamicSharedMemorySize, LDS_BYTES) != hipSuccess) { fprintf(stderr, "kernel_launch: hipFuncSetAttribute failed\n"); grid = -1; return; }
        if (hipOccupancyMaxActiveBlocksPerMultiprocessor(&per_cu, (const void*)mega_fwd, 512, LDS_BYTES) != hipSuccess || per_cu < 1) { fprintf(stderr, "kernel_launch: occupancy query says %d blocks per CU\n", per_cu); per_cu = 1; }
        (void)hipGetLastError();
        grid = cus;
    }
    if (grid < 0) return;
    (void)hipMemsetAsync((char*)d_ws + WS_CTL, 0, CTL_ZERO_BYTES, stream);
    Args a{};
    for (int i = 0; i < 28; ++i) a.in[i] = d_in[i];
    a.out = (float*)d_out; a.ws = (unsigned char*)d_ws;
    constexpr int NPH = MK_LAST_PHASE;
    if (MK_N_LAUNCHES == 1) { a.ph_lo = 0; a.ph_hi = NPH; hipLaunchKernelGGL(mega_fwd, dim3(grid), dim3(512), LDS_BYTES, stream, a); }
    else { for (int p = 0; p < NPH; ++p) { const int reps = (p == PROBE_PHASE) ? PROBE_REP : 1;
            for (int r = 0; r < reps; ++r) { if (r > 0 && p == 8) (void)hipMemsetAsync((char*)d_ws + WS_CTL, 0, CTL_ZERO_BYTES, stream);
                a.ph_lo = p; a.ph_hi = p + 1; hipLaunchKernelGGL(mega_fwd, dim3(grid), dim3(512), LDS_BYTES, stream, a); } } }
}
```

```cpp
#include <hip/hip_runtime.h>
#include <cstdio>
#include <cstdint>

#ifndef MK_N_LAUNCHES
#define MK_N_LAUNCHES 1
#endif
#ifndef PROBE_PHASE
#define PROBE_PHASE -1
#endif
#ifndef PROBE_REP
#define PROBE_REP 3
#endif
#ifndef MK_LAST_PHASE
#define MK_LAST_PHASE 12
#endif

#define LAS __attribute__((address_space(3)))
#define GAS __attribute__((address_space(1)))
typedef unsigned short bf16;
typedef short bf16x8 __attribute__((ext_vector_type(8)));
typedef float f32x4 __attribute__((ext_vector_type(4)));
typedef float f32x16 __attribute__((ext_vector_type(16)));
typedef unsigned u32x4 __attribute__((ext_vector_type(4)));
typedef unsigned u32x2 __attribute__((ext_vector_type(2)));
typedef float f32x2 __attribute__((ext_vector_type(2)));
typedef int v4i __attribute__((ext_vector_type(4)));
typedef int v8i __attribute__((ext_vector_type(8)));

constexpr int NB = 8, SEQ = 4096, DM = 1024, T = NB * SEQ;
constexpr int DLRU = 512, NHEAD = 8, QKH = 96, VH = 64, QLORA = 256, KVLORA = 128, DIN = 1440, DINP = 1536;
constexpr int NEXP = 32, TOPK = 4, DFF = 1024;
constexpr float EPS = 1e-6f;
constexpr int ACT_ROWS = T * TOPK + NEXP * 256;

constexpr size_t MiB = 1u << 20;
constexpr size_t WS_CTL = 0, CTL_ZERO_BYTES = 64 * 1024;
constexpr size_t WS_MOD = 1 * MiB;
constexpr size_t WS_COS = 2 * MiB, WS_SIN = 4 * MiB;
constexpr size_t WS_SSQ = 6 * MiB;
constexpr size_t WS_AGG = 8 * MiB;
constexpr size_t WS_WAX = 10 * MiB;
constexpr size_t WS_LIST = 12 * MiB;
constexpr size_t WS_GATES = 16 * MiB;
constexpr size_t WS_WUQ = 17 * MiB;
constexpr size_t WS_WUKV = 18 * MiB;
constexpr size_t WS_WIN = 20 * MiB;
constexpr size_t WS_WOUT = 24 * MiB;
constexpr size_t WS_WR = 26 * MiB;
constexpr size_t WS_LOGIT = 28 * MiB;
constexpr size_t WS_W2 = 32 * MiB;
constexpr size_t WS_W1 = 96 * MiB;
constexpr size_t WS_H = 224 * MiB;
constexpr size_t WS_Z = 288 * MiB;
constexpr size_t WS_Q = 384 * MiB;
constexpr size_t WS_K = 432 * MiB;
constexpr size_t WS_V = 480 * MiB;
constexpr size_t WS_ACT = 224 * MiB;
constexpr size_t WS_MIX = 512 * MiB;
constexpr size_t WS_H2 = 576 * MiB;
constexpr size_t WS_Y4 = 640 * MiB;
constexpr size_t WS_H2B = 768 * MiB;
constexpr size_t WS_X1B = 832 * MiB;
constexpr size_t WS_END = 896 * MiB;
static_assert(WS_ACT + (size_t)ACT_ROWS * 1024 * 2 <= WS_MIX, "act overlay");
constexpr int CW_BAR = 1024;
constexpr int CW_CNT = 8192;

constexpr int RING_BYTES = 131072;
constexpr int LDSCTL_OFF = RING_BYTES;
constexpr int MISC_OFF = LDSCTL_OFF + 64;
constexpr int TAB_OFF = LDSCTL_OFF + 256;
constexpr int ROWTAB_OFF = LDSCTL_OFF + 1024;
constexpr int BIASTAB_OFF = LDSCTL_OFF + 5120;
constexpr int LDS_BYTES = 147456;

#define RLX_AGENT __ATOMIC_RELAXED, __HIP_MEMORY_SCOPE_AGENT
#define LDS_WAIT() asm volatile("s_waitcnt lgkmcnt(0)" ::: "memory")
typedef __bf16 bf16x2_t __attribute__((ext_vector_type(2)));
__device__ __forceinline__ unsigned cvt_pk_bf16(float lo, float hi) { const f32x2 v = {lo, hi}; const bf16x2_t b = __builtin_convertvector(v, bf16x2_t); return __builtin_bit_cast(unsigned, b); }
__device__ __forceinline__ unsigned f2bf(float f) { return cvt_pk_bf16(f, f) & 0xffffu; }
__device__ __forceinline__ unsigned pk2(float lo, float hi) { return cvt_pk_bf16(lo, hi); }
__device__ __forceinline__ float bf2f(unsigned short v) { return __builtin_bit_cast(float, (unsigned)v << 16); }
__device__ __forceinline__ float bflo(unsigned w) { return __builtin_bit_cast(float, w << 16); }
__device__ __forceinline__ float bfhi(unsigned w) { return __builtin_bit_cast(float, w & 0xffff0000u); }
__device__ __forceinline__ float clamp448(float v) { return __builtin_amdgcn_fmed3f(v, -448.0f, 448.0f); }
__device__ __forceinline__ unsigned pk4_fp8(float a, float b, float c, float d) { int w = 0; w = __builtin_amdgcn_cvt_pk_fp8_f32(clamp448(a), clamp448(b), w, false); w = __builtin_amdgcn_cvt_pk_fp8_f32(clamp448(c), clamp448(d), w, true); return (unsigned)w; }
__device__ __forceinline__ float fast_exp(float v) { return __builtin_amdgcn_exp2f(v * 1.4426950408889634f); }
__device__ __forceinline__ float sigmoidf_(float v) { return __builtin_amdgcn_rcpf(1.0f + fast_exp(-v)); }
__device__ __forceinline__ float wave_sum(float v) {
#pragma unroll
    for (int o = 1; o < 64; o <<= 1) v += __shfl_xor(v, o);
    return v;
}
__device__ __forceinline__ float wave_max(float v) {
#pragma unroll
    for (int o = 1; o < 64; o <<= 1) v = fmaxf(v, __shfl_xor(v, o));
    return v;
}
__device__ __forceinline__ int wave_min_i(int v) {
#pragma unroll
    for (int o = 1; o < 64; o <<= 1) { int t = __shfl_xor(v, o); v = t < v ? t : v; }
    return v;
}
__device__ __forceinline__ int lane_id() { int l; asm volatile("v_mbcnt_lo_u32_b32 %0, -1, 0\n\tv_mbcnt_hi_u32_b32 %0, -1, %0" : "=v"(l)); __builtin_assume(l >= 0 && l < 64); return l; }
__device__ __forceinline__ int crow(int r, int hi) { return (r & 3) + 8 * (r >> 2) + 4 * hi; }

#ifndef MOE_DUPK
#define MOE_DUPK 0
#endif
#ifndef MOE_DUPE
#define MOE_DUPE 0
#endif
namespace pg8 {
constexpr int BM = 256, BK = 64, HALF = 128, HTB = HALF * BK * 2, STAGE_BYTES = 8 * HTB, NXCD = 8, WGM = 8;
template <int SW> __device__ __forceinline__ int lds_byte(int r, int kb) { const int st = (r >> 4) * 2 + (kb >> 6), rr = r & 15, ob = rr * 64 + (kb & 63); return st * 1024 + (ob ^ (((ob >> 9) & 1) << SW)); }
template <int SW> __device__ __forceinline__ void stage_rc(int b, int& R, int& CB) { const int st = b / 1024, sb = b % 1024, swz = sb ^ (((sb >> 9) & 1) << SW); R = (st >> 1) * 16 + swz / 64; CB = (st & 1) * 64 + (swz % 64); }
__device__ __forceinline__ int perm32(int rho) { const int n = rho >> 4, i = rho & 15; return 8 * (i >> 2) + 4 * n + (i & 3); }

struct Unit { int pm, pn, e, aux, par; };

struct DenseSched {
    static constexpr bool VAROFF = false, VAROFF_OR_MOE = false, HAS_PREFETCH = false;
    const GAS bf16* A; const GAS bf16* Bt; int lda, K, nM, nN, nwg, G, c;
    __device__ __forceinline__ void init(const GAS bf16* A_, int lda_, const GAS bf16* Bt_, int K_, int M, int N, int G_, int c_) { A = A_; lda = lda_; Bt = Bt_; K = K_; nM = M / BM; nN = N / BM; nwg = nM * nN; G = G_; c = c_; }
    __device__ __forceinline__ bool next(int i, Unit& u) const {
        const long L = (long)i * G + c; if (L >= nwg) return false;
        int wgid = (int)L; { const int q = nwg / NXCD, r = nwg % NXCD, xcd = wgid % NXCD, off = wgid / NXCD; wgid = (xcd < r ? xcd * (q + 1) : r * (q + 1) + (xcd - r) * q) + off; }
        const int nig = WGM * nN, gid = wgid / nig, fm = gid * WGM, gsz = (nM - fm) < WGM ? (nM - fm) : WGM;
        u.pm = fm + ((wgid % nig) % gsz); u.pn = (wgid % nig) / gsz; u.e = 0; u.aux = 0; u.par = 0; return true;
    }
    __device__ __forceinline__ const GAS char* baseA(const Unit& u) const { return (const GAS char*)(A + (size_t)u.pm * BM * lda); }
    __device__ __forceinline__ const GAS char* baseB(const Unit& u) const { return (const GAS char*)(Bt + (size_t)u.pn * BM * K); }
    __device__ __forceinline__ void offsA(const Unit&, const int (&R)[2], const int (&CB)[2], unsigned (&vo)[2][2]) const {
#pragma unroll
        for (int h = 0; h < 2; ++h)
#pragma unroll
            for (int i = 0; i < 2; ++i) vo[h][i] = (unsigned)((h * HALF + R[i]) * lda * 2 + CB[i]);
    }
};

template <int NN, bool GATHER> struct MoeSched {
    const LAS int* tab; const GAS int* list; const GAS unsigned char* A; const GAS unsigned char* Bt; int G, v; size_t bstride;
    static constexpr int PMT = 32 / NN; static constexpr bool VAROFF = GATHER, VAROFF_OR_MOE = true, HAS_PREFETCH = true;
    const GAS float* gates; LAS unsigned* rowtab; const GAS float* bias; LAS float* biastab;
    __device__ __forceinline__ void prefetch(const Unit& u, int tid) const {
        if (tid < 256) {
            const int bcol = GATHER ? ((tid < 128) ? (u.pn * 128 + tid) : (1024 + u.pn * 128 + tid - 128)) : (u.pn * BM + tid);
            biastab[u.par * 256 + tid] = bias[(size_t)u.e * (GATHER ? 2048 : 1024) + bcol];
            if constexpr (!GATHER) { const int cnt = tab[33 + u.e]; const int pos = u.aux * BM + tid; const int pc = pos < cnt ? pos : cnt - 1; const int ent = list[(size_t)u.e * T + pc]; const float g = 16.0f * gates[ent];
                LAS unsigned* p = rowtab + (u.par * 256 + tid) * 2; p[0] = (unsigned)ent; p[1] = __builtin_bit_cast(unsigned, g); } } }
    __device__ __forceinline__ bool next(int i0, Unit& u) const {
        const int i = MOE_DUPK ? (i0 >> 1) : i0;
        const int L = i * G + v, gq = L >> 5, w = L & 31, gmt = gq * PMT + (w % PMT), Mt = tab[32];
        if (gmt >= Mt) return false;
        int e = 0;
        for (int j = 1; j < 32; ++j) e += (tab[j] <= gmt) ? 1 : 0;
        u.pm = gmt; u.pn = w / PMT; u.e = e; u.aux = gmt - tab[e]; u.par = i0 & 1; return true;
    }
    __device__ __forceinline__ const GAS char* baseA(const Unit& u) const { return GATHER ? (const GAS char*)A : (const GAS char*)(A + (size_t)u.pm * BM * 1024); }
    __device__ __forceinline__ const GAS char* baseB(const Unit& u) const { return (const GAS char*)(Bt + (size_t)u.e * bstride + (size_t)u.pn * BM * 1024); }
    __device__ __forceinline__ void offsA(const Unit& u, const int (&R)[2], const int (&C)[2], unsigned (&vo)[2][2]) const {
        if constexpr (GATHER) {
            const int cnt = tab[33 + u.e];
#pragma unroll
            for (int h = 0; h < 2; ++h)
#pragma unroll
                for (int i = 0; i < 2; ++i) { const int pos = u.aux * BM + h * HALF + R[i]; const int pc = pos < cnt ? pos : cnt - 1;
                    const int tok = list[(size_t)u.e * T + pc] >> 2; vo[h][i] = (unsigned)(tok * 1024 + C[i]); }
        } else {
#pragma unroll
            for (int h = 0; h < 2; ++h)
#pragma unroll
                for (int i = 0; i < 2; ++i) vo[h][i] = (unsigned)((h * HALF + R[i]) * 1024 + C[i]);
        }
    }
};

template <class Epi> struct BRowMap { static constexpr int HALF_ROWS = HALF; __device__ static __forceinline__ int map(int R) { return Epi::PERM ? ((R & ~31) + perm32(R & 31)) : R; } };
template <class Epi> __device__ __forceinline__ constexpr int bhalf_rows() { return BRowMap<Epi>::HALF_ROWS; }
template <class Epi> __device__ __forceinline__ int brow_of(int R) { return BRowMap<Epi>::map(R); }
template <class Epi, class Sched, bool ALIGN_EPI, bool FP8 = false>
__device__ __forceinline__ void gemm_phase(LAS unsigned char* lds, const int KB, const Sched& S, const Epi& E, const int wid) {
    const int lane = lane_id(), tid = wid * 64 + lane, wr = wid >> 2, wc = wid & 3, fr = lane & 15, fq = lane >> 4;
    constexpr int SW = FP8 ? 4 : 5;
    int nt = KB / 128; asm volatile("" : "+s"(nt));
    unsigned voffB[2];
#define PG8_RC() int Rp[2], Cp[2]; _Pragma("unroll") for (int i = 0; i < 2; ++i) { int t_ = tid; asm volatile("" : "+v"(t_)); stage_rc<SW>(t_ * 16 + i * 8192, Rp[i], Cp[i]); }
    { PG8_RC();
#pragma unroll
      for (int i = 0; i < 2; ++i) { const int Rb = brow_of<Epi>(Rp[i]); voffB[i] = (unsigned)(Rb * KB + Cp[i]); } }
    const size_t kstep = (size_t)128;
    const size_t hstepB = (size_t)bhalf_rows<Epi>() * KB;
    const unsigned ldsw = (unsigned)wid * 1024u;
    int aoffk[2], boffk[2];
#pragma unroll
    for (int k = 0; k < 2; ++k) { const int kb = FP8 ? (32 * fq + 16 * k) : (16 * fq + 64 * k); aoffk[k] = lds_byte<SW>(wr * 64 + fr, kb); boffk[k] = lds_byte<SW>(wc * 32 + fr, kb); }
#define PG8_SA(b, h) (((b) * 2 + (h)) * HTB)
#define PG8_SB(b, h) ((4 + (b) * 2 + (h)) * HTB)
#define PG8_STAGE(bufoff, gbase, voff) do { _Pragma("unroll") for (int _i = 0; _i < 2; ++_i) \
        __builtin_amdgcn_global_load_lds((const GAS unsigned*)((gbase) + (voff)[_i]), (LAS unsigned*)(lds + (bufoff) + ldsw + _i * 8192), 16, 0, 0); } while (0)
#define PG8_LD16(off) (*(const LAS v4i*)(lds + (off)))
#define PG8_LDA(dst, b, h) do { _Pragma("unroll") for (int m = 0; m < 4; ++m) { if constexpr (FP8) dst##8[m] = __builtin_shufflevector(PG8_LD16(PG8_SA(b, h) + aoffk[0] + m * 2048), PG8_LD16(PG8_SA(b, h) + aoffk[1] + m * 2048), 0, 1, 2, 3, 4, 5, 6, 7); \
        else { _Pragma("unroll") for (int k = 0; k < 2; ++k) dst[m][k] = *(const LAS bf16x8*)(lds + PG8_SA(b, h) + aoffk[k] + m * 2048); } } } while (0)
#define PG8_LDB(dst, b, h) do { _Pragma("unroll") for (int n = 0; n < 2; ++n) { if constexpr (FP8) dst##8[n] = __builtin_shufflevector(PG8_LD16(PG8_SB(b, h) + boffk[0] + n * 2048), PG8_LD16(PG8_SB(b, h) + boffk[1] + n * 2048), 0, 1, 2, 3, 4, 5, 6, 7); \
        else { _Pragma("unroll") for (int k = 0; k < 2; ++k) dst[n][k] = *(const LAS bf16x8*)(lds + PG8_SB(b, h) + boffk[k] + n * 2048); } } } while (0)
#define PG8_MMA(ai, bj, At, Bt) do { __builtin_amdgcn_s_setprio(1); \
        if constexpr (FP8) { _Pragma("unroll") for (int m = 0; m < 4; ++m) _Pragma("unroll") for (int n = 0; n < 2; ++n) \
            asm volatile("v_mfma_f32_16x16x128_f8f6f4 %0, %1, %2, %0" : "+v"(acc[ai][bj][m][n]) : "v"(Bt##8[n]), "v"(At##8[m])); } \
        else { _Pragma("unroll") for (int m = 0; m < 4; ++m) _Pragma("unroll") for (int n = 0; n < 2; ++n) _Pragma("unroll") for (int k = 0; k < 2; ++k) \
            acc[ai][bj][m][n] = __builtin_amdgcn_mfma_f32_16x16x32_bf16(Bt[n][k], At[m][k], acc[ai][bj][m][n], 0, 0, 0); } \
        __builtin_amdgcn_s_setprio(0); } while (0)
#define PG8_WAIT_V(n) asm volatile("s_waitcnt vmcnt(" #n ")" ::: "memory")
#define PG8_WAIT_L(n) asm volatile("s_waitcnt lgkmcnt(" #n ")" ::: "memory")
#define PG8_BAR __builtin_amdgcn_s_barrier()
#define PG8_SCHED __builtin_amdgcn_sched_barrier(0)
    Unit cur, nxt; int ui = 0;
    if (!S.next(0, cur)) return;
    f32x4 acc[2][2][4][2];
#pragma unroll
    for (int a = 0; a < 2; ++a)
#pragma unroll
        for (int b = 0; b < 2; ++b)
#pragma unroll
            for (int m = 0; m < 4; ++m)
#pragma unroll
                for (int n = 0; n < 2; ++n) acc[a][b][m][n] = (f32x4){0.f, 0.f, 0.f, 0.f};
    bf16x8 At[4][2], B0[2][2], B1[2][2]; v8i At8[4], B08[2], B18[2];
    unsigned voA[2][2], vnA[2][2];
    { PG8_RC(); S.offsA(cur, Rp, Cp, voA); }
    if constexpr (Sched::HAS_PREFETCH) S.prefetch(cur, tid);
    const GAS char* cA = S.baseA(cur); const GAS char* cB = S.baseB(cur);
    PG8_STAGE(PG8_SB(0, 0), cB, voffB); PG8_STAGE(PG8_SB(0, 1), cB + hstepB, voffB); PG8_STAGE(PG8_SA(0, 0), cA, voA[0]); PG8_STAGE(PG8_SA(0, 1), cA, voA[1]);
    if (wr == 1) PG8_BAR;
    PG8_WAIT_V(2); PG8_BAR;
    PG8_STAGE(PG8_SB(1, 0), cB + kstep, voffB); PG8_STAGE(PG8_SA(1, 0), cA + kstep, voA[0]); PG8_STAGE(PG8_SB(1, 1), cB + hstepB + kstep, voffB);
    PG8_WAIT_V(6); PG8_BAR;
    for (;;) {
        const bool has_next = S.next(ui + 1, nxt);
        const GAS char* nA = has_next ? S.baseA(nxt) : cA; const GAS char* nB = has_next ? S.baseB(nxt) : cB;
        if constexpr (Sched::VAROFF) { if (has_next) { PG8_RC(); S.offsA(nxt, Rp, Cp, vnA); } }
        if (!Sched::VAROFF || !has_next) {
#pragma unroll
            for (int h = 0; h < 2; ++h)
#pragma unroll
                for (int i = 0; i < 2; ++i) vnA[h][i] = voA[h][i];
        }
#pragma unroll 1
        for (int t = 0; t < nt; t += 2) {
            const bool last = (t == nt - 2);
            asm volatile("" : "+v"(voffB[0]), "+v"(voffB[1]), "+v"(voA[0][0]), "+v"(voA[0][1]), "+v"(voA[1][0]), "+v"(voA[1][1]));
            const GAS char* a1 = cA + (size_t)(t + 1) * kstep;
            const GAS char* a2 = last ? nA : cA + (size_t)(t + 2) * kstep; const GAS char* b2 = last ? nB : cB + (size_t)(t + 2) * kstep;
            const GAS char* a3 = a2 + kstep; const GAS char* b3 = b2 + kstep;
            unsigned o0[2], o1[2];
#pragma unroll
            for (int i = 0; i < 2; ++i) { o0[i] = voA[0][i]; o1[i] = voA[1][i]; }
            if constexpr (Sched::VAROFF) { if (last) {
#pragma unroll
                for (int i = 0; i < 2; ++i) { o0[i] = vnA[0][i]; o1[i] = vnA[1][i]; } } }
            PG8_LDB(B0, 0, 0); PG8_LDB(B1, 0, 1); PG8_SCHED; PG8_LDA(At, 0, 0); PG8_STAGE(PG8_SA(1, 1), a1, voA[1]);
            PG8_WAIT_V(8); PG8_WAIT_L(0); PG8_BAR; PG8_MMA(0, 0, At, B0); PG8_MMA(0, 1, At, B1); PG8_BAR; PG8_SCHED;
            PG8_LDA(At, 0, 1); PG8_STAGE(PG8_SB(0, 0), b2, voffB); PG8_STAGE(PG8_SB(0, 1), b2 + hstepB, voffB); PG8_STAGE(PG8_SA(0, 0), a2, o0);
            PG8_WAIT_V(8); PG8_WAIT_L(0); PG8_BAR; PG8_MMA(1, 0, At, B0); PG8_MMA(1, 1, At, B1); PG8_BAR; PG8_SCHED;
            PG8_LDB(B0, 1, 0); PG8_LDB(B1, 1, 1); PG8_SCHED; PG8_LDA(At, 1, 0); PG8_STAGE(PG8_SA(0, 1), a2, o1);
            PG8_WAIT_V(8); PG8_WAIT_L(0); PG8_BAR; PG8_MMA(0, 0, At, B0); PG8_MMA(0, 1, At, B1); PG8_BAR; PG8_SCHED;
            PG8_LDA(At, 1, 1); PG8_STAGE(PG8_SB(1, 0), b3, voffB); PG8_STAGE(PG8_SB(1, 1), b3 + hstepB, voffB); PG8_STAGE(PG8_SA(1, 0), a3, o0);
            PG8_WAIT_V(8); PG8_WAIT_L(0); PG8_BAR; PG8_MMA(1, 0, At, B0); PG8_MMA(1, 1, At, B1); PG8_BAR; PG8_SCHED;
        }
        if constexpr (ALIGN_EPI) { if (wr == 0) PG8_BAR; }
        if constexpr (FP8) asm volatile("s_nop 15\n\ts_nop 7" ::: "memory");
        if (!(MOE_DUPK && Sched::VAROFF_OR_MOE && !(ui & 1))) E(acc, cur, wr, wc, fr, fq);
        if (MOE_DUPE && Sched::VAROFF_OR_MOE) { asm volatile("" ::: "memory"); E(acc, cur, wr, wc, fr, fq); }
        if (!has_next) break;
#pragma unroll
        for (int a = 0; a < 2; ++a)
#pragma unroll
            for (int b = 0; b < 2; ++b)
#pragma unroll
                for (int m = 0; m < 4; ++m)
#pragma unroll
                    for (int n = 0; n < 2; ++n) acc[a][b][m][n] = (f32x4){0.f, 0.f, 0.f, 0.f};
        cur = nxt; cA = nA; cB = nB; ++ui;
        if constexpr (Sched::HAS_PREFETCH) S.prefetch(cur, wid * 64 + lane_id());
#pragma unroll
        for (int h = 0; h < 2; ++h)
#pragma unroll
            for (int i = 0; i < 2; ++i) voA[h][i] = vnA[h][i];
        if constexpr (ALIGN_EPI) { if (wr == 1) PG8_BAR; }
    }
    PG8_WAIT_V(0);
    if constexpr (!ALIGN_EPI) { if (wr == 0) PG8_BAR; }
    PG8_BAR;
#undef PG8_SA
#undef PG8_SB
#undef PG8_STAGE
#undef PG8_LDA
#undef PG8_LDB
#undef PG8_MMA
#undef PG8_LD16
#undef PG8_RC
#undef PG8_WAIT_V
#undef PG8_WAIT_L
#undef PG8_BAR
#undef PG8_SCHED
}

typedef const f32x4 (&AccRef)[2][2][4][2];

struct EpiZ {
    static constexpr bool PERM = true;
    GAS bf16* Z; GAS float* ssq;
    __device__ __forceinline__ void operator()(AccRef acc, const Unit& u, int wr, int wc, int fr, int fq) const {
        const int row0 = u.pm * BM + wr * 64 + fr, col0 = u.pn * BM + wc * 32 + 8 * fq;
#pragma unroll
        for (int ai = 0; ai < 2; ++ai)
#pragma unroll
            for (int m = 0; m < 4; ++m) { const int row = row0 + ai * HALF + m * 16; GAS bf16* rowp = Z + (size_t)row * DINP + col0;
                float s0 = 0.f, s1 = 0.f;
#pragma unroll
                for (int bj = 0; bj < 2; ++bj) { const f32x4 v0 = acc[ai][bj][m][0], v1 = acc[ai][bj][m][1];
                    const float s = (v0[0] * v0[0] + v0[1] * v0[1]) + (v0[2] * v0[2] + v0[3] * v0[3]) + (v1[0] * v1[0] + v1[1] * v1[1]) + (v1[2] * v1[2] + v1[3] * v1[3]);
                    if (bj == 0) s0 = s; else s1 = s;
                    u32x4 w; w.x = cvt_pk_bf16(v0[0], v0[1]); w.y = cvt_pk_bf16(v0[2], v0[3]); w.z = cvt_pk_bf16(v1[0], v1[1]); w.w = cvt_pk_bf16(v1[2], v1[3]);
                    *(GAS u32x4*)(rowp + bj * HALF) = w; }
                if (u.pn >= 4) {
                    s0 += __shfl_xor(s0, 16); s0 += __shfl_xor(s0, 32); s1 += __shfl_xor(s1, 16); s1 += __shfl_xor(s1, 32);
                    if (fq == 0) {
                        if (u.pn == 4) ssq[(size_t)row * 12 + wc] = s0 + s1;
                        else { ssq[(size_t)row * 12 + 4 + wc] = s0; if (wc == 0) ssq[(size_t)row * 12 + 8] = s1; }
                    }
                }
            }
    }
};
struct EpiQ {
    static constexpr bool PERM = true;
    GAS bf16* Q; const GAS float* ssq;
    __device__ __forceinline__ void operator()(AccRef acc, const Unit& u, int wr, int wc, int fr, int fq) const {
        const int row0 = u.pm * BM + wr * 64 + fr, col0 = u.pn * BM + wc * 32 + 8 * fq;
#pragma unroll
        for (int ai = 0; ai < 2; ++ai)
#pragma unroll
            for (int m = 0; m < 4; ++m) { const int row = row0 + ai * HALF + m * 16; GAS bf16* rowp = Q + (size_t)row * 768 + col0;
                const f32x4 sp = *(const GAS f32x4*)(ssq + (size_t)row * 12);
                const float rs = __builtin_amdgcn_rsqf(((sp[0] + sp[1]) + (sp[2] + sp[3])) * (1.0f / QLORA) + EPS);
#pragma unroll
                for (int bj = 0; bj < 2; ++bj) { const f32x4 v0 = acc[ai][bj][m][0] * rs, v1 = acc[ai][bj][m][1] * rs;
                    u32x4 w; w.x = cvt_pk_bf16(v0[0], v0[1]); w.y = cvt_pk_bf16(v0[2], v0[3]); w.z = cvt_pk_bf16(v1[0], v1[1]); w.w = cvt_pk_bf16(v1[2], v1[3]);
                    *(GAS u32x4*)(rowp + bj * HALF) = w; }
            }
    }
};
struct EpiKV {
    static constexpr bool PERM = true;
    GAS bf16* Kb; GAS bf16* Vb; const GAS bf16* Z; const GAS float* ssq; const GAS float* gkn; const GAS float* ctab; const GAS float* stab;
    __device__ __forceinline__ void operator()(AccRef acc, const Unit& u, int wr, int wc, int fr, int fq) const {
        const int row0 = u.pm * BM + wr * 64 + fr; const int head = 2 * u.pn + (wc & 1);
        if (wc < 2) {
#pragma unroll
            for (int am = 0; am < 4; ++am) { const int ai = am >> 1, mb = 2 * (am & 1);
                asm volatile("" ::: "memory");
                f32x4 sp[2], cs[2], sn[2]; float ssr[2]; u32x2 r1[2], r2[2];
#pragma unroll
                for (int mm = 0; mm < 2; ++mm) { const int m = mm; const int row = row0 + ai * HALF + (mb + mm) * 16;
                    sp[m] = *(const GAS f32x4*)(ssq + (size_t)row * 12 + 4); ssr[m] = ssq[(size_t)row * 12 + 8];
                    r1[m] = *(const GAS u32x2*)(Z + (size_t)row * DINP + 1408 + 4 * fq); r2[m] = *(const GAS u32x2*)(Z + (size_t)row * DINP + 1424 + 4 * fq);
                    cs[m] = *(const GAS f32x4*)(ctab + (size_t)row * 16 + 4 * fq); sn[m] = *(const GAS f32x4*)(stab + (size_t)row * 16 + 4 * fq); }
                const f32x4 gr1 = *(const GAS f32x4*)(gkn + 64 + 4 * fq), gr2 = *(const GAS f32x4*)(gkn + 80 + 4 * fq);
                f32x4 g0v[2], g1v[2];
#pragma unroll
                for (int bj = 0; bj < 2; ++bj) { g0v[bj] = *(const GAS f32x4*)(gkn + bj * 32 + 8 * fq); g1v[bj] = *(const GAS f32x4*)(gkn + bj * 32 + 8 * fq + 4); }
#pragma unroll
                for (int mm = 0; mm < 2; ++mm) { const int m = mm; const int mi = mb + mm; const int row = row0 + ai * HALF + mi * 16;
                    const float rkv = __builtin_amdgcn_rsqf(((sp[m][0] + sp[m][1]) + (sp[m][2] + sp[m][3])) * (1.0f / KVLORA) + EPS);
                    f32x4 v[2][2]; float s = 0.f;
#pragma unroll
                    for (int bj = 0; bj < 2; ++bj)
#pragma unroll
                        for (int n = 0; n < 2; ++n) { v[bj][n] = acc[ai][bj][mi][n] * rkv; s += (v[bj][n][0] * v[bj][n][0] + v[bj][n][1] * v[bj][n][1]) + (v[bj][n][2] * v[bj][n][2] + v[bj][n][3] * v[bj][n][3]); }
                    s += __shfl_xor(s, 16); s += __shfl_xor(s, 32);
                    const float rk = __builtin_amdgcn_rsqf((s + ssr[m]) * (1.0f / QKH) + EPS);
                    GAS bf16* kp = Kb + (size_t)row * 768 + head * QKH;
#pragma unroll
                    for (int bj = 0; bj < 2; ++bj) { u32x4 w; const f32x4 g0 = g0v[bj] * rk, g1 = g1v[bj] * rk;
                        w.x = cvt_pk_bf16(v[bj][0][0] * g0[0], v[bj][0][1] * g0[1]); w.y = cvt_pk_bf16(v[bj][0][2] * g0[2], v[bj][0][3] * g0[3]);
                        w.z = cvt_pk_bf16(v[bj][1][0] * g1[0], v[bj][1][1] * g1[1]); w.w = cvt_pk_bf16(v[bj][1][2] * g1[2], v[bj][1][3] * g1[3]);
                        *(GAS u32x4*)(kp + bj * 32 + 8 * fq) = w; }
                    float x1[4] = {bflo(r1[m].x), bfhi(r1[m].x), bflo(r1[m].y), bfhi(r1[m].y)}, x2[4] = {bflo(r2[m].x), bfhi(r2[m].x), bflo(r2[m].y), bfhi(r2[m].y)};
                    float o1[4], o2[4];
#pragma unroll
                    for (int j = 0; j < 4; ++j) { const float a = x1[j] * rk * gr1[j], b = x2[j] * rk * gr2[j]; o1[j] = a * cs[m][j] - b * sn[m][j]; o2[j] = b * cs[m][j] + a * sn[m][j]; }
                    u32x2 w1, w2; w1.x = cvt_pk_bf16(o1[0], o1[1]); w1.y = cvt_pk_bf16(o1[2], o1[3]); w2.x = cvt_pk_bf16(o2[0], o2[1]); w2.y = cvt_pk_bf16(o2[2], o2[3]);
                    *(GAS u32x2*)(kp + 64 + 4 * fq) = w1; *(GAS u32x2*)(kp + 80 + 4 * fq) = w2;
                }
            }
        } else {
#pragma unroll
            for (int ai = 0; ai < 2; ++ai)
#pragma unroll
                for (int m = 0; m < 4; ++m) { const int row = row0 + ai * HALF + m * 16;
                    const f32x4 sp = *(const GAS f32x4*)(ssq + (size_t)row * 12 + 4);
                    const float rkv = __builtin_amdgcn_rsqf(((sp[0] + sp[1]) + (sp[2] + sp[3])) * (1.0f / KVLORA) + EPS);
                    GAS bf16* vp = Vb + (size_t)row * 512 + head * VH;
#pragma unroll
                    for (int bj = 0; bj < 2; ++bj) { const f32x4 v0 = acc[ai][bj][m][0] * rkv, v1 = acc[ai][bj][m][1] * rkv;
                        u32x4 w; w.x = cvt_pk_bf16(v0[0], v0[1]); w.y = cvt_pk_bf16(v0[2], v0[3]); w.z = cvt_pk_bf16(v1[0], v1[1]); w.w = cvt_pk_bf16(v1[2], v1[3]);
                        *(GAS u32x4*)(vp + bj * 32 + 8 * fq) = w; }
                }
        }
    }
};
struct EpiX1 {
    static constexpr bool PERM = true;
    const GAS float* x; GAS bf16* x1; const GAS float* gate;
    __device__ __forceinline__ void operator()(AccRef acc, const Unit& u, int wr, int wc, int fr, int fq) const {
        const int row0 = u.pm * BM + wr * 64 + fr, col0 = u.pn * BM + wc * 32 + 8 * fq; const int b = (u.pm * BM) / SEQ;
        f32x4 gv[2][2];
#pragma unroll
        for (int bj = 0; bj < 2; ++bj)
#pragma unroll
            for (int n = 0; n < 2; ++n) gv[bj][n] = *(const GAS f32x4*)(gate + (size_t)b * 6144 + col0 + bj * HALF + n * 4);
#pragma unroll
        for (int ai = 0; ai < 2; ++ai)
#pragma unroll
            for (int m = 0; m < 4; ++m) { const size_t off = (size_t)(row0 + ai * HALF + m * 16) * DM + col0;
#pragma unroll
                for (int bj = 0; bj < 2; ++bj) { const f32x4 x0 = __builtin_nontemporal_load((const GAS f32x4*)(x + off + bj * HALF)), x1v = __builtin_nontemporal_load((const GAS f32x4*)(x + off + bj * HALF + 4));
                    const f32x4 v0 = x0 + gv[bj][0] * acc[ai][bj][m][0], v1 = x1v + gv[bj][1] * acc[ai][bj][m][1];
                    u32x4 w; w.x = cvt_pk_bf16(v0[0], v0[1]); w.y = cvt_pk_bf16(v0[2], v0[3]); w.z = cvt_pk_bf16(v1[0], v1[1]); w.w = cvt_pk_bf16(v1[2], v1[3]);
                    *(GAS u32x4*)(x1 + off + bj * HALF) = w; }
                if (m == 3) asm volatile("" ::: "memory"); }
    }
};
struct EpiAct {
    static constexpr bool PERM = true;
    GAS unsigned char* act; const LAS float* biastab;
    __device__ __forceinline__ void operator()(AccRef acc, const Unit& u, int wr, int wc, int fr, int fq) const {
        const int row0 = u.pm * BM + wr * 64 + fr, col0 = u.pn * 128 + wc * 32 + 8 * fq;
        const LAS float* bp = biastab + u.par * 256 + wc * 32 + 8 * fq;
        f32x2 bg[4], bu[4];
#pragma unroll
        for (int q = 0; q < 4; ++q) { bg[q] = *(const LAS f32x2*)(bp + 2 * q); bu[q] = *(const LAS f32x2*)(bp + 128 + 2 * q); }
#pragma unroll
        for (int ai = 0; ai < 2; ++ai)
#pragma unroll
            for (int m = 0; m < 4; ++m) { GAS unsigned char* rowp = act + (size_t)(row0 + ai * HALF + m * 16) * DFF + col0;
                f32x2 o[4];
#pragma unroll
                for (int q = 0; q < 4; ++q) { const int n = q >> 1, j = 2 * (q & 1);
                    const f32x2 ga = {acc[ai][0][m][n][j], acc[ai][0][m][n][j + 1]}, ua = {acc[ai][1][m][n][j], acc[ai][1][m][n][j + 1]};
                    f32x2 gl = ga * 0.015625f + bg[q], li = ua * 0.015625f + bu[q];
                    gl.x = fminf(gl.x, 7.0f); gl.y = fminf(gl.y, 7.0f);
                    li.x = __builtin_amdgcn_fmed3f(li.x, -7.0f, 7.0f); li.y = __builtin_amdgcn_fmed3f(li.y, -7.0f, 7.0f);
                    const f32x2 ea = gl * (-1.702f * 1.4426950408889634f);
                    f32x2 den; den.x = __builtin_amdgcn_exp2f(ea.x); den.y = __builtin_amdgcn_exp2f(ea.y); den = den + 1.0f;
                    f32x2 sg; sg.x = __builtin_amdgcn_rcpf(den.x); sg.y = __builtin_amdgcn_rcpf(den.y);
                    o[q] = (li * 4.0f + 4.0f) * (gl * sg); }
                u32x2 w;
                { int t0 = 0; t0 = __builtin_amdgcn_cvt_pk_fp8_f32(o[0].x, o[0].y, t0, false); t0 = __builtin_amdgcn_cvt_pk_fp8_f32(o[1].x, o[1].y, t0, true); w.x = (unsigned)t0; }
                { int t1 = 0; t1 = __builtin_amdgcn_cvt_pk_fp8_f32(o[2].x, o[2].y, t1, false); t1 = __builtin_amdgcn_cvt_pk_fp8_f32(o[3].x, o[3].y, t1, true); w.y = (unsigned)t1; }
                *(GAS u32x2*)rowp = w; }
    }
};
struct EpiY {
    static constexpr bool PERM = true;
    GAS unsigned char* y4; const LAS float* biastab; const LAS unsigned* rowtab; const LAS int* tab;
    __device__ __forceinline__ void operator()(AccRef acc, const Unit& u, int wr, int wc, int fr, int fq) const {
        const int r0 = wr * 64 + fr, col0 = u.pn * BM + wc * 64 + 16 * fq; const int cnt = tab[33 + u.e];
        f32x4 bv[2][2];
#pragma unroll
        for (int bj = 0; bj < 2; ++bj)
#pragma unroll
            for (int n = 0; n < 2; ++n) bv[bj][n] = *(const LAS f32x4*)(biastab + u.par * 256 + wc * 64 + 16 * fq + 8 * bj + 4 * n);
        int ent[8]; float gg[8];
#pragma unroll
        for (int q = 0; q < 8; ++q) { const LAS unsigned* p = rowtab + (u.par * 256 + r0 + (q >> 2) * HALF + (q & 3) * 16) * 2; ent[q] = (int)p[0]; gg[q] = __builtin_bit_cast(float, p[1]); }
#pragma unroll
        for (int ai = 0; ai < 2; ++ai)
#pragma unroll
            for (int m = 0; m < 4; ++m) { const int pos = u.aux * BM + r0 + ai * HALF + m * 16;
                if (pos < cnt) { const float g = gg[ai * 4 + m]; GAS unsigned char* rowp = y4 + (size_t)ent[ai * 4 + m] * DM + col0;
                    u32x4 w;
#pragma unroll
                    for (int bj = 0; bj < 2; ++bj) { const f32x4 v0 = (acc[ai][bj][m][0] * 0.00390625f + bv[bj][0]) * g, v1 = (acc[ai][bj][m][1] * 0.00390625f + bv[bj][1]) * g;
                        w[2 * bj] = pk4_fp8(v0[0], v0[1], v0[2], v0[3]); w[2 * bj + 1] = pk4_fp8(v1[0], v1[1], v1[2], v1[3]); }
                    *(GAS u32x4*)rowp = w; } }
    }
};
template <> struct BRowMap<EpiY> { static constexpr int HALF_ROWS = 8; __device__ static __forceinline__ int map(int R) { const int wc = R >> 5, i = perm32(R & 31); return 64 * wc + 16 * (i >> 3) + (i & 7); } };
struct EpiLogit {
    static constexpr bool PERM = false;
    GAS float* logit; const GAS float* br;
    __device__ __forceinline__ void operator()(AccRef acc, const Unit& u, int wr, int wc, int fr, int fq) const {
        if (wc != 0) return;
        const int row0 = u.pm * BM + wr * 64 + fr;
        const f32x4 b0 = *(const GAS f32x4*)(br + 4 * fq), b1 = *(const GAS f32x4*)(br + 16 + 4 * fq);
#pragma unroll
        for (int ai = 0; ai < 2; ++ai)
#pragma unroll
            for (int m = 0; m < 4; ++m) { GAS float* rp = logit + (size_t)(row0 + ai * HALF + m * 16) * NEXP + 4 * fq;
                *(GAS f32x4*)rp = acc[ai][0][m][0] + b0; *(GAS f32x4*)(rp + 16) = acc[ai][0][m][1] + b1; }
    }
};
}

#define XB_TMO      128
#define XB_XCNT(j)  (256  + 64 * (j))
#define XB_XSUB(j)  (1280 + 64 * (j))
#define XB_XGEN(j)  (2304 + 64 * (j))
#define XB_TOP      3328
#define XB_TOPGEN   3392
#define XCD_BAR_WORDS 3456
#define XB_SPIN_CAP (1u << 18)
__device__ __forceinline__ unsigned xb_ld(unsigned* p)              { return __hip_atomic_load(p, __ATOMIC_RELAXED, __HIP_MEMORY_SCOPE_AGENT); }
__device__ __forceinline__ unsigned xb_add(unsigned* p, unsigned v) { return __hip_atomic_fetch_add(p, v, __ATOMIC_RELAXED, __HIP_MEMORY_SCOPE_AGENT); }
__device__ __forceinline__ unsigned xb_xcc_id() { return (unsigned)__builtin_amdgcn_s_getreg((3 << 11) | 20) & 0xFu; }
#define XB_SPIN(cond, bar) do { unsigned _sp = 0; while (cond) { __builtin_amdgcn_s_sleep(1); \
    if ((++_sp & 255u) == 0u) { if (xb_ld(&(bar)[XB_TMO])) break; if (_sp > XB_SPIN_CAP) { atomicAdd(&(bar)[XB_TMO], 1u); break; } } } } while (0)
struct XcdBarrier { unsigned* bar; unsigned x; volatile LAS unsigned* st; };
__device__ __forceinline__ XcdBarrier xcd_barrier_post(unsigned* bar, volatile LAS unsigned* st, bool leader) {
    XcdBarrier b; b.bar = bar; b.x = xb_xcc_id(); b.st = st;
    if (leader) (void)xb_add(&bar[XB_XCNT(b.x)], 1u);
    return b;
}
__device__ __forceinline__ void xcd_barrier_complete(unsigned* bar, unsigned x, unsigned& nloc, unsigned& nx) {
    const unsigned G = gridDim.x * gridDim.y * gridDim.z;
    unsigned sum, cnt, mine, sp = 0u;
    for (;;) {
        sum = 0u; cnt = 0u; mine = 0u;
#pragma unroll
        for (unsigned j = 0; j < 16; ++j) { const unsigned c = xb_ld(&bar[XB_XCNT(j)]); sum += c; cnt += (c > 0u) ? 1u : 0u; mine = (j == x) ? c : mine; }
        if (sum == G) break;
        __builtin_amdgcn_s_sleep(1);
        if ((++sp & 255u) == 0u) { if (xb_ld(&bar[XB_TMO])) break; if (sp > XB_SPIN_CAP) { atomicAdd(&bar[XB_TMO], 1u); break; } }
    }
    nloc = mine > 0u ? mine : 1u; nx = cnt > 0u ? cnt : 1u;
}
__device__ __forceinline__ void xcd_barrier(const XcdBarrier& b, bool leader) {
    asm volatile("s_waitcnt vmcnt(0)" ::: "memory");
    __syncthreads();
    if (leader) {
        unsigned* bar = b.bar;
        __builtin_amdgcn_s_waitcnt(0);
        unsigned nloc = b.st[0], nx = b.st[1];
        if (nloc == 0u) { xcd_barrier_complete(bar, b.x, nloc, nx); b.st[0] = nloc; b.st[1] = nx; }
        const unsigned old = xb_add(&bar[XB_XSUB(b.x)], 1u);
        const unsigned gen = old / nloc;
        if (old + 1u == (gen + 1u) * nloc) {
            __builtin_amdgcn_fence(__ATOMIC_RELEASE, "agent");
            asm volatile("s_waitcnt vmcnt(0)" ::: "memory");
            const unsigned og = xb_add(&bar[XB_TOP], 1u);
            const unsigned tg = og / nx;
            if (og + 1u == (tg + 1u) * nx) xb_add(&bar[XB_TOPGEN], 1u);
            else XB_SPIN(xb_ld(&bar[XB_TOPGEN]) == tg, bar);
            __builtin_amdgcn_fence(__ATOMIC_ACQUIRE, "agent");
            xb_add(&bar[XB_XGEN(b.x)], 1u);
            asm volatile("s_waitcnt vmcnt(0)" ::: "memory");
        } else {
            XB_SPIN(xb_ld(&bar[XB_XGEN(b.x)]) == gen, bar);
            __builtin_amdgcn_fence(__ATOMIC_ACQUIRE, "agent");
            asm volatile("s_waitcnt vmcnt(0)" ::: "memory");
        }
    }
    __syncthreads();
}

struct Frame {
    LAS unsigned char* lds;
    int tid, lane, wave, vcu, G;
    const float *x, *c; const int* pos; const float *w_ada, *b_ada, *g_mix, *w_in, *conv_w, *conv_b, *w_a, *b_a, *w_x, *b_x, *lam, *g_q_lat, *w_uq, *g_kv_lat, *w_ukv, *g_qn, *g_kn, *w_out, *g_ffn, *w_router, *b_router, *w1, *b1, *w2, *b2;
    float* out; unsigned char* ws; unsigned* ctl;
};
#define WSP(type, off) ((type*)(GAS type*)(F.ws + (off)))
#define WSG(type, off) ((GAS type*)(F.ws + (off)))
#define GG(type, p) ((const GAS type*)(p))

__device__ __forceinline__ void p0_mod_rope(Frame& F) {
    LAS float* sc = (LAS float*)F.lds; LAS float* red = (LAS float*)(F.lds + 32768);
    for (int i = F.tid; i < NB * DM; i += 512) { const float v = F.c[i]; sc[i] = v * sigmoidf_(v); }
    __syncthreads();
    float* mod = WSP(float, WS_MOD);
    for (int u = blockIdx.x; u < 192; u += F.G) {
        const int n = u * 32 + (F.lane & 31), k0 = F.wave * 128 + (F.lane >> 5) * 64;
        float acc[8];
#pragma unroll
        for (int b = 0; b < 8; ++b) acc[b] = 0.f;
#pragma unroll 16
        for (int kk = 0; kk < 64; ++kk) { const int k = k0 + kk; const float w = __builtin_nontemporal_load((const GAS float*)F.w_ada + (size_t)k * 6144 + n);
#pragma unroll
            for (int b = 0; b < 8; ++b) acc[b] += sc[b * DM + k] * w; }
#pragma unroll
        for (int b = 0; b < 8; ++b) acc[b] += __shfl_xor(acc[b], 32);
        if (F.lane < 32) {
#pragma unroll
            for (int b = 0; b < 8; ++b) red[(F.wave * 8 + b) * 32 + F.lane] = acc[b]; }
        __syncthreads();
        if (F.tid < 256) { const int b = F.tid >> 5, j = F.tid & 31; float s = 0.f;
#pragma unroll
            for (int w = 0; w < 8; ++w) s += red[(w * 8 + b) * 32 + j];
            mod[b * 6144 + u * 32 + j] = s + F.b_ada[u * 32 + j]; }
        __syncthreads();
    }
    float* ct = WSP(float, WS_COS); float* st = WSP(float, WS_SIN);
    for (int idx = blockIdx.x * 512 + F.tid; idx < T * 16; idx += F.G * 512) {
        const int t = idx >> 4, i = idx & 15; const float freq = exp2f(-(float)i * (13.287712379549449f / 16.0f));
        const float ang = (float)F.pos[t] * freq; double rev = (double)ang * 0.15915494309189535; rev -= floor(rev); const float rv = (float)rev;
        ct[idx] = __builtin_amdgcn_cosf(rv); st[idx] = __builtin_amdgcn_sinf(rv);
    }
}

__device__ __forceinline__ void transpose_item(const float* W, int ldw, int Ks, int scol0, const float* g, bf16* WT, int Kd, int n0, int k0, LAS float* scr, int lane, float cs = 1.0f) {
#pragma unroll 8
    for (int i = 0; i < 32; ++i) { const int kk = 2 * i + (lane >> 5), k = k0 + kk; float v = 0.f;
        if (scol0 >= 0 && k < Ks) { v = W[(size_t)k * ldw + scol0 + (lane & 31)] * cs; if (g) v *= g[k]; }
        scr[kk * 33 + (lane & 31)] = v; }
    LDS_WAIT(); asm volatile("" ::: "memory");
    const int c = lane & 7;
#pragma unroll
    for (int j = 0; j < 4; ++j) { const int n = (lane >> 3) + 8 * j; const LAS float* s = scr + (8 * c) * 33 + n;
        u32x4 o; o.x = pk2(s[0 * 33], s[1 * 33]); o.y = pk2(s[2 * 33], s[3 * 33]); o.z = pk2(s[4 * 33], s[5 * 33]); o.w = pk2(s[6 * 33], s[7 * 33]);
        *(u32x4*)(WT + (size_t)(n0 + n) * Kd + k0 + 8 * c) = o; }
    LDS_WAIT(); asm volatile("" ::: "memory");
}
__device__ __forceinline__ void transpose_item_fp8(const float* W, int ldw, int scol0, unsigned char* WT, int Kd, int n0, int k0, LAS float* scr, int lane) {
    const GAS float* Wg = (const GAS float*)W;
    f32x4 v[8];
#pragma unroll
    for (int i = 0; i < 8; ++i) v[i] = __builtin_nontemporal_load((const GAS f32x4*)(Wg + (size_t)(k0 + 8 * i + (lane >> 3)) * ldw + scol0 + 4 * (lane & 7)));
#pragma unroll
    for (int i = 0; i < 8; ++i) { LAS float* d = scr + (8 * i + (lane >> 3)) * 33 + 4 * (lane & 7); d[0] = v[i][0] * 64.0f; d[1] = v[i][1] * 64.0f; d[2] = v[i][2] * 64.0f; d[3] = v[i][3] * 64.0f; }
    LDS_WAIT(); asm volatile("" ::: "memory");
    const int c = lane & 3;
#pragma unroll
    for (int j = 0; j < 2; ++j) { const int n = (lane >> 2) + 16 * j; const LAS float* s = scr + (16 * c) * 33 + n;
        u32x4 o; o.x = pk4_fp8(s[0 * 33], s[1 * 33], s[2 * 33], s[3 * 33]); o.y = pk4_fp8(s[4 * 33], s[5 * 33], s[6 * 33], s[7 * 33]);
        o.z = pk4_fp8(s[8 * 33], s[9 * 33], s[10 * 33], s[11 * 33]); o.w = pk4_fp8(s[12 * 33], s[13 * 33], s[14 * 33], s[15 * 33]);
        __builtin_nontemporal_store(o, (GAS u32x4*)(WT + (size_t)(n0 + n) * Kd + k0 + 16 * c)); }
    LDS_WAIT(); asm volatile("" ::: "memory");
}
__device__ __forceinline__ void p1_convert_norm(Frame& F) {
    LAS float* scr = (LAS float*)(F.lds + F.wave * 16384);
    const int gw = F.vcu * 8 + F.wave, NGW = F.G * 8;
    constexpr int I_W1 = NEXP * 16 * 64, I_W2 = NEXP * 16 * 32, I_IN = 16 * 48, I_OUT = 16 * 32, I_UQ = 4 * 24, I_UKV = 4 * 32, I_AX = 32;
    constexpr int I_WR = 16 * 8;
    constexpr int NITEMS = I_W1 + I_W2 + I_IN + I_OUT + I_UQ + I_UKV + I_AX + I_WR;
    for (int it = gw; it < NITEMS; it += NGW) {
        int r = it;
        if (r < I_W1) { const int e = r >> 10, q = r & 1023, kb = q >> 6, ng = q & 63; const int pn = ng >> 3, bj = (ng >> 2) & 1, c32 = ng & 3;
            transpose_item_fp8(F.w1 + (size_t)e * 1024 * 2048, 2048, bj * 1024 + 128 * pn + 32 * c32, WSP(unsigned char, WS_W1) + (size_t)e * 2048 * 1024, 1024, ng * 32, kb * 64, scr, F.lane); continue; } r -= I_W1;
        if (r < I_W2) { const int e = r >> 9, q = r & 511, kb = q >> 5, ng = q & 31;
            transpose_item_fp8(F.w2 + (size_t)e * 1024 * 1024, 1024, ng * 32, WSP(unsigned char, WS_W2) + (size_t)e * 1024 * 1024, 1024, ng * 32, kb * 64, scr, F.lane); continue; } r -= I_W2;
        if (r < I_IN) { const int kb = r / 48, ng = r % 48;
            transpose_item(F.w_in, DIN, 1024, ng < 45 ? ng * 32 : -1, nullptr, WSP(bf16, WS_WIN), 1024, ng * 32, kb * 64, scr, F.lane); continue; } r -= I_IN;
        if (r < I_OUT) { const int kb = r >> 5, ng = r & 31;
            transpose_item(F.w_out, 1024, 1024, ng * 32, nullptr, WSP(bf16, WS_WOUT), 1024, ng * 32, kb * 64, scr, F.lane); continue; } r -= I_OUT;
        if (r < I_UQ) { const int kb = r / 24, ng = r % 24;
            transpose_item(F.w_uq, 768, 256, ng * 32, F.g_q_lat, WSP(bf16, WS_WUQ), 256, ng * 32, kb * 64, scr, F.lane); continue; } r -= I_UQ;
        if (r < I_UKV) { const int kb = r >> 5, ng = r & 31; const int pn = ng >> 3, bj = (ng >> 2) & 1, wc = ng & 3; const int head = 2 * pn + (wc & 1);
            transpose_item(F.w_ukv, 1024, 128, head * 128 + (wc < 2 ? 0 : 64) + 32 * bj, F.g_kv_lat, WSP(bf16, WS_WUKV), 256, ng * 32, kb * 64, scr, F.lane); continue; } r -= I_UKV;
        if (r >= I_AX) { r -= I_AX; const int kb = r >> 3, ng = r & 7;
            transpose_item(F.w_router, NEXP, 1024, ng == 0 ? 0 : -1, nullptr, WSP(bf16, WS_WR), 1024, ng * 32, kb * 64, scr, F.lane); continue; }
        { const int g = r >> 4, n = (r >> 1) & 7, ng = r & 1;
            transpose_item((g ? F.w_x : F.w_a) + (size_t)n * 64 * 64, 64, 64, ng * 32, nullptr, WSP(bf16, WS_WAX) + (size_t)(g * 8 + n) * 64 * 64, 64, ng * 32, 0, scr, F.lane, -1.4426950408889634f); }
    }
    const GAS float* mod = WSG(float, WS_MOD); GAS bf16* H = WSG(bf16, WS_H); const GAS float* X = GG(float, F.x); const GAS float* gm = GG(float, F.g_mix);
    for (int m0 = gw * 2; m0 < T; m0 += NGW * 2) {
        const int b = m0 / SEQ;
        f32x4 v[2][4]; float s[2] = {0.f, 0.f};
#pragma unroll
        for (int r = 0; r < 2; ++r)
#pragma unroll
            for (int j = 0; j < 4; ++j) v[r][j] = __builtin_nontemporal_load((const GAS f32x4*)(X + (size_t)(m0 + r) * DM) + F.lane + 64 * j);
#pragma unroll
        for (int r = 0; r < 2; ++r) {
#pragma unroll
            for (int j = 0; j < 4; ++j) s[r] += (v[r][j][0] * v[r][j][0] + v[r][j][1] * v[r][j][1]) + (v[r][j][2] * v[r][j][2] + v[r][j][3] * v[r][j][3]);
            const float rstd = 1.0f / sqrtf(wave_sum(s[r]) * (1.0f / DM) + EPS);
            GAS u32x2* o8 = (GAS u32x2*)(H + (size_t)(m0 + r) * DM) + F.lane;
#pragma unroll
            for (int j = 0; j < 4; ++j) { const int col = 256 * j + 4 * F.lane;
                const f32x4 g = *(const GAS f32x4*)(gm + col), sh = *(const GAS f32x4*)(mod + (size_t)b * 6144 + col), scl = *(const GAS f32x4*)(mod + (size_t)b * 6144 + 1024 + col);
                const f32x4 o = v[r][j] * rstd * g * (scl + 1.0f) + sh;
                u32x2 w; w.x = pk2(o[0], o[1]); w.y = pk2(o[2], o[3]); o8[64 * j] = w; } }
    }
}

constexpr int LRU_XROW = 144, LRU_WL = 15616;
template <bool PASS2>
__device__ __forceinline__ void lru_pass(Frame& F) {
    const int lane = F.lane, n = F.wave, r32 = lane & 31, hi = lane >> 5;
    LAS unsigned char* wl = F.lds + n * LRU_WL; LAS unsigned char* xs = wl; LAS unsigned char* xcs = wl + 5120; LAS float* cw = (LAS float*)(wl + 5120 + 4608); LAS unsigned char* ys = wl + 5120 + 4608 + 1280;
#pragma unroll
    for (int j = 0; j < 4; ++j) cw[j * 64 + lane] = F.conv_w[j * DLRU + 64 * n + lane];
    cw[256 + lane] = F.conv_b[64 * n + lane];
    const GAS bf16* Wt = WSG(bf16, WS_WAX);
    bf16x8 wfa[2][4], wfx[2][4];
#pragma unroll
    for (int oc = 0; oc < 2; ++oc)
#pragma unroll
        for (int ks = 0; ks < 4; ++ks) { wfa[oc][ks] = *(const GAS bf16x8*)(Wt + ((size_t)((0 * 8 + n) * 64 + 32 * oc + r32) * 64 + 16 * ks + 8 * hi)); wfx[oc][ks] = *(const GAS bf16x8*)(Wt + ((size_t)((1 * 8 + n) * 64 + 32 * oc + r32) * 64 + 16 * ks + 8 * hi)); }
    float ba[2], bx[2], sp8[2];
#pragma unroll
    for (int oc = 0; oc < 2; ++oc) { const int ch = 64 * n + 32 * oc + r32; ba[oc] = -1.4426950408889634f * F.b_a[ch]; bx[oc] = -1.4426950408889634f * F.b_x[ch]; sp8[oc] = -8.0f * 1.4426950408889634f * log1pf(expf(-F.lam[ch])); }
    const GAS bf16* Z = WSG(bf16, WS_Z); GAS float* agg = WSG(float, WS_AGG); GAS bf16* MIX = WSG(bf16, WS_MIX);
    const int gw = F.vcu * 8 + F.wave, NGW = F.G * 8;
    for (int pidx = gw >> 3; pidx < NB * 32; pidx += (NGW >> 3)) {
        const int b = pidx >> 5, ttp = pidx & 31; const size_t rowb = (size_t)b * SEQ;
        float c[2] = {0.f, 0.f};
        if constexpr (PASS2) {
            for (int tp0 = 0; tp0 < 2 * ttp; tp0 += 8) {
                f32x2 ah[8][2];
#pragma unroll
                for (int j = 0; j < 8; ++j) { const int tp = (tp0 + j < 2 * ttp) ? tp0 + j : 2 * ttp - 1;
#pragma unroll
                    for (int oc = 0; oc < 2; ++oc) ah[j][oc] = *(const GAS f32x2*)(agg + ((size_t)((b * 64 + tp) * DLRU) + 64 * n + 32 * oc + r32) * 2); }
#pragma unroll
                for (int j = 0; j < 8; ++j) { const bool ok = tp0 + j < 2 * ttp;
#pragma unroll
                    for (int oc = 0; oc < 2; ++oc) c[oc] = ok ? ah[j][oc].x * c[oc] + ah[j][oc].y : c[oc]; } }
        }
#pragma unroll 1
        for (int u2 = 0; u2 < 2; ++u2) {
            const int tt = 2 * ttp + u2, t0 = tt * 64;
            float aprod[2] = {1.f, 1.f};
            if constexpr (!PASS2) { c[0] = 0.f; c[1] = 0.f; }
#pragma unroll 1
            for (int tt2 = 0; tt2 < 2; ++tt2) {
                const int tb = t0 + 32 * tt2;
#pragma unroll
                for (int i = 0; i < 5; ++i) { const int row = i * 8 + (lane >> 3), ch = lane & 7; const int t = tb - 3 + row;
                    if (row < 35) { u32x4 v = (u32x4){0u, 0u, 0u, 0u}; if (t >= 0) v = *(const GAS u32x4*)(Z + (rowb + t) * DINP + 64 * n + ch * 8);
                        *(LAS u32x4*)(xs + row * LRU_XROW + ch * 16) = v; } }
                if constexpr (PASS2) {
#pragma unroll
                    for (int i = 0; i < 4; ++i) { const int row = i * 8 + (lane >> 3), ch = lane & 7;
                        *(LAS u32x4*)(ys + row * LRU_XROW + ch * 16) = *(const GAS u32x4*)(Z + (rowb + tb + row) * DINP + DLRU + 64 * n + ch * 8); }
                }
                bf16x8 af[4];
#pragma unroll
                for (int ks = 0; ks < 4; ++ks) { const int c0 = 16 * ks + 8 * hi;
                    float xc[8];
                    { const f32x4 b0 = *(const LAS f32x4*)(cw + 256 + c0), b1 = *(const LAS f32x4*)(cw + 256 + c0 + 4);
#pragma unroll
                      for (int q = 0; q < 4; ++q) { xc[q] = b0[q]; xc[4 + q] = b1[q]; } }
#pragma unroll
                    for (int j = 0; j < 4; ++j) { const u32x4 xv = *(const LAS u32x4*)(xs + (r32 + j) * LRU_XROW + c0 * 2);
                        const f32x4 w0 = *(const LAS f32x4*)(cw + j * 64 + c0), w1 = *(const LAS f32x4*)(cw + j * 64 + c0 + 4);
                        xc[0] += w0[0] * bflo(xv.x); xc[1] += w0[1] * bfhi(xv.x); xc[2] += w0[2] * bflo(xv.y); xc[3] += w0[3] * bfhi(xv.y);
                        xc[4] += w1[0] * bflo(xv.z); xc[5] += w1[1] * bfhi(xv.z); xc[6] += w1[2] * bflo(xv.w); xc[7] += w1[3] * bfhi(xv.w); }
                    u32x4 pk; pk.x = pk2(xc[0], xc[1]); pk.y = pk2(xc[2], xc[3]); pk.z = pk2(xc[4], xc[5]); pk.w = pk2(xc[6], xc[7]);
                    af[ks] = __builtin_bit_cast(bf16x8, pk);
                    *(LAS u32x4*)(xcs + r32 * LRU_XROW + c0 * 2) = pk; }
#pragma unroll
                for (int oc = 0; oc < 2; ++oc) {
                    f32x16 da = {}, dx = {};
#pragma unroll
                    for (int ks = 0; ks < 4; ++ks) { da = __builtin_amdgcn_mfma_f32_32x32x16_bf16(af[ks], wfa[oc][ks], da, 0, 0, 0); dx = __builtin_amdgcn_mfma_f32_32x32x16_bf16(af[ks], wfx[oc][ks], dx, 0, 0, 0); }
                    float av[16], uv[16];
#pragma unroll
                    for (int r = 0; r < 16; ++r) { const int tl = crow(r, hi); const float xcv = bf2f(*(const LAS unsigned short*)(xcs + tl * LRU_XROW + (32 * oc + r32) * 2));
                        const float rg = __builtin_amdgcn_rcpf(1.0f + __builtin_amdgcn_exp2f(da[r] + ba[oc])), ig = __builtin_amdgcn_rcpf(1.0f + __builtin_amdgcn_exp2f(dx[r] + bx[oc])); const float a = __builtin_amdgcn_exp2f(rg * sp8[oc]);
                        av[r] = a; uv[r] = __builtin_amdgcn_sqrtf(fmaxf(1.0f - a * a, 0.f)) * ig * xcv; }
                    float As[4], Hs[4], cin[4];
#pragma unroll
                    for (int g = 0; g < 4; ++g) { float h = uv[4 * g]; float ap = av[4 * g];
#pragma unroll
                        for (int q = 1; q < 4; ++q) { h = av[4 * g + q] * h + uv[4 * g + q]; ap *= av[4 * g + q]; }
                        As[g] = ap; Hs[g] = h; }
                    float crun = c[oc];
#pragma unroll
                    for (int g = 0; g < 4; ++g) { const float o0 = As[g] * crun + Hs[g]; const float mid = __shfl_xor(o0, 32); const float ci = hi ? mid : crun; const float o1 = As[g] * ci + Hs[g];
                        const float fin = __shfl_xor(o1, 32); crun = hi ? o1 : fin; cin[g] = ci; }
                    c[oc] = crun;
                    if constexpr (!PASS2) { aprod[oc] *= (As[0] * As[1]) * (As[2] * As[3]); }
                    else {
#pragma unroll
                        for (int g = 0; g < 4; ++g) { float h = cin[g];
#pragma unroll
                            for (int q = 0; q < 4; ++q) { const int r = 4 * g + q; h = av[r] * h + uv[r];
                                LAS unsigned short* yp = (LAS unsigned short*)(ys + crow(r, hi) * LRU_XROW + (32 * oc + r32) * 2);
                                const float y = bf2f(*yp); const float ge = y * __builtin_amdgcn_rcpf(1.0f + __builtin_amdgcn_exp2f(y * (-2.3022082f + -0.1029432f * (y * y))));
                                *yp = (unsigned short)f2bf(ge * h); } }
                    }
                }
                if constexpr (PASS2) {
#pragma unroll
                    for (int i = 0; i < 4; ++i) { const int row = i * 8 + (lane >> 3), ch = lane & 7;
                        *(GAS u32x4*)(MIX + (rowb + tb + row) * DM + 64 * n + ch * 8) = *(const LAS u32x4*)(ys + row * LRU_XROW + ch * 16); }
                }
            }
            if constexpr (!PASS2) {
#pragma unroll
                for (int oc = 0; oc < 2; ++oc) { const float at = aprod[oc] * __shfl_xor(aprod[oc], 32);
                    if (hi == 0) *(GAS f32x2*)(agg + ((size_t)((b * 64 + tt) * DLRU) + 64 * n + 32 * oc + r32) * 2) = (f32x2){at, c[oc]}; }
            }
        }
    }
}

namespace att {
constexpr int KROW = 208, KTB = 64 * KROW, VROW = 192, VTB = 64 * VROW;
constexpr int OFF_K = 0, OFF_V = 2 * KTB, OFF_Q = 2 * KTB + 3 * VTB;
typedef short s16x4 __attribute__((ext_vector_type(4)));
__device__ __forceinline__ s16x4 vtr(const LAS unsigned char* p) { return __builtin_bit_cast(s16x4, __builtin_amdgcn_ds_read_tr16_b64_v4i16((LAS s16x4*)p)); }
__device__ __forceinline__ void unit(Frame& F, int b, int h, int qb, float MB) {
    const int tid = F.tid, lane = F.lane, w = F.wave, r32 = lane & 31, hi = lane >> 5;
    const GAS bf16* Qb = WSG(bf16, WS_Q); const GAS bf16* Kb = WSG(bf16, WS_K); const GAS bf16* Vb = WSG(bf16, WS_V); GAS bf16* MIX = WSG(bf16, WS_MIX);
    const GAS float* ct = WSG(float, WS_COS); const GAS float* st = WSG(float, WS_SIN); const GAS float* gqn = GG(float, F.g_qn);
    const size_t rowb = (size_t)b * SEQ; const int qrow = qb * 256 + w * 32 + r32; const size_t gr = rowb + qrow;
    bf16x8 qr[6];
    {
        float qf[6][8]; float ss = 0.f;
#pragma unroll
        for (int ks = 0; ks < 6; ++ks) { const u32x4 v = *(const GAS u32x4*)(Qb + gr * 768 + h * QKH + 16 * ks + 8 * hi);
            qf[ks][0] = bflo(v.x); qf[ks][1] = bfhi(v.x); qf[ks][2] = bflo(v.y); qf[ks][3] = bfhi(v.y); qf[ks][4] = bflo(v.z); qf[ks][5] = bfhi(v.z); qf[ks][6] = bflo(v.w); qf[ks][7] = bfhi(v.w);
#pragma unroll
            for (int j = 0; j < 8; ++j) ss += qf[ks][j] * qf[ks][j]; }
        ss += __shfl_xor(ss, 32);
        const float rs = __builtin_amdgcn_rsqf(ss * (1.0f / QKH) + EPS);
#pragma unroll
        for (int ks = 0; ks < 6; ++ks)
#pragma unroll
            for (int j = 0; j < 8; ++j) qf[ks][j] *= rs * gqn[16 * ks + 8 * hi + j];
#pragma unroll
        for (int j = 0; j < 8; ++j) { const float cs = ct[gr * 16 + 8 * hi + j], sn = st[gr * 16 + 8 * hi + j]; const float a = qf[4][j], bb = qf[5][j]; qf[4][j] = a * cs - bb * sn; qf[5][j] = bb * cs + a * sn; }
        const float sc = 0.10206207261596575f * 1.4426950408889634f;
#pragma unroll
        for (int ks = 0; ks < 6; ++ks) { u32x4 pk; pk.x = pk2(qf[ks][0] * sc, qf[ks][1] * sc); pk.y = pk2(qf[ks][2] * sc, qf[ks][3] * sc); pk.z = pk2(qf[ks][4] * sc, qf[ks][5] * sc); pk.w = pk2(qf[ks][6] * sc, qf[ks][7] * sc);
            qr[ks] = __builtin_bit_cast(bf16x8, pk); }
    }
    LAS unsigned char* qlds = F.lds + OFF_Q + w * 6144 + hi * 512 + r32 * 16;
#pragma unroll
    for (int ks = 0; ks < 6; ++ks) *(LAS bf16x8*)(qlds + ks * 1024) = qr[ks];
    const int NT = 4 * (qb + 1);
    const int kr1 = tid / 12, kc1 = tid % 12, kr2 = (512 + tid) / 12, kc2 = (512 + tid) % 12; const bool k2 = tid < 256;
    const int vr = tid >> 3, vc = tid & 7;
    const GAS char* kbase = (const GAS char*)(Kb + rowb * 768 + h * QKH); const GAS char* vbase_g = (const GAS char*)(Vb + rowb * 512 + h * VH);
    const unsigned ko1 = (unsigned)(kr1 * 768 + kc1 * 8) * 2u, ko2 = (unsigned)(kr2 * 768 + kc2 * 8) * 2u, vo1 = (unsigned)(vr * 512 + vc * 8) * 2u;
    LAS unsigned char* L = F.lds;
    u32x4 skA1, skA2 = (u32x4){0u, 0u, 0u, 0u}, svA;
#define ATT_BAR() do { __builtin_amdgcn_sched_barrier(0); asm volatile("s_waitcnt lgkmcnt(0)" ::: "memory"); __builtin_amdgcn_s_barrier(); asm volatile("" ::: "memory"); __builtin_amdgcn_sched_barrier(0); } while (0)
#define ATT_LOADK(X, t) do { const GAS char* kt_ = kbase + (size_t)(t) * (64 * 768 * 2); sk##X##1 = *(const GAS u32x4*)(kt_ + ko1); if (k2) sk##X##2 = *(const GAS u32x4*)(kt_ + ko2); } while (0)
#define ATT_LOADV(X, t) do { sv##X = *(const GAS u32x4*)(vbase_g + (size_t)(t) * (64 * 512 * 2) + vo1); } while (0)
#define ATT_WRITEK(X, buf) do { *(LAS u32x4*)(L + OFF_K + (buf) * KTB + kr1 * KROW + kc1 * 16) = sk##X##1; if (k2) *(LAS u32x4*)(L + OFF_K + (buf) * KTB + kr2 * KROW + kc2 * 16) = sk##X##2; } while (0)
#define ATT_WRITEV(X, voff) do { *(LAS u32x4*)(L + OFF_V + (voff) + vr * VROW + vc * 16) = sv##X; } while (0)
#define ATT_QK(S0, S1, buf) do { const LAS unsigned char* kb_ = L + OFF_K + (buf) * KTB + r32 * KROW + hi * 16; \
        _Pragma("unroll") for (int ks = 0; ks < 6; ++ks) { const bf16x8 a0 = *(const LAS bf16x8*)(kb_ + ks * 32), a1 = *(const LAS bf16x8*)(kb_ + 32 * KROW + ks * 32); \
            const bf16x8 qv = *(const LAS bf16x8*)(qlds + ks * 1024); \
            if (ks == 0) { S0 = __builtin_amdgcn_mfma_f32_32x32x16_bf16(a0, qv, f32x16{}, 0, 0, 0); S1 = __builtin_amdgcn_mfma_f32_32x32x16_bf16(a1, qv, f32x16{}, 0, 0, 0); } \
            else { S0 = __builtin_amdgcn_mfma_f32_32x32x16_bf16(a0, qv, S0, 0, 0, 0); S1 = __builtin_amdgcn_mfma_f32_32x32x16_bf16(a1, qv, S1, 0, 0, 0); } } } while (0)
#define ATT_PV(voff) do { const LAS unsigned char* vb = vbase + (voff); \
        _Pragma("unroll") for (int s4 = 0; s4 < 4; ++s4) { const bf16x8 pfv = __builtin_bit_cast(bf16x8, pf[s4]); \
            _Pragma("unroll") for (int d = 0; d < 2; ++d) { const LAS unsigned char* vp = vb + (16 * s4) * VROW + (32 * d) * 2; \
                const s16x4 lo = vtr(vp), hh = vtr(vp + 8 * VROW); \
                const bf16x8 vv = __builtin_shufflevector(lo, hh, 0, 1, 2, 3, 4, 5, 6, 7); \
                o[d] = __builtin_amdgcn_mfma_f32_32x32x16_bf16(vv, pfv, o[d], 0, 0, 0); } } } while (0)
    const float sh = fmaxf(MB - 100.0f, 0.f);
    { u32x4 skT1, skT2 = (u32x4){0u, 0u, 0u, 0u};
      ATT_LOADK(A, 0); ATT_LOADV(A, 0); ATT_LOADK(T, 1); ATT_WRITEK(A, 0); ATT_WRITEV(A, 0); ATT_WRITEK(T, 1); }
    for (int i = tid; i < VTB / 8; i += 512) *(LAS u32x2*)(L + OFF_V + 2 * VTB + i * 8) = (u32x2){0u, 0u};
    ATT_LOADK(A, 2); ATT_LOADV(A, 1);
    ATT_BAR();
    float lsum = 0.f; f32x16 o[2]; o[0] = f32x16{}; o[1] = f32x16{};
    const int wq_max = qb * 256 + w * 32 + 31;
    f32x16 pa0, pa1, pb0 = f32x16{}, pb1 = f32x16{};
    u32x4 pf[4]; pf[0] = pf[1] = pf[2] = pf[3] = (u32x4){0u, 0u, 0u, 0u};
    ATT_QK(pa0, pa1, 0);
    const LAS unsigned char* vbase = L + OFF_V + (4 * hi + ((lane & 15) >> 2)) * VROW + (16 * ((lane >> 4) & 1) + 4 * (lane & 3)) * 2;
    int vprev = 2 * VTB, vcur = 0, vnext = VTB;
#ifndef ATT_DUP
#define ATT_DUP 0
#endif
#ifndef ATT_HINT_MODE
#define ATT_HINT_MODE 3
#endif
#if ATT_HINT_MODE == 0
#define ATT_HINT(C) do {} while (0)
#elif ATT_HINT_MODE == 1
#define ATT_HINT(C) do { if (C) { _Pragma("unroll") for (int i_ = 0; i_ < 20; ++i_) { __builtin_amdgcn_sched_group_barrier(0x008, 1, 0); __builtin_amdgcn_sched_group_barrier(0x002, 5, 0); } } } while (0)
#elif ATT_HINT_MODE == 3
#define ATT_HINT(C) do { if (C) { __builtin_amdgcn_sched_group_barrier(0x100, 6, 0); \
        _Pragma("unroll") for (int i_ = 0; i_ < 6; ++i_) { __builtin_amdgcn_sched_group_barrier(0x008, 1, 0); __builtin_amdgcn_sched_group_barrier(0x002, 5, 0); __builtin_amdgcn_sched_group_barrier(0x008, 1, 0); __builtin_amdgcn_sched_group_barrier(0x100, 3, 0); __builtin_amdgcn_sched_group_barrier(0x002, 5, 0); } \
        _Pragma("unroll") for (int i_ = 0; i_ < 8; ++i_) { __builtin_amdgcn_sched_group_barrier(0x008, 1, 0); __builtin_amdgcn_sched_group_barrier(0x100, 2, 0); __builtin_amdgcn_sched_group_barrier(0x002, 6, 0); } } } while (0)
#elif ATT_HINT_MODE == 2
#define ATT_HINT(C) do { if (C) { __builtin_amdgcn_sched_group_barrier(0x100, 18, 0); \
        _Pragma("unroll") for (int i_ = 0; i_ < 12; ++i_) { __builtin_amdgcn_sched_group_barrier(0x008, 1, 0); if (i_ < 8) __builtin_amdgcn_sched_group_barrier(0x100, 2, 0); __builtin_amdgcn_sched_group_barrier(0x002, 4, 0); } \
        _Pragma("unroll") for (int i_ = 0; i_ < 8; ++i_) { __builtin_amdgcn_sched_group_barrier(0x008, 1, 0); __builtin_amdgcn_sched_group_barrier(0x002, 6, 0); } } } while (0)
#endif
#define ATT_STEP(t, P0, P1, N0, N1, CLEAN) do { const int buf = (t) & 1; \
        if (CLEAN || (((t) + 1 < NT) && (64 * ((t) + 1) <= wq_max))) ATT_QK(N0, N1, buf ^ 1); \
        if (CLEAN || (64 * ((t) - 1) <= wq_max)) ATT_PV(vprev); \
        if (CLEAN || (64 * (t) <= wq_max)) { \
            if (!CLEAN && (t) >= 4 * qb) { const int kv0 = 64 * (t) + 4 * hi; \
                _Pragma("unroll") for (int r = 0; r < 16; ++r) { const int kv = kv0 + (r & 3) + 8 * (r >> 2); if (kv > qrow) P0[r] = -1e30f; if (kv + 32 > qrow) P1[r] = -1e30f; } } \
            if (!CLEAN) { if (sh > 0.f) { _Pragma("unroll") for (int r = 0; r < 16; ++r) { P0[r] -= sh; P1[r] -= sh; } } } \
            f32x2 ps0 = {0.f, 0.f}, ps1 = {0.f, 0.f}, ps2 = {0.f, 0.f}, ps3 = {0.f, 0.f};     \
            _Pragma("unroll") for (int r = 0; r < 16; ++r) { P0[r] = __builtin_amdgcn_exp2f(P0[r]); P1[r] = __builtin_amdgcn_exp2f(P1[r]); } \
            _Pragma("unroll") for (int r = 0; r < 16; r += 4) { ps0 += (f32x2){P0[r], P0[r + 1]}; ps1 += (f32x2){P0[r + 2], P0[r + 3]}; ps2 += (f32x2){P1[r], P1[r + 1]}; ps3 += (f32x2){P1[r + 2], P1[r + 3]}; } \
            { const f32x2 pt = (ps0 + ps1) + (ps2 + ps3); lsum += pt.x + pt.y; } \
            _Pragma("unroll") for (int s = 0; s < 2; ++s) { \
                pf[s].x = cvt_pk_bf16(P0[8 * s + 0], P0[8 * s + 1]); pf[s].y = cvt_pk_bf16(P0[8 * s + 2], P0[8 * s + 3]); pf[s].z = cvt_pk_bf16(P0[8 * s + 4], P0[8 * s + 5]); pf[s].w = cvt_pk_bf16(P0[8 * s + 6], P0[8 * s + 7]); \
                pf[2 + s].x = cvt_pk_bf16(P1[8 * s + 0], P1[8 * s + 1]); pf[2 + s].y = cvt_pk_bf16(P1[8 * s + 2], P1[8 * s + 3]); pf[2 + s].z = cvt_pk_bf16(P1[8 * s + 4], P1[8 * s + 5]); pf[2 + s].w = cvt_pk_bf16(P1[8 * s + 6], P1[8 * s + 7]); } \
        } else { pf[0] = pf[1] = pf[2] = pf[3] = (u32x4){0u, 0u, 0u, 0u}; } \
        ATT_HINT(CLEAN); \
        ATT_WRITEK(A, buf); \
        ATT_WRITEV(A, vnext); \
        if (ATT_DUP && CLEAN) { asm volatile("" ::: "memory"); ATT_WRITEK(A, buf); ATT_WRITEV(A, vnext); asm volatile("" ::: "memory"); \
            ATT_LOADK(A, ((t) + 3 < NT) ? (t) + 3 : NT - 1); ATT_LOADV(A, ((t) + 2 < NT) ? (t) + 2 : NT - 1); asm volatile("" : "+v"(skA1), "+v"(skA2), "+v"(svA)); } \
        ATT_LOADK(A, ((t) + 3 < NT) ? (t) + 3 : NT - 1); \
        ATT_LOADV(A, ((t) + 2 < NT) ? (t) + 2 : NT - 1); \
        ATT_BAR(); \
        { const int tmp_ = vprev; vprev = vcur; vcur = vnext; vnext = tmp_; } } while (0)
    int t = 0;
    if (sh == 0.f) for (; t < 4 * qb; t += 2) { ATT_STEP(t, pa0, pa1, pb0, pb1, 1); ATT_STEP(t + 1, pb0, pb1, pa0, pa1, 1); }
    for (; t < NT; t += 2) { ATT_STEP(t, pa0, pa1, pb0, pb1, 0); ATT_STEP(t + 1, pb0, pb1, pa0, pa1, 0); }
    if (64 * (NT - 1) <= wq_max) ATT_PV(vprev);
    ATT_BAR();
#undef ATT_STEP
#undef ATT_HINT
#undef ATT_BAR
#undef ATT_PV
#undef ATT_LOADK
#undef ATT_LOADV
#undef ATT_WRITEK
#undef ATT_WRITEV
#undef ATT_QK
    lsum += __shfl_xor(lsum, 32);
    const float inv = 1.0f / lsum;
    GAS bf16* op = MIX + gr * DM + DLRU + h * VH;
#pragma unroll
    for (int d = 0; d < 2; ++d)
#pragma unroll
        for (int g = 0; g < 4; ++g) { u32x2 wv; wv.x = cvt_pk_bf16(o[d][4 * g] * inv, o[d][4 * g + 1] * inv); wv.y = cvt_pk_bf16(o[d][4 * g + 2] * inv, o[d][4 * g + 3] * inv);
            *(GAS u32x2*)(op + 32 * d + 8 * g + 4 * hi) = wv; }
}
__device__ __forceinline__ void phase(Frame& F) {
    float gq = 0.f, gk = 0.f;
    for (int i = 0; i < QKH; ++i) { gq = fmaxf(gq, fabsf(F.g_qn[i])); gk = fmaxf(gk, fabsf(F.g_kn[i])); }
    const float MB = 9.797958971f * 1.4426950408889634f * gq * gk * 1.02f;
    for (int pi = F.vcu; pi < 512; pi += F.G) {
        const int bh = pi >> 3, s = pi & 7;
        unit(F, bh >> 3, bh & 7, 15 - s, MB);
        unit(F, bh >> 3, bh & 7, s, MB);
    }
}
}

__device__ __forceinline__ void p6a_norm(Frame& F) {
    const GAS float* mod = WSG(float, WS_MOD); GAS unsigned char* H2 = WSG(unsigned char, WS_H2); GAS bf16* H2B = WSG(bf16, WS_H2B);
    const GAS float* gf = GG(float, F.g_ffn); const GAS bf16* X1 = WSG(bf16, WS_X1B);
    const int gw = F.vcu * 8 + F.wave, NGW = F.G * 8, lane = F.lane;
    for (int m0 = gw * 2; m0 < T; m0 += NGW * 2) {
        const int b = m0 / SEQ;
        u32x4 xr[2][2];
#pragma unroll
        for (int r = 0; r < 2; ++r)
#pragma unroll
            for (int h = 0; h < 2; ++h) xr[r][h] = *(const GAS u32x4*)(X1 + (size_t)(m0 + r) * DM + 16 * lane + 8 * h);
        f32x4 G[4], S[4];
#pragma unroll
        for (int q = 0; q < 4; ++q) { const int col = 16 * lane + 4 * q; const f32x4 g = *(const GAS f32x4*)(gf + col), sc = *(const GAS f32x4*)(mod + (size_t)b * 6144 + 4096 + col);
            G[q] = g * (sc + 1.0f); S[q] = *(const GAS f32x4*)(mod + (size_t)b * 6144 + 3072 + col); }
#pragma unroll
        for (int r = 0; r < 2; ++r) { f32x4 v[4];
#pragma unroll
            for (int h = 0; h < 2; ++h) { v[2 * h] = (f32x4){bflo(xr[r][h].x), bfhi(xr[r][h].x), bflo(xr[r][h].y), bfhi(xr[r][h].y)}; v[2 * h + 1] = (f32x4){bflo(xr[r][h].z), bfhi(xr[r][h].z), bflo(xr[r][h].w), bfhi(xr[r][h].w)}; }
            float s = 0.f;
#pragma unroll
            for (int q = 0; q < 4; ++q) s += (v[q][0] * v[q][0] + v[q][1] * v[q][1]) + (v[q][2] * v[q][2] + v[q][3] * v[q][3]);
            const float rstd = 1.0f / sqrtf(wave_sum(s) * (1.0f / DM) + EPS);
            u32x4 o8, ob[2];
#pragma unroll
            for (int q = 0; q < 4; ++q) { const f32x4 hv = v[q] * rstd * G[q] + S[q];
                o8[q] = pk4_fp8(hv[0], hv[1], hv[2], hv[3]);
                ob[q >> 1][2 * (q & 1)] = cvt_pk_bf16(hv[0], hv[1]); ob[q >> 1][2 * (q & 1) + 1] = cvt_pk_bf16(hv[2], hv[3]); }
            *(GAS u32x4*)(H2 + (size_t)(m0 + r) * DM + 16 * lane) = o8;
            *(GAS u32x4*)(H2B + (size_t)(m0 + r) * DM + 16 * lane) = ob[0]; *(GAS u32x4*)(H2B + (size_t)(m0 + r) * DM + 16 * lane + 8) = ob[1]; }
    }
}
__device__ __forceinline__ void p6_mfma(Frame& F) {
    LAS unsigned char* WL = F.lds;
    LAS float* GT = (LAS float*)(F.lds + 65536);
    LAS float* lgw = (LAS float*)(F.lds + 65536 + 8192) + F.wave * 512;
    LAS int* hist = (LAS int*)(F.lds + TAB_OFF); LAS int* base = hist + 32;
    const GAS bf16* WR = WSG(bf16, WS_WR);
    for (int idx = F.tid; idx < 4096; idx += 512) { const int e = idx & 31, kk = idx >> 5;
        *(LAS u32x4*)(WL + idx * 16) = *(const GAS u32x4*)(WR + (size_t)e * DM + kk * 8); }
    const GAS float* mod = WSG(float, WS_MOD); GAS unsigned char* H2 = WSG(unsigned char, WS_H2); const GAS float* gf = GG(float, F.g_ffn); const GAS bf16* X1 = WSG(bf16, WS_X1B);
    GAS int* list = WSG(int, WS_LIST); GAS float* gates = WSG(float, WS_GATES); unsigned* gcount = F.ctl + CW_CNT;
    const int lane = F.lane, r = lane & 15, kq = lane >> 4;
    const float br0 = F.b_router[r], br1 = F.b_router[16 + r];
    for (int chunk = blockIdx.x; chunk < T / 128; chunk += F.G) {
        const int b = (chunk * 128) / SEQ;
        __syncthreads();
        if (F.tid < 32) hist[F.tid] = 0;
        for (int c = F.tid; c < 1024; c += 512) { GT[c] = gf[c] * (1.0f + mod[(size_t)b * 6144 + 4096 + c]); GT[1024 + c] = mod[(size_t)b * 6144 + 3072 + c]; }
        __syncthreads();
        const int row = chunk * 128 + F.wave * 16 + r;
        const GAS bf16* xp = X1 + (size_t)row * DM + 8 * kq;
        u32x4 xr[32]; float ss = 0.f;
#pragma unroll
        for (int ks = 0; ks < 32; ++ks) xr[ks] = *(const GAS u32x4*)(xp + 32 * ks);
#pragma unroll
        for (int ks = 0; ks < 32; ++ks) { const float a0 = bflo(xr[ks].x), a1 = bfhi(xr[ks].x), a2 = bflo(xr[ks].y), a3 = bfhi(xr[ks].y), a4 = bflo(xr[ks].z), a5 = bfhi(xr[ks].z), a6 = bflo(xr[ks].w), a7 = bfhi(xr[ks].w);
            ss += (a0 * a0 + a1 * a1) + (a2 * a2 + a3 * a3) + (a4 * a4 + a5 * a5) + (a6 * a6 + a7 * a7); asm volatile("" : "+v"(xr[ks])); }
        ss += __shfl_xor(ss, 16); ss += __shfl_xor(ss, 32);
        const float rstd = 1.0f / sqrtf(ss * (1.0f / DM) + EPS);
        f32x4 acc0 = {0.f, 0.f, 0.f, 0.f}, acc1 = {0.f, 0.f, 0.f, 0.f};
        GAS unsigned char* hp = H2 + (size_t)row * DM + 8 * kq;
#pragma unroll
        for (int ks = 0; ks < 32; ++ks) { const int col = 32 * ks + 8 * kq;
            const f32x4 g0 = *(const LAS f32x4*)(GT + col), g1 = *(const LAS f32x4*)(GT + col + 4), s0 = *(const LAS f32x4*)(GT + 1024 + col), s1 = *(const LAS f32x4*)(GT + 1024 + col + 4);
            const f32x4 x0 = {bflo(xr[ks].x), bfhi(xr[ks].x), bflo(xr[ks].y), bfhi(xr[ks].y)}, x1v = {bflo(xr[ks].z), bfhi(xr[ks].z), bflo(xr[ks].w), bfhi(xr[ks].w)};
            const f32x4 h0 = x0 * rstd * g0 + s0, h1 = x1v * rstd * g1 + s1;
            u32x2 f8; f8.x = pk4_fp8(h0[0], h0[1], h0[2], h0[3]); f8.y = pk4_fp8(h1[0], h1[1], h1[2], h1[3]);
            *(GAS u32x2*)(hp + 32 * ks) = f8;
            u32x4 af; af.x = cvt_pk_bf16(h0[0], h0[1]); af.y = cvt_pk_bf16(h0[2], h0[3]); af.z = cvt_pk_bf16(h1[0], h1[1]); af.w = cvt_pk_bf16(h1[2], h1[3]);
            const bf16x8 a = __builtin_bit_cast(bf16x8, af);
            const bf16x8 b0 = *(const LAS bf16x8*)(WL + ((ks * 4 + kq) * 32 + r) * 16), b1 = *(const LAS bf16x8*)(WL + ((ks * 4 + kq) * 32 + 16 + r) * 16);
            acc0 = __builtin_amdgcn_mfma_f32_16x16x32_bf16(a, b0, acc0, 0, 0, 0); acc1 = __builtin_amdgcn_mfma_f32_16x16x32_bf16(a, b1, acc1, 0, 0, 0); }
#pragma unroll
        for (int q = 0; q < 4; ++q) { lgw[(4 * kq + q) * 32 + r] = acc0[q] + br0; lgw[(4 * kq + q) * 32 + 16 + r] = acc1[q] + br1; }
        asm volatile("s_waitcnt lgkmcnt(0)" ::: "memory");
        int se[4] = {0, 0, 0, 0}, lp[4] = {0, 0, 0, 0}; float gk[4] = {0.f, 0.f, 0.f, 0.f};
        const bool act = lane < 16; const int trow = chunk * 128 + F.wave * 16 + lane;
        if (act) {
            float v[32];
#pragma unroll
            for (int q = 0; q < 8; ++q) { const f32x4 t = *(const LAS f32x4*)(lgw + lane * 32 + 4 * q); v[4 * q] = t[0]; v[4 * q + 1] = t[1]; v[4 * q + 2] = t[2]; v[4 * q + 3] = t[3]; }
            float sv[4];
#pragma unroll
            for (int k = 0; k < 4; ++k) { float best = v[0]; int bi = 0;
#pragma unroll
                for (int e = 1; e < 32; ++e) { const bool gt = v[e] > best; best = gt ? v[e] : best; bi = gt ? e : bi; }
                sv[k] = best; se[k] = bi;
#pragma unroll
                for (int e = 0; e < 32; ++e) v[e] = (e == bi) ? -3.0e38f : v[e]; }
            const float t1 = fast_exp(sv[1] - sv[0]), t2 = fast_exp(sv[2] - sv[0]), t3 = fast_exp(sv[3] - sv[0]); const float rinv = 1.0f / (1.0f + t1 + t2 + t3);
            gk[0] = rinv; gk[1] = t1 * rinv; gk[2] = t2 * rinv; gk[3] = t3 * rinv;
#pragma unroll
            for (int k = 0; k < 4; ++k) lp[k] = __hip_atomic_fetch_add(hist + se[k], 1, __ATOMIC_RELAXED, __HIP_MEMORY_SCOPE_WORKGROUP);
        }
        __syncthreads();
        if (F.tid < 32) base[F.tid] = (int)__hip_atomic_fetch_add(gcount + F.tid, (unsigned)hist[F.tid], RLX_AGENT);
        __syncthreads();
        if (act) {
#pragma unroll
            for (int k = 0; k < 4; ++k) { const int ent = trow * 4 + k; list[(size_t)se[k] * T + base[se[k]] + lp[k]] = ent; gates[ent] = gk[k]; }
        }
    }
}

__device__ __forceinline__ void p6c_topk(Frame& F) {
    LAS int* hist = (LAS int*)(F.lds + TAB_OFF); LAS int* base = hist + 32;
    const GAS float* logit = WSG(float, WS_LOGIT); GAS int* list = WSG(int, WS_LIST); GAS float* gates = WSG(float, WS_GATES);
    unsigned* gcount = F.ctl + CW_CNT;
    for (int chunk = blockIdx.x; chunk < T / 128; chunk += F.G) {
        if (F.tid < 32) hist[F.tid] = 0;
        __syncthreads();
        const int row = chunk * 128 + F.tid; const bool act = F.tid < 128;
        int se[4] = {0, 0, 0, 0}, lp[4] = {0, 0, 0, 0}; float gk[4] = {0.f, 0.f, 0.f, 0.f};
        if (act) {
            float v[32];
#pragma unroll
            for (int q = 0; q < 8; ++q) { const f32x4 t = *(const GAS f32x4*)(logit + (size_t)row * NEXP + 4 * q); v[4 * q] = t[0]; v[4 * q + 1] = t[1]; v[4 * q + 2] = t[2]; v[4 * q + 3] = t[3]; }
            float sv[4];
#pragma unroll
            for (int k = 0; k < 4; ++k) { float best = v[0]; int bi = 0;
#pragma unroll
                for (int e = 1; e < 32; ++e) { const bool gt = v[e] > best; best = gt ? v[e] : best; bi = gt ? e : bi; }
                sv[k] = best; se[k] = bi;
#pragma unroll
                for (int e = 0; e < 32; ++e) v[e] = (e == bi) ? -3.0e38f : v[e]; }
            const float t1 = fast_exp(sv[1] - sv[0]), t2 = fast_exp(sv[2] - sv[0]), t3 = fast_exp(sv[3] - sv[0]); const float rinv = 1.0f / (1.0f + t1 + t2 + t3);
            gk[0] = rinv; gk[1] = t1 * rinv; gk[2] = t2 * rinv; gk[3] = t3 * rinv;
#pragma unroll
            for (int k = 0; k < 4; ++k) lp[k] = __hip_atomic_fetch_add(hist + se[k], 1, __ATOMIC_RELAXED, __HIP_MEMORY_SCOPE_WORKGROUP);
        }
        __syncthreads();
        if (F.tid < 32) base[F.tid] = (int)__hip_atomic_fetch_add(gcount + F.tid, (unsigned)hist[F.tid], RLX_AGENT);
        __syncthreads();
        if (act) {
#pragma unroll
            for (int k = 0; k < 4; ++k) { const int ent = row * 4 + k; list[(size_t)se[k] * T + base[se[k]] + lp[k]] = ent; gates[ent] = gk[k]; }
        }
        __syncthreads();
    }
}

__device__ __forceinline__ void moe_tables(Frame& F) {
    LAS int* tab = (LAS int*)(F.lds + TAB_OFF);
    if (F.tid == 0) { int acc = 0;
        for (int e = 0; e < NEXP; ++e) { const int c = (int)__hip_atomic_load(F.ctl + CW_CNT + e, RLX_AGENT); tab[e] = acc; tab[33 + e] = c; acc += (c + 255) >> 8; }
        tab[32] = acc; }
    __syncthreads();
}

__device__ __forceinline__ void p9_combine(Frame& F) {
    const GAS float* mod = WSG(float, WS_MOD); const GAS unsigned char* Y4 = WSG(unsigned char, WS_Y4); GAS float* O = (GAS float*)F.out; const GAS bf16* X1 = WSG(bf16, WS_X1B);
    const int gw = F.vcu * 8 + F.wave, NGW = F.G * 8, lane = F.lane;
    for (int m0 = gw * 2; m0 < T; m0 += NGW * 2) {
        const int b = m0 / SEQ;
        u32x4 y[2][4], xr[2][2];
#pragma unroll
        for (int r = 0; r < 2; ++r) {
#pragma unroll
            for (int k = 0; k < 4; ++k) y[r][k] = *(const GAS u32x4*)(Y4 + ((size_t)(m0 + r) * 4 + k) * DM + 16 * lane);
#pragma unroll
            for (int h = 0; h < 2; ++h) xr[r][h] = *(const GAS u32x4*)(X1 + (size_t)(m0 + r) * DM + 16 * lane + 8 * h); }
        f32x4 g2[4];
#pragma unroll
        for (int q = 0; q < 4; ++q) g2[q] = *(const GAS f32x4*)(mod + (size_t)b * 6144 + 5120 + 16 * lane + 4 * q) * 0.0625f;
#pragma unroll
        for (int r = 0; r < 2; ++r)
#pragma unroll
            for (int q = 0; q < 4; ++q) { f32x4 s = (f32x4){0.f, 0.f, 0.f, 0.f};
#pragma unroll
                for (int k = 0; k < 4; ++k) { const int w = (int)y[r][k][q]; const f32x2 lo = __builtin_amdgcn_cvt_pk_f32_fp8(w, false), hi2 = __builtin_amdgcn_cvt_pk_f32_fp8(w, true); s[0] += lo[0]; s[1] += lo[1]; s[2] += hi2[0]; s[3] += hi2[1]; }
                const unsigned w0 = xr[r][q >> 1][2 * (q & 1)], w1 = xr[r][q >> 1][2 * (q & 1) + 1];
                const f32x4 xv = (f32x4){bflo(w0), bfhi(w0), bflo(w1), bfhi(w1)};
                *(GAS f32x4*)(O + (size_t)(m0 + r) * DM + 16 * lane + 4 * q) = xv + g2[q] * s; }
    }
}

struct Args { const void* in[28]; float* out; unsigned char* ws; int ph_lo, ph_hi; };
__global__ void __launch_bounds__(512, 2) mega_fwd(Args args) {
    extern __shared__ __attribute__((aligned(16))) unsigned char lds_raw[];
    Frame F;
    F.lds = (LAS unsigned char*)lds_raw;
    F.wave = __builtin_amdgcn_readfirstlane((int)threadIdx.x >> 6); F.lane = lane_id(); F.tid = F.wave * 64 + F.lane;
    F.G = gridDim.x; { const int bx = blockIdx.x; F.vcu = (F.G % 8 == 0) ? (bx % 8) * (F.G / 8) + bx / 8 : bx; }
    F.x = F.c = F.w_ada = F.b_ada = F.g_mix = F.w_in = F.conv_w = F.conv_b = F.w_a = F.b_a = F.w_x = F.b_x = F.lam = F.g_q_lat = F.w_uq = F.g_kv_lat = F.w_ukv = F.g_qn = F.g_kn = F.w_out = F.g_ffn = F.w_router = F.b_router = F.w1 = F.b1 = F.w2 = F.b2 = nullptr; F.pos = nullptr;
#define LDIN(field, idx) F.field = (decltype(F.field))(GAS void*)args.in[idx]
#define PH_BEGIN() do { unsigned char* w_ = args.ws; asm volatile("" : "+s"(w_)); F.ws = (unsigned char*)(GAS unsigned char*)w_; F.ctl = (unsigned*)(F.ws + WS_CTL); F.lane = lane_id(); F.tid = F.wave * 64 + F.lane; } while (0)
    F.out = (float*)(GAS float*)args.out; F.ws = (unsigned char*)(GAS unsigned char*)args.ws; F.ctl = (unsigned*)(F.ws + WS_CTL);
    for (int u = F.tid; u < (LDS_BYTES - LDSCTL_OFF) / 4; u += 512) ((LAS unsigned*)(F.lds + LDSCTL_OFF))[u] = 0u;
    __syncthreads();
    const int lo = args.ph_lo, hi = args.ph_hi;
    const bool multi = (hi - lo) > 1;
    XcdBarrier bar; bar.bar = F.ctl + CW_BAR; bar.x = 0; bar.st = nullptr;
    if (multi) bar = xcd_barrier_post(F.ctl + CW_BAR, (volatile LAS unsigned*)(F.lds + MISC_OFF), F.tid == 0);
#ifndef PH_MASK
#define PH_MASK 0xfff
#endif
#define IN(k) ((((PH_MASK) >> (k)) & 1) && lo <= (k) && (k) < hi)
#define LEADER() (F.wave == 0 && lane_id() == 0)
#define SEAM(k) do { if (IN(k) && IN((k) + 1)) xcd_barrier(bar, LEADER()); } while (0)

    if (IN(0)) { PH_BEGIN(); LDIN(c, 1); LDIN(pos, 2); LDIN(w_ada, 3); LDIN(b_ada, 4); p0_mod_rope(F); SEAM(0); }
    if (IN(1)) { PH_BEGIN(); LDIN(x, 0); LDIN(g_mix, 5); LDIN(w_in, 6); LDIN(w_router, 22); LDIN(w_a, 9); LDIN(w_x, 11); LDIN(g_q_lat, 14); LDIN(w_uq, 15); LDIN(g_kv_lat, 16); LDIN(w_ukv, 17); LDIN(w_out, 20); LDIN(w1, 24); LDIN(w2, 26);
        p1_convert_norm(F); SEAM(1); }
    if (IN(2)) { PH_BEGIN();
        pg8::DenseSched S; S.init(WSG(bf16, WS_H), DM, WSG(bf16, WS_WIN), DM, T, DINP, F.G, (int)blockIdx.x);
        pg8::EpiZ E{WSG(bf16, WS_Z), WSG(float, WS_SSQ)};
        pg8::gemm_phase<pg8::EpiZ, pg8::DenseSched, true>(F.lds, DM * 2, S, E, F.wave);
        SEAM(2);
    }
    if (IN(3)) { PH_BEGIN();
        LDIN(conv_w, 7); LDIN(conv_b, 8); LDIN(b_a, 10); LDIN(b_x, 12); LDIN(lam, 13); LDIN(g_kn, 19);
#ifndef P3_PARTS
#define P3_PARTS 7
#endif
        if (P3_PARTS & 1) { pg8::DenseSched S; S.init(WSG(bf16, WS_Z) + 1024, DINP, WSG(bf16, WS_WUQ), 256, T, 768, F.G, (int)blockIdx.x);
          pg8::EpiQ E{WSG(bf16, WS_Q), WSG(float, WS_SSQ)};
          pg8::gemm_phase<pg8::EpiQ, pg8::DenseSched, true>(F.lds, 512, S, E, F.wave); }
        if (P3_PARTS & 2) { pg8::DenseSched S; S.init(WSG(bf16, WS_Z) + 1280, DINP, WSG(bf16, WS_WUKV), 256, T, 1024, F.G, (int)blockIdx.x);
          pg8::EpiKV E{WSG(bf16, WS_K), WSG(bf16, WS_V), WSG(bf16, WS_Z), WSG(float, WS_SSQ), GG(float, F.g_kn), WSG(float, WS_COS), WSG(float, WS_SIN)};
          pg8::gemm_phase<pg8::EpiKV, pg8::DenseSched, true>(F.lds, 512, S, E, F.wave); }
#ifndef P3_LRU_REP
#define P3_LRU_REP 1
#endif
        if (P3_PARTS & 4) for (int rr_ = 0; rr_ < P3_LRU_REP; ++rr_) lru_pass<false>(F);
        SEAM(3);
    }
    if (IN(4)) { PH_BEGIN();
        LDIN(conv_w, 7); LDIN(conv_b, 8); LDIN(b_a, 10); LDIN(b_x, 12); LDIN(lam, 13); LDIN(g_qn, 18); LDIN(g_kn, 19);
#ifndef P4_PARTS
#define P4_PARTS 3
#endif
#ifndef P4_LRU_REP
#define P4_LRU_REP 1
#endif
        if (P4_PARTS & 1) for (int rr_ = 0; rr_ < P4_LRU_REP; ++rr_) lru_pass<true>(F);
        __syncthreads();
        if (P4_PARTS & 2) att::phase(F);
        SEAM(4);
    }
    if (IN(5)) { PH_BEGIN();
        LDIN(x, 0);
        pg8::DenseSched S; S.init(WSG(bf16, WS_MIX), DM, WSG(bf16, WS_WOUT), DM, T, DM, F.G, (int)blockIdx.x);
        pg8::EpiX1 E{GG(float, F.x), WSG(bf16, WS_X1B), WSG(float, WS_MOD) + 2048};
        pg8::gemm_phase<pg8::EpiX1, pg8::DenseSched, true>(F.lds, DM * 2, S, E, F.wave);
        SEAM(5);
    }
#ifndef P6_MFMA
#define P6_MFMA 1
#endif
    if (P6_MFMA) {
        if (IN(6)) { PH_BEGIN(); LDIN(g_ffn, 21); LDIN(b_router, 23); p6_mfma(F); if (IN(9)) xcd_barrier(bar, LEADER()); }
    } else {
        if (IN(6)) { PH_BEGIN(); LDIN(g_ffn, 21); p6a_norm(F); SEAM(6); }
        if (IN(7)) { PH_BEGIN(); LDIN(b_router, 23);
            pg8::DenseSched S; S.init(WSG(bf16, WS_H2B), DM, WSG(bf16, WS_WR), DM, T, 256, F.G, (int)blockIdx.x);
            pg8::EpiLogit E{WSG(float, WS_LOGIT), GG(float, F.b_router)};
            pg8::gemm_phase<pg8::EpiLogit, pg8::DenseSched, true>(F.lds, DM * 2, S, E, F.wave);
            SEAM(7); }
        if (IN(8)) { PH_BEGIN(); p6c_topk(F); SEAM(8); }
    }
    if (IN(9)) { PH_BEGIN();
        LDIN(b1, 25);
        moe_tables(F);
        pg8::MoeSched<8, true> S{(const LAS int*)(F.lds + TAB_OFF), WSG(int, WS_LIST), WSG(unsigned char, WS_H2), WSG(unsigned char, WS_W1), F.G, F.vcu, (size_t)2048 * 1024, nullptr, nullptr, GG(float, F.b1), (LAS float*)(F.lds + BIASTAB_OFF)};
        pg8::EpiAct E{WSG(unsigned char, WS_ACT), (const LAS float*)(F.lds + BIASTAB_OFF)};
        pg8::gemm_phase<pg8::EpiAct, pg8::MoeSched<8, true>, true, true>(F.lds, DM, S, E, F.wave);
        SEAM(9);
    }
    if (IN(10)) { PH_BEGIN();
        LDIN(b2, 27);
        moe_tables(F);
        pg8::MoeSched<4, false> S{(const LAS int*)(F.lds + TAB_OFF), WSG(int, WS_LIST), WSG(unsigned char, WS_ACT), WSG(unsigned char, WS_W2), F.G, F.vcu, (size_t)1024 * 1024, WSG(float, WS_GATES), (LAS unsigned*)(F.lds + ROWTAB_OFF), GG(float, F.b2), (LAS float*)(F.lds + BIASTAB_OFF)};
        pg8::EpiY E{WSG(unsigned char, WS_Y4), (const LAS float*)(F.lds + BIASTAB_OFF), (const LAS unsigned*)(F.lds + ROWTAB_OFF), (const LAS int*)(F.lds + TAB_OFF)};
        pg8::gemm_phase<pg8::EpiY, pg8::MoeSched<4, false>, true, true>(F.lds, DFF, S, E, F.wave);
        SEAM(10);
    }
    if (IN(11)) { PH_BEGIN(); p9_combine(F); }
#undef IN
#undef SEAM
}

extern "C" void kernel_launch(void* const* d_in, const int* in_sizes, int n_in, void* d_out, int out_size, void* d_ws, size_t ws_size, hipStream_t stream) {
    static int grid = 0;
    if (grid == 0) {
        if (n_in != 28 || out_size != T * DM || ws_size < WS_END) { fprintf(stderr, "kernel_launch: unexpected shapes (n_in %d out %d ws %zu)\n", n_in, out_size, ws_size); grid = -1; return; }
        int dev = 0, cus = 0, per_cu = 0;
        if (hipGetDevice(&dev) != hipSuccess || hipDeviceGetAttribute(&cus, hipDeviceAttributeMultiprocessorCount, dev) != hipSuccess) { grid = -1; return; }
        if (hipFuncSetAttribute((const void*)mega_fwd, hipFuncAttributeMaxDynamicSharedMemorySize, LDS_BYTES) != hipSuccess) { fprintf(stderr, "kernel_launch: hipFuncSetAttribute failed\n"); grid = -1; return; }
        if (hipOccupancyMaxActiveBlocksPerMultiprocessor(&per_cu, (const void*)mega_fwd, 512, LDS_BYTES) != hipSuccess || per_cu < 1) { fprintf(stderr, "kernel_launch: occupancy query says %d blocks per CU\n", per_cu); per_cu = 1; }
        (void)hipGetLastError();
        grid = cus;
    }
    if (grid < 0) return;
    (void)hipMemsetAsync((char*)d_ws + WS_CTL, 0, CTL_ZERO_BYTES, stream);
    Args a{};
    for (int i = 0; i < 28; ++i) a.in[i] = d_in[i];
    a.out = (float*)d_out; a.ws = (unsigned char*)d_ws;
    constexpr int NPH = MK_LAST_PHASE;
    if (MK_N_LAUNCHES == 1) { a.ph_lo = 0; a.ph_hi = NPH; hipLaunchKernelGGL(mega_fwd, dim3(grid), dim3(512), LDS_BYTES, stream, a); }
    else { for (int p = 0; p < NPH; ++p) { const int reps = (p == PROBE_PHASE) ? PROBE_REP : 1;
            for (int r = 0; r < reps; ++r) { if (r > 0 && p == 8) (void)hipMemsetAsync((char*)d_ws + WS_CTL, 0, CTL_ZERO_BYTES, stream);
                a.ph_lo = p; a.ph_hi = p + 1; hipLaunchKernelGGL(mega_fwd, dim3(grid), dim3(512), LDS_BYTES, stream, a); } } }
}
```
